# Optimizing an MI355X kernel written in HIP

```python
import functools
import jax
import jax.numpy as jnp
from jax import lax
import numpy as np

D_MODEL = 2048
BATCH = 2
SEQ = 4096
DEPTH = 2

GRID_W = 64
CTX_LEN = 256
D_FF = -(-(8 * D_MODEL) // (3 * 256)) * 256

MIX_A = D_MODEL // 2
RWKV_HEAD = 64
RWKV_HEADS = MIX_A // RWKV_HEAD
LORA_W = 3 * D_MODEL // 64
LORA_A = 3 * D_MODEL // 64
LORA_G = D_MODEL // 8
A_COLS = 3 * MIX_A + LORA_W + LORA_A + LORA_G
RWKV_SPLITS = [MIX_A, 2 * MIX_A, 3 * MIX_A, 3 * MIX_A + LORA_W, 3 * MIX_A + LORA_W + LORA_A]
RWKV_GN_EPS = 64e-5

MIX_B = D_MODEL - MIX_A
GLA_HEADS = 4
GLA_KEY = MIX_B // 2
GLA_DK = GLA_KEY // GLA_HEADS
GLA_DV = MIX_B // GLA_HEADS
GLA_GATE_RANK = 16
GLA_GATE_TEMP = 16.0
B_COLS = 2 * GLA_KEY + 2 * MIX_B + GLA_GATE_RANK
GLA_SPLITS = [GLA_KEY, 2 * GLA_KEY, 2 * GLA_KEY + MIX_B, 2 * GLA_KEY + 2 * MIX_B]
AB_COLS = A_COLS + B_COLS

RET_HEADS = 8
RET_DK = D_MODEL // RET_HEADS
RET_DV = 2 * D_MODEL // RET_HEADS
RET_COLS = 6 * D_MODEL
RET_SPLITS = [D_MODEL, 2 * D_MODEL, 4 * D_MODEL]

CHUNK = 64
ROPE_THETA = 10000.0
RMS_EPS = 1e-6

kernel_name = "hybrid_rwkv7_gla_retention_dit"


def rmsnorm(x, g):
    xf = x.astype(jnp.float32)
    y = xf * lax.rsqrt(jnp.mean(xf * xf, axis=-1, keepdims=True) + RMS_EPS) * g.astype(jnp.float32)
    return y.astype(x.dtype)


def head_rmsnorm(t, g=None):
    y = t * lax.rsqrt(jnp.mean(t * t, axis=-1, keepdims=True) + RMS_EPS)
    return y if g is None else y * g


def modulate(h, shift, scale):
    return h * (1.0 + scale) + shift


def to_heads(t, n_heads):
    return t.reshape(*t.shape[:-1], n_heads, t.shape[-1] // n_heads)


def from_heads(t):
    return t.reshape(*t.shape[:-2], t.shape[-2] * t.shape[-1])


def centred_shift(z):
    zp = jnp.pad(z, ((0, 0), (1, 1), (0, 0)))
    return 0.5 * (zp[:, :-2] + zp[:, 2:])


def swiglu(h, w_in, w_out):
    gate, up = jnp.split(h @ w_in, 2, axis=-1)
    return (jax.nn.silu(gate) * up) @ w_out


def rotary_tables(rows, cols):
    nf = RET_DK // 4
    inv = ROPE_THETA ** (-jnp.arange(nf, dtype=jnp.float32) / nf)
    ang = jnp.concatenate([rows[:, None] * inv, cols[:, None] * inv], axis=-1)
    return jnp.cos(ang)[None, :, None, :], jnp.sin(ang)[None, :, None, :]


def apply_rotary(t, cos, sin):
    t1, t2 = jnp.split(t, 2, axis=-1)
    return jnp.concatenate([t1 * cos - t2 * sin, t1 * sin + t2 * cos], axis=-1)


def _chunks(t):
    b, T, h, e = t.shape
    return t.reshape(b, T // CHUNK, CHUNK, h, e).transpose(1, 0, 3, 2, 4)


def _unchunk(t):
    n, b, h, c, e = t.shape
    return t.transpose(1, 0, 3, 2, 4).reshape(b, n * c, h, e)


def ctx_then_latent(scan_fn, ctx_in, lat_in, s0, reverse):
    flip = (lambda t: jnp.flip(t, axis=1)) if reverse else (lambda t: t)
    y_c, s_c = scan_fn(*[flip(t) for t in ctx_in], s0)
    y_l, _ = scan_fn(*[flip(t) for t in lat_in], s_c)
    return flip(y_c), flip(y_l)


def rwkv7_scan(r, decay, k, v, a, b, s0):
    def step(s, inp):
        r_t, w_t, k_t, v_t, a_t, b_t = inp
        sa = jnp.einsum('bhvk,bhk->bhv', s, a_t)
        s = s * w_t[:, :, None, :] + sa[..., None] * b_t[:, :, None, :] + v_t[..., None] * k_t[:, :, None, :]
        return s, jnp.einsum('bhvk,bhk->bhv', s, r_t)
    xs = tuple(jnp.swapaxes(t, 0, 1) for t in (r, decay, k, v, a, b))
    s_fin, ys = lax.scan(step, s0, xs)
    return jnp.swapaxes(ys, 0, 1), s_fin


def rwkv7_prep(z, mu, w0, w2, a0, a2, g2, k_k, k_a):
    z = z.astype(jnp.float32)
    z = z + (centred_shift(z) - z) * mu
    r, k, v, wd, ad, gd = jnp.split(z, RWKV_SPLITS, axis=-1)
    lr = jax.nn.sigmoid(a0 + ad @ a2)
    kk = to_heads(k * k_k, RWKV_HEADS)
    kk = kk / jnp.maximum(jnp.sqrt(jnp.sum(kk * kk, axis=-1, keepdims=True)), 1e-12)
    k = k * (1.0 + (lr - 1.0) * k_a)
    g = jax.nn.sigmoid(gd) @ g2
    rh, kh, vh, lrh = (to_heads(t, RWKV_HEADS) for t in (r, k, v, lr))
    wt = jnp.tanh(wd)
    scan_in = []
    for d in range(2):
        w_log = -jax.nn.softplus(-(w0[d] + wt @ w2[d])) - 0.5
        decay = to_heads(jnp.exp(-jnp.exp(w_log)), RWKV_HEADS)
        scan_in.append((rh, decay, kh, vh, -kk, kk * lrh))
    return scan_in, (rh, kh, vh, g)


def rwkv7_finish(y, aux, r_k, ln_w, ln_b):
    rh, kh, vh, g = aux
    mean = jnp.mean(y, axis=-1, keepdims=True)
    var = jnp.mean(jnp.square(y - mean), axis=-1, keepdims=True)
    yn = from_heads((y - mean) * lax.rsqrt(var + RWKV_GN_EPS)) * ln_w + ln_b
    bonus = jnp.sum(rh * kh * r_k, axis=-1, keepdims=True) * vh
    return (yn + from_heads(bonus)) * g


def gla_chunk_scan(q, k, v, g, s0):
    q, k, v, g = (_chunks(t) for t in (q, k, v, g))
    bcum = jnp.cumsum(g, axis=3)
    b_last = bcum[..., -1:, :]
    q_in = q * jnp.exp(bcum)
    k_in = k * jnp.exp(-bcum)
    k_out = k * jnp.exp(b_last - bcum)
    mask = jnp.tril(jnp.ones((CHUNK, CHUNK), jnp.float32))
    att = jnp.einsum('nbhik,nbhjk->nbhij', q_in, k_in) * mask
    o_intra = jnp.einsum('nbhij,nbhjv->nbhiv', att, v)

    def step(s, inp):
        qi, ko, vv, dl = inp
        o = jnp.einsum('bhik,bhkv->bhiv', qi, s)
        s = s * dl[:, :, 0, :, None] + jnp.einsum('bhjk,bhjv->bhkv', ko, vv)
        return s, o
    s_fin, o_cross = lax.scan(step, s0, (q_in, k_out, v, jnp.exp(b_last)))
    return _unchunk(o_intra + o_cross), s_fin


def gla_prep(z, gk_up, gk_b):
    z = z.astype(jnp.float32)
    q, k, v, r, gd = jnp.split(z, GLA_SPLITS, axis=-1)
    qh = to_heads(q, GLA_HEADS) * GLA_DK ** -0.5
    kh = to_heads(k, GLA_HEADS)
    vh = to_heads(v, GLA_HEADS)
    scan_in = []
    for d in range(2):
        lg = jax.nn.log_sigmoid(gd @ gk_up[d] + gk_b[d]) / GLA_GATE_TEMP
        scan_in.append((qh, kh, vh, to_heads(lg, GLA_HEADS)))
    return scan_in, r


def rwkv_gla_mixer(h_lat, h_ctx, w_in, w_out, mu, w0, w2, a0, a2, g2, k_k, k_a, r_k,
                   ln_w, ln_b, gk_up, gk_b, gla_g, ctx_out):
    bsz = h_lat.shape[0]
    z_l = h_lat @ w_in
    z_c = h_ctx @ w_in
    ra_l, aux_l = rwkv7_prep(z_l[..., :A_COLS], mu, w0, w2, a0, a2, g2, k_k, k_a)
    ra_c, aux_c = rwkv7_prep(z_c[..., :A_COLS], mu, w0, w2, a0, a2, g2, k_k, k_a)
    gb_l, gate_l = gla_prep(z_l[..., A_COLS:], gk_up, gk_b)
    gb_c, gate_c = gla_prep(z_c[..., A_COLS:], gk_up, gk_b)
    s0_a = jnp.zeros((bsz, RWKV_HEADS, RWKV_HEAD, RWKV_HEAD), jnp.float32)
    s0_b = jnp.zeros((bsz, GLA_HEADS, GLA_DK, GLA_DV), jnp.float32)
    ya_c = ya_l = yb_c = yb_l = 0.0
    for d, rev in enumerate((False, True)):
        yc, yl = ctx_then_latent(rwkv7_scan, ra_c[d], ra_l[d], s0_a, rev)
        ya_c, ya_l = ya_c + yc, ya_l + yl
        yc, yl = ctx_then_latent(gla_chunk_scan, gb_c[d], gb_l[d], s0_b, rev)
        yb_c, yb_l = yb_c + yc, yb_l + yl

    def finish(ya, aux, yb, gate, h):
        out_a = rwkv7_finish(ya, aux, r_k, ln_w, ln_b)
        out_b = from_heads(head_rmsnorm(yb, gla_g)) * jax.nn.silu(gate)
        return jnp.concatenate([out_a, out_b], axis=-1).astype(h.dtype) @ w_out
    y_l = finish(ya_l, aux_l, yb_l, gate_l, h_lat)
    y_c = finish(ya_c, aux_c, yb_c, gate_c, h_ctx) if ctx_out else None
    return y_l, y_c


def retention_scan(gamma, q, k, v, s0):
    q, k, v = (_chunks(t) for t in (q, k, v))
    log_g = jnp.log(gamma)[:, None]
    pos = jnp.arange(CHUNK, dtype=jnp.float32)
    rel = pos[:, None] - pos[None, :]
    intra = jnp.where(rel[None] >= 0, jnp.exp(rel[None] * log_g[..., None]), 0.0)
    q_dec = q * jnp.exp((pos + 1.0) * log_g)[..., None]
    k_dec = k * jnp.exp((CHUNK - 1.0 - pos) * log_g)[..., None]
    chunk_dec = jnp.exp(CHUNK * log_g)[..., None]
    att = jnp.einsum('nbhik,nbhjk->nbhij', q, k) * intra
    o_intra = jnp.einsum('nbhij,nbhjv->nbhiv', att, v)

    def step(s, inp):
        qd, kd, vv = inp
        o = jnp.einsum('bhik,bhkv->bhiv', qd, s)
        s = s * chunk_dec + jnp.einsum('bhjk,bhjv->bhkv', kd, vv)
        return s, o
    s_fin, o_cross = lax.scan(step, s0, (q_dec, k_dec, v))
    return _unchunk(o_intra + o_cross), s_fin


def retention_mixer(h_lat, h_ctx, w_in, w_out, cos, sin, ctx_out):
    bsz = h_lat.shape[0]
    gamma = 1.0 - 2.0 ** (-5.0 - jnp.arange(RET_HEADS, dtype=jnp.float32))
    scan = functools.partial(retention_scan, gamma)

    def prep(h, rotate):
        z = (h @ w_in).astype(jnp.float32)
        q, k, v, g = jnp.split(z, RET_SPLITS, axis=-1)
        q, k = to_heads(q, RET_HEADS), to_heads(k, RET_HEADS)
        if rotate:
            q, k = apply_rotary(q, cos, sin), apply_rotary(k, cos, sin)
        return (q, k * RET_DK ** -0.5, to_heads(v, RET_HEADS)), g
    in_l, g_l = prep(h_lat, True)
    in_c, g_c = prep(h_ctx, False)
    s0 = jnp.zeros((bsz, RET_HEADS, RET_DK, RET_DV), jnp.float32)
    o_c = o_l = 0.0
    for rev in (False, True):
        yc, yl = ctx_then_latent(scan, in_c, in_l, s0, rev)
        o_c, o_l = o_c + yc, o_l + yl

    def finish(o, g, h):
        return (from_heads(head_rmsnorm(o)) * jax.nn.silu(g)).astype(h.dtype) @ w_out
    y_l = finish(o_l, g_l, h_lat)
    y_c = finish(o_c, g_c, h_ctx) if ctx_out else None
    return y_l, y_c


def mixer_residual(h, y, mod, ng):
    return h + mod[2] * rmsnorm(y, ng[1])


def ffn_residual(h, mod, ng, w_in, w_out):
    f = swiglu(modulate(rmsnorm(h, ng[2]), mod[3], mod[4]), w_in, w_out)
    return h + mod[5] * rmsnorm(f, ng[3])


def setup_inputs(seed: int = 0) -> dict:
    key = jax.random.key(seed)
    ks = iter(jax.random.split(key, 32))
    D = D_MODEL
    NE = (DEPTH + 1) // 2
    NO = DEPTH // 2

    def nrm(shape, scale):
        return jax.random.normal(next(ks), shape, jnp.float32) * scale
    return {
        "x": nrm((BATCH, SEQ, D), 1.0),
        "c": nrm((BATCH, D), 1.0),
        "ctx": nrm((BATCH, CTX_LEN, D), 1.0),
        "c_ctx": nrm((D,), 1.0),
        "mod_w": nrm((DEPTH, D, 6 * D), 0.5 * D ** -0.5),
        "mod_b": nrm((DEPTH, 6 * D), 0.02),
        "norm_g": 1.0 + nrm((DEPTH, 4, D), 0.05),
        "ffn_w_in": nrm((DEPTH, D, 2 * D_FF), D ** -0.5),
        "ffn_w_out": nrm((DEPTH, D_FF, D), D_FF ** -0.5),
        "ab_w_in": nrm((NE, D, AB_COLS), D ** -0.5),
        "ab_w_out": nrm((NE, MIX_A + MIX_B, D), (MIX_A + MIX_B) ** -0.5),
        "rwkv_mu": jax.random.uniform(next(ks), (NE, A_COLS), jnp.float32),
        "rwkv_w0": nrm((NE, 2, MIX_A), 1.0),
        "rwkv_w2": nrm((NE, 2, LORA_W, MIX_A), LORA_W ** -0.5),
        "rwkv_a0": nrm((NE, MIX_A), 0.5),
        "rwkv_a2": nrm((NE, LORA_A, MIX_A), LORA_A ** -0.5),
        "rwkv_g2": nrm((NE, LORA_G, MIX_A), LORA_G ** -0.5),
        "rwkv_kk": 0.85 + nrm((NE, MIX_A), 0.05),
        "rwkv_ka": 1.0 + nrm((NE, MIX_A), 0.05),
        "rwkv_rk": nrm((NE, RWKV_HEADS, RWKV_HEAD), 0.1),
        "rwkv_ln_w": 1.0 + nrm((NE, MIX_A), 0.05),
        "rwkv_ln_b": nrm((NE, MIX_A), 0.02),
        "gla_gk_up": nrm((NE, 2, GLA_GATE_RANK, GLA_KEY), GLA_GATE_RANK ** -0.5),
        "gla_gk_b": nrm((NE, 2, GLA_KEY), 0.5),
        "gla_norm_g": 1.0 + nrm((NE, GLA_DV), 0.05),
        "ret_w_in": nrm((NO, D, RET_COLS), D ** -0.5),
        "ret_w_out": nrm((NO, 2 * D, D), (2 * D) ** -0.5),
    }


def reference(x, c, ctx, c_ctx, mod_w, mod_b, norm_g, ffn_w_in, ffn_w_out, ab_w_in, ab_w_out,
              rwkv_mu, rwkv_w0, rwkv_w2, rwkv_a0, rwkv_a2, rwkv_g2, rwkv_kk, rwkv_ka, rwkv_rk,
              rwkv_ln_w, rwkv_ln_b, gla_gk_up, gla_gk_b, gla_norm_g, ret_w_in, ret_w_out):
    bsz, n_lat = x.shape[0], x.shape[1]
    rows_n = n_lat // GRID_W
    rows = jnp.repeat(jnp.arange(rows_n, dtype=jnp.float32), GRID_W)
    cols = jnp.tile(jnp.arange(GRID_W, dtype=jnp.float32), rows_n)
    cos, sin = rotary_tables(rows, cols)
    silu_c = jax.nn.silu(c)
    silu_cc = jax.nn.silu(c_ctx)
    h_lat, h_ctx = x, ctx
    for i in range(DEPTH):
        last = i == DEPTH - 1
        j = i // 2
        mod_l = (silu_c @ mod_w[i] + mod_b[i]).reshape(bsz, 6, D_MODEL).transpose(1, 0, 2)[:, :, None, :]
        mod_c = (silu_cc @ mod_w[i] + mod_b[i]).reshape(6, D_MODEL)
        ng = norm_g[i]
        a_l = modulate(rmsnorm(h_lat, ng[0]), mod_l[0], mod_l[1])
        a_c = modulate(rmsnorm(h_ctx, ng[0]), mod_c[0], mod_c[1])
        if i % 2 == 0:
            y_l, y_c = rwkv_gla_mixer(a_l, a_c, ab_w_in[j], ab_w_out[j], rwkv_mu[j], rwkv_w0[j],
                                      rwkv_w2[j], rwkv_a0[j], rwkv_a2[j], rwkv_g2[j], rwkv_kk[j],
                                      rwkv_ka[j], rwkv_rk[j], rwkv_ln_w[j], rwkv_ln_b[j],
                                      gla_gk_up[j], gla_gk_b[j], gla_norm_g[j], not last)
        else:
            y_l, y_c = retention_mixer(a_l, a_c, ret_w_in[j], ret_w_out[j], cos, sin, not last)
        h_lat = mixer_residual(h_lat, y_l, mod_l, ng)
        h_lat = ffn_residual(h_lat, mod_l, ng, ffn_w_in[i], ffn_w_out[i])
        if not last:
            h_ctx = mixer_residual(h_ctx, y_c, mod_c, ng)
            h_ctx = ffn_residual(h_ctx, mod_c, ng, ffn_w_in[i], ffn_w_out[i])
    return h_lat
```

```cpp
#include <hip/hip_runtime.h>
#include <hip/hip_cooperative_groups.h>
#include <cstdio>
#include <cstdint>
namespace cg = cooperative_groups;

#ifndef MK_ONE_LAUNCH
#define MK_ONE_LAUNCH 1
#endif

#define LAS __attribute__((address_space(3)))
typedef unsigned short bf16;
typedef short bf16x8 __attribute__((ext_vector_type(8)));
typedef float f32x4 __attribute__((ext_vector_type(4)));
typedef float f32x2 __attribute__((ext_vector_type(2)));
typedef unsigned u32x4 __attribute__((ext_vector_type(4)));
typedef unsigned u32x2 __attribute__((ext_vector_type(2)));

constexpr int D = 2048, NB = 2, SEQ = 4096, CTX = 256, TB = CTX + SEQ  , M = NB * TB  ;
constexpr int DFF = 5632, MIXA = 1024, ACOLS = 3520, ABCOLS = 6608, ZLD0 = 6656, RETC = 12288;
constexpr int GQ = 3520, GK = 4032, GV = 4544, GR = 5568, GGD = 6592;
constexpr float RMS_EPS = 1e-6f, GN_EPS = 64e-5f;
constexpr int NWAVES = 8, NTHR = 512;
constexpr int LDS_BYTES = 160 * 1024;

constexpr size_t MiB = 1u << 20;
constexpr size_t SZ_WAB = (size_t)ZLD0 * D * 2, SZ_WO0 = (size_t)D * D * 2, SZ_WFI = (size_t)2 * DFF * D * 2, SZ_WFO = (size_t)D * DFF * 2,
                 SZ_WRI = (size_t)RETC * D * 2, SZ_WRO = (size_t)D * 2 * D * 2, SZ_WLO = (size_t)4096 * 512 * 2;
constexpr size_t WS_CTL = 0;
constexpr size_t WS_WAB = 1 * MiB;
constexpr size_t WS_WO0 = WS_WAB + SZ_WAB;
constexpr size_t WS_WFI0 = WS_WO0 + SZ_WO0;
constexpr size_t WS_WFI1 = WS_WFI0 + SZ_WFI;
constexpr size_t WS_WFO0 = WS_WFI1 + SZ_WFI;
constexpr size_t WS_WFO1 = WS_WFO0 + SZ_WFO;
constexpr size_t WS_WRI = WS_WFO1 + SZ_WFO;
constexpr size_t WS_WRO = WS_WRI + SZ_WRI;
constexpr size_t WS_WLO = WS_WRO + SZ_WRO;
constexpr size_t WS_MODV = WS_WLO + SZ_WLO;
constexpr size_t WS_ROT = WS_MODV + 512 * 1024;
constexpr size_t WS_H = WS_ROT + 512 * 1024;
constexpr size_t SZ_H = (size_t)M * D * 4;
constexpr size_t WS_ZR = WS_H + SZ_H;
constexpr size_t SZ_ZR = (size_t)M * RETC * 2;
constexpr size_t RW_ITEMS = (size_t)NB * 16 * (TB / 64);
constexpr size_t WS_RWG = WS_ZR + (size_t)M * ZLD0 * 2;
constexpr size_t WS_RWP = WS_RWG + RW_ITEMS * 8192;
constexpr size_t WS_RWY = WS_RWP + RW_ITEMS * 8192;
constexpr size_t WS_RWQ = WS_RWY + RW_ITEMS * 8192;
constexpr size_t GLA_ITEMS = (size_t)NB * 4 * 2 * (TB / 64);
constexpr size_t WS_GKI = WS_RWQ + RW_ITEMS * 8192;
constexpr size_t WS_GDL = WS_GKI + GLA_ITEMS * 16384;
constexpr size_t DO_GQI = (size_t)M * D * 2;
static_assert(WS_GDL + GLA_ITEMS * 512 <= WS_ZR + SZ_ZR, "RWKV chunk operators (direction 0) + GLA k_in must fit in the tail of the Z region");
static_assert(DO_GQI + GLA_ITEMS * 16384 <= (size_t)NB * SEQ * D * 4, "GLA q_in must fit in d_out behind ABF");
static_assert(RW_ITEMS * 8192 * 4 <= SZ_H, "RWKV chunk operators (direction 1) live in the residual-stream buffer H, which is first written after the mixer");
constexpr size_t WS_MIX = WS_ZR + SZ_ZR;
constexpr size_t SZ_T = (size_t)M * MIXA * 2;
constexpr size_t MX_Y = 0;
constexpr size_t MX_R = 0, MX_V = SZ_T, MX_K = 2 * SZ_T, MX_KK = 3 * SZ_T, MX_BV = 4 * SZ_T, MX_G = 5 * SZ_T;
constexpr size_t MX_DEC = 6 * SZ_T;
constexpr size_t MX_ALO = MX_DEC + 4 * SZ_T;
constexpr size_t MX_YA = MX_ALO + SZ_T / 2;
constexpr size_t MX_YB = MX_YA + 2 * SZ_T;
constexpr size_t SZ_MIX0 = MX_YB + 2 * SZ_T;
constexpr size_t MX_YC = 80 * MiB;
constexpr size_t WS_YC = WS_MIX + MX_YC;
static_assert(MX_YC >= (size_t)M * D * 4 && MX_YC + (size_t)11 * NB * CTX * D * 4 <= SZ_MIX0, "split-K slabs inside the mixer scratch, above Y");
constexpr size_t MX_OC = 0;
constexpr size_t MX_A3 = (size_t)2 * M * 4096 * 2;
constexpr size_t SZ_MIX1 = MX_A3 + (size_t)M * 4096 * 2;
constexpr size_t SZ_MIX = SZ_MIX0 > SZ_MIX1 ? SZ_MIX0 : SZ_MIX1;
constexpr size_t WS_END = WS_MIX + SZ_MIX;
static_assert(WS_END <= (size_t)768 * MiB, "workspace map exceeds 768 MiB");
static_assert((size_t)M * D * 2 <= (size_t)NB * SEQ * D * 4, "ABF must fit in d_out");

__device__ __forceinline__ float bf2f(unsigned v) { return __uint_as_float(v << 16); }
__device__ __forceinline__ float bflo(unsigned w) { return __uint_as_float(w << 16); }
__device__ __forceinline__ float bfhi(unsigned w) { return __uint_as_float(w & 0xffff0000u); }
typedef __bf16 bf16x2_t __attribute__((ext_vector_type(2)));
__device__ __forceinline__ unsigned pk2(float lo, float hi) { const f32x2 v = {lo, hi}; const bf16x2_t r = __builtin_convertvector(v, bf16x2_t); return __builtin_bit_cast(unsigned, r); }
__device__ __forceinline__ bf16 f2bf(float f) { return (bf16)(pk2(f, 0.f) & 0xffffu); }
__device__ __forceinline__ int lane_id_opaque() { int l; asm volatile("v_mbcnt_lo_u32_b32 %0, -1, 0\n\tv_mbcnt_hi_u32_b32 %0, -1, %0" : "=v"(l)); return l; }
__device__ __forceinline__ float wave_sum(float v) {
    v += __int_as_float(__builtin_amdgcn_update_dpp(0, __float_as_int(v), 0xB1, 0xF, 0xF, false));
    v += __int_as_float(__builtin_amdgcn_update_dpp(0, __float_as_int(v), 0x4E, 0xF, 0xF, false));
    v += __int_as_float(__builtin_amdgcn_update_dpp(0, __float_as_int(v), 0x141, 0xF, 0xF, false));
    v += __int_as_float(__builtin_amdgcn_update_dpp(0, __float_as_int(v), 0x140, 0xF, 0xF, false));
    const int iv = __float_as_int(v);
    return (__int_as_float(__builtin_amdgcn_readlane(iv, 0)) + __int_as_float(__builtin_amdgcn_readlane(iv, 16))) + (__int_as_float(__builtin_amdgcn_readlane(iv, 32)) + __int_as_float(__builtin_amdgcn_readlane(iv, 48)));
}
__device__ __forceinline__ float quad_sum(float v) {
    v += __int_as_float(__builtin_amdgcn_update_dpp(0, __float_as_int(v), 0xB1, 0xF, 0xF, false));
    v += __int_as_float(__builtin_amdgcn_update_dpp(0, __float_as_int(v), 0x4E, 0xF, 0xF, false));
    return v;
}
__device__ __forceinline__ float row16_sum(float v) {
    v = quad_sum(v);
    v += __int_as_float(__builtin_amdgcn_update_dpp(0, __float_as_int(v), 0x141, 0xF, 0xF, false));
    v += __int_as_float(__builtin_amdgcn_update_dpp(0, __float_as_int(v), 0x140, 0xF, 0xF, false));
    return v;
}
__device__ __forceinline__ float fexp(float x) { return __builtin_amdgcn_exp2f(x * 1.4426950408889634f); }
__device__ __forceinline__ float flog(float x) { return __builtin_amdgcn_logf(x) * 0.6931471805599453f; }
__device__ __forceinline__ float fsigmoid(float x) { return __builtin_amdgcn_rcpf(1.0f + fexp(-x)); }
__device__ __forceinline__ float fsilu(float x) { return x * __builtin_amdgcn_rcpf(1.0f + fexp(-x)); }
__device__ __forceinline__ float flogsigmoid(float x) { return -(fmaxf(-x, 0.f) + flog(1.0f + fexp(-fabsf(x)))); }
__device__ __forceinline__ void unpack8(const u32x4 w, float (&o)[8]) {
    o[0] = bflo(w.x); o[1] = bfhi(w.x); o[2] = bflo(w.y); o[3] = bfhi(w.y); o[4] = bflo(w.z); o[5] = bfhi(w.z); o[6] = bflo(w.w); o[7] = bfhi(w.w);
}
__device__ __forceinline__ u32x4 pack8(const float (&v)[8]) { u32x4 w; w.x = pk2(v[0], v[1]); w.y = pk2(v[2], v[3]); w.z = pk2(v[4], v[5]); w.w = pk2(v[6], v[7]); return w; }

namespace pg8 {
#define PG8_LAS __attribute__((address_space(3)))
typedef unsigned short bf16_t;
constexpr int BM = 256, BK = 64, HALF = 128, HTB = HALF * BK * 2, STAGE_BYTES = 8 * HTB, NXCD = 8, WGM = 4;
__host__ __device__ __forceinline__ int lds_byte(int r, int c) { const int st = (r >> 4) * 2 + (c >> 5), rr = r & 15, cc = c & 31, ob = rr * 64 + cc * 2; return st * 1024 + (ob ^ (((ob >> 9) & 1) << 5)); }
__host__ __device__ __forceinline__ void stage_rc(int b, int& R, int& C) { const int st = b / 1024, sb = b % 1024, swz = sb ^ (((sb >> 9) & 1) << 5); R = (st >> 1) * 16 + swz / 64; C = (st & 1) * 32 + (swz % 64) / 2; }
__host__ __device__ __forceinline__ int perm32(int rho) { const int n = rho >> 4, i = rho & 15; return 8 * (i >> 2) + 4 * n + (i & 3); }

struct Unit { int pm, pn, ko, nk, part; };
struct Gemm { const bf16_t* A; const bf16_t* Bt; int lda, ldb, K; };

struct StaticOrder {
    int nM, nN, nwg, G, c, mode, pn0, ko, nk, S;
    __device__ void init(int nM_, int nN_, int G_, int c_, int mode_, int nk_, int pn0_ = 0, int ko_ = 0, int S_ = 1) { nM = nM_; nN = nN_; nwg = nM * nN; G = G_; c = c_; mode = mode_; pn0 = pn0_; ko = ko_; nk = nk_; S = S_; }
    __device__ bool next(int i, Unit& u) const {
        const long L = (long)i * G + c;
        if (mode == 3 && L >= nwg) {
            const int j = (int)(L - nwg); if (j >= 16 * S) return false;
            const int tile = j / S, part = j % S;
            u.pm = (tile >> 3) ? 17 : 0; u.pn = tile & 7; u.nk = nk / S; u.ko = part * (nk / S) * 64; u.part = part + 1; return true;
        }
        if (L >= nwg) return false;
        int wgid = (int)L; { const int q = nwg / NXCD, r = nwg % NXCD, xcd = wgid % NXCD, off = wgid / NXCD; wgid = (xcd < r ? xcd * (q + 1) : r * (q + 1) + (xcd - r) * q) + off; }
        const int nig = WGM * nN, gid = wgid / nig, fm = gid * WGM, gsz = (nM - fm) < WGM ? (nM - fm) : WGM;
        u.pm = fm + ((wgid % nig) % gsz); u.pn = (wgid % nig) / gsz + pn0; u.ko = ko; u.nk = nk; u.part = 0;
        if (mode == 1 || mode == 3) u.pm = u.pm + 1 + (u.pm >= 16 ? 1 : 0);
        return true;
    }
};

template <class Epi, class Sched, bool ALIGN_EPI = true>
__device__ __forceinline__ void gemm_phase(PG8_LAS unsigned char* lds, const Gemm g, const Sched& S, const Epi& E, const int tid) {
    const int wid = __builtin_amdgcn_readfirstlane(tid >> 6), lane = tid & 63, wr = wid >> 2, wc = wid & 3, fr = lane & 15, fq = lane >> 4;
    unsigned voffA[2], voffB[2];
#pragma unroll
    for (int i = 0; i < 2; ++i) { int R, C; stage_rc(tid * 16 + i * 8192, R, C); const int Rb = Epi::PERM ? ((R & ~31) + perm32(R & 31)) : R;
        voffA[i] = (unsigned)(R * g.lda + C) * 2u; voffB[i] = (unsigned)(Rb * g.ldb + C) * 2u; }
    const size_t kstep = (size_t)(BK * 2);
    const size_t hstepA = (size_t)HALF * g.lda * 2, hstepB = (size_t)HALF * g.ldb * 2;
    const size_t tstepA = 2 * hstepA, tstepB = 2 * hstepB;
    const unsigned ldsw = (unsigned)wid * 1024u;
    const int aoff = lds_byte(wr * 64 + fr, fq * 8), boff = lds_byte(wc * 32 + fr, fq * 8);
#define PG8_SA(b, h) (((b) * 2 + (h)) * HTB)
#define PG8_SB(b, h) ((4 + (b) * 2 + (h)) * HTB)
#define PG8_STAGE(bufoff, gbase, voff) do { _Pragma("unroll") for (int _i = 0; _i < 2; ++_i) \
        __builtin_amdgcn_global_load_lds((const unsigned*)((const char*)(gbase) + (voff)[_i]), (PG8_LAS unsigned*)(lds + (bufoff) + ldsw + _i * 8192), 16, 0, 0); } while (0)
#define PG8_LDA(dst, b, h) do { _Pragma("unroll") for (int m = 0; m < 4; ++m) _Pragma("unroll") for (int k = 0; k < 2; ++k) dst[m][k] = *(const PG8_LAS bf16x8*)(lds + PG8_SA(b, h) + aoff + m * 2048 + k * 1024); } while (0)
#define PG8_LDB(dst, b, h) do { _Pragma("unroll") for (int n = 0; n < 2; ++n) _Pragma("unroll") for (int k = 0; k < 2; ++k) dst[n][k] = *(const PG8_LAS bf16x8*)(lds + PG8_SB(b, h) + boff + n * 2048 + k * 1024); } while (0)
#define PG8_MMA(ai, bj, At, Bt) do { __builtin_amdgcn_s_setprio(1); _Pragma("unroll") for (int m = 0; m < 4; ++m) _Pragma("unroll") for (int n = 0; n < 2; ++n) _Pragma("unroll") for (int k = 0; k < 2; ++k) \
        acc[ai][bj][m][n] = __builtin_amdgcn_mfma_f32_16x16x32_bf16(Bt[n][k], At[m][k], acc[ai][bj][m][n], 0, 0, 0); __builtin_amdgcn_s_setprio(0); } while (0)
#define PG8_WAIT_V(n) asm volatile("s_waitcnt vmcnt(" #n ")" ::: "memory")
#define PG8_WAIT_L(n) asm volatile("s_waitcnt lgkmcnt(" #n ")" ::: "memory")
#define PG8_BAR __builtin_amdgcn_s_barrier()
#define PG8_SCHED __builtin_amdgcn_sched_barrier(0)
    Unit cur, nxt; int ui = 0;
    if (!S.next(0, cur)) return;
    f32x4 acc[2][2][4][2];
#pragma unroll
    for (int a = 0; a < 2; ++a)
#pragma unroll
        for (int b = 0; b < 2; ++b)
#pragma unroll
            for (int m = 0; m < 4; ++m)
#pragma unroll
                for (int n = 0; n < 2; ++n) acc[a][b][m][n] = (f32x4){0.f, 0.f, 0.f, 0.f};
    bf16x8 At[4][2], B0[2][2], B1[2][2];
    const char* cA = (const char*)g.A + (size_t)cur.pm * tstepA + (size_t)cur.ko * 2; const char* cB = (const char*)g.Bt + (size_t)cur.pn * tstepB + (size_t)cur.ko * 2;
    PG8_STAGE(PG8_SB(0, 0), cB, voffB); PG8_STAGE(PG8_SB(0, 1), cB + hstepB, voffB); PG8_STAGE(PG8_SA(0, 0), cA, voffA); PG8_STAGE(PG8_SA(0, 1), cA + hstepA, voffA);
    if (wr == 1) PG8_BAR;
    PG8_WAIT_V(2); PG8_BAR;
    PG8_STAGE(PG8_SB(1, 0), cB + kstep, voffB); PG8_STAGE(PG8_SA(1, 0), cA + kstep, voffA); PG8_STAGE(PG8_SB(1, 1), cB + hstepB + kstep, voffB);
    PG8_WAIT_V(6); PG8_BAR;
    for (;;) {
        const bool has_next = S.next(ui + 1, nxt);
        const char* nA = has_next ? (const char*)g.A + (size_t)nxt.pm * tstepA + (size_t)nxt.ko * 2 : cA; const char* nB = has_next ? (const char*)g.Bt + (size_t)nxt.pn * tstepB + (size_t)nxt.ko * 2 : cB;
        const int nt = cur.nk;
        for (int t = 0; t < nt; t += 2) {
            const bool last = (t == nt - 2);
            const char* a1 = cA + (size_t)(t + 1) * kstep;
            const char* a2 = last ? nA : cA + (size_t)(t + 2) * kstep; const char* b2 = last ? nB : cB + (size_t)(t + 2) * kstep;
            const char* a3 = a2 + kstep; const char* b3 = b2 + kstep;
            PG8_LDB(B0, 0, 0); PG8_LDB(B1, 0, 1); PG8_SCHED; PG8_LDA(At, 0, 0); PG8_STAGE(PG8_SA(1, 1), a1 + hstepA, voffA);
            PG8_WAIT_V(8); PG8_WAIT_L(0); PG8_BAR; PG8_MMA(0, 0, At, B0); PG8_MMA(0, 1, At, B1); PG8_BAR; PG8_SCHED;
            PG8_LDA(At, 0, 1); PG8_STAGE(PG8_SB(0, 0), b2, voffB); PG8_STAGE(PG8_SB(0, 1), b2 + hstepB, voffB); PG8_STAGE(PG8_SA(0, 0), a2, voffA);
            PG8_WAIT_V(8); PG8_WAIT_L(0); PG8_BAR; PG8_MMA(1, 0, At, B0); PG8_MMA(1, 1, At, B1); PG8_BAR; PG8_SCHED;
            PG8_LDB(B0, 1, 0); PG8_LDB(B1, 1, 1); PG8_SCHED; PG8_LDA(At, 1, 0); PG8_STAGE(PG8_SA(0, 1), a2 + hstepA, voffA);
            PG8_WAIT_V(8); PG8_WAIT_L(0); PG8_BAR; PG8_MMA(0, 0, At, B0); PG8_MMA(0, 1, At, B1); PG8_BAR; PG8_SCHED;
            PG8_LDA(At, 1, 1); PG8_STAGE(PG8_SB(1, 0), b3, voffB); PG8_STAGE(PG8_SB(1, 1), b3 + hstepB, voffB); PG8_STAGE(PG8_SA(1, 0), a3, voffA);
            PG8_WAIT_V(8); PG8_WAIT_L(0); PG8_BAR; PG8_MMA(1, 0, At, B0); PG8_MMA(1, 1, At, B1); PG8_BAR; PG8_SCHED;
        }
        if constexpr (ALIGN_EPI) { if (wr == 0) PG8_BAR; }
        if constexpr (!Epi::AFTER_DRAIN) { const int l2 = lane_id_opaque(); E(acc, cur, wr, wc, l2 & 15, l2 >> 4); }
        if (!has_next) break;
#pragma unroll
        for (int a = 0; a < 2; ++a)
#pragma unroll
            for (int b = 0; b < 2; ++b)
#pragma unroll
                for (int m = 0; m < 4; ++m)
#pragma unroll
                    for (int n = 0; n < 2; ++n) acc[a][b][m][n] = (f32x4){0.f, 0.f, 0.f, 0.f};
        cur = nxt; cA = nA; cB = nB; ++ui;
        if constexpr (ALIGN_EPI) { if (wr == 1) PG8_BAR; }
    }
    PG8_WAIT_V(0);
    if constexpr (!ALIGN_EPI) { if (wr == 0) PG8_BAR; }
    PG8_BAR;
    if constexpr (Epi::AFTER_DRAIN) { const int l2 = lane_id_opaque(); E.fused(acc, cur, wr, wc, l2 & 15, l2 >> 4, lds, wid, l2); }
#undef PG8_SA
#undef PG8_SB
#undef PG8_STAGE
#undef PG8_LDA
#undef PG8_LDB
#undef PG8_MMA
#undef PG8_WAIT_V
#undef PG8_WAIT_L
#undef PG8_BAR
#undef PG8_SCHED
}

struct EpiF32 {
    static constexpr bool PERM = true, AFTER_DRAIN = false;
    bf16_t* C; int ldc; float* YC;
    __device__ __forceinline__ void operator()(const f32x4 (&acc)[2][2][4][2], const Unit& u, int wr, int wc, int fr, int fq) const {
        const int col0 = u.pn * BM + wc * 32 + 8 * fq;
        if (u.part) {
            const int row0 = (u.pm ? CTX : 0) + wr * 64 + fr; float* slab = YC + (size_t)(u.part - 1) * NB * CTX * ldc;
#pragma unroll
            for (int ai = 0; ai < 2; ++ai)
#pragma unroll
                for (int m = 0; m < 4; ++m) { float* rowp = slab + (size_t)(row0 + ai * HALF + m * 16) * ldc + col0;
#pragma unroll
                    for (int bj = 0; bj < 2; ++bj)
#pragma unroll
                        for (int n = 0; n < 2; ++n) *(f32x4*)(rowp + bj * HALF + 4 * n) = acc[ai][bj][m][n]; }
        } else {
            const int row0 = u.pm * BM + wr * 64 + fr;
#pragma unroll
            for (int ai = 0; ai < 2; ++ai)
#pragma unroll
                for (int m = 0; m < 4; ++m) { bf16_t* rowp = C + (size_t)(row0 + ai * HALF + m * 16) * ldc + col0;
#pragma unroll
                    for (int bj = 0; bj < 2; ++bj) { const f32x4 v0 = acc[ai][bj][m][0], v1 = acc[ai][bj][m][1];
                        u32x4 w; w.x = pk2(v0[0], v0[1]); w.y = pk2(v0[2], v0[3]); w.z = pk2(v1[0], v1[1]); w.w = pk2(v1[2], v1[3]);
                        *(u32x4*)(rowp + bj * HALF) = w; } }
        }
    }
};
struct EpiBf16 {
    static constexpr bool PERM = true, AFTER_DRAIN = false;
    bf16_t* O; int ldc; int coff;
    __device__ __forceinline__ void operator()(const f32x4 (&acc)[2][2][4][2], const Unit& u, int wr, int wc, int fr, int fq) const {
        const int row0 = u.pm * BM + wr * 64 + fr, col0 = u.pn * BM - coff + wc * 32 + 8 * fq;
#pragma unroll
        for (int ai = 0; ai < 2; ++ai)
#pragma unroll
            for (int m = 0; m < 4; ++m) { bf16_t* rowp = O + (size_t)(row0 + ai * HALF + m * 16) * ldc + col0;
#pragma unroll
                for (int bj = 0; bj < 2; ++bj) { const f32x4 v0 = acc[ai][bj][m][0], v1 = acc[ai][bj][m][1];
                    u32x4 w; w.x = pk2(v0[0], v0[1]); w.y = pk2(v0[2], v0[3]); w.z = pk2(v1[0], v1[1]); w.w = pk2(v1[2], v1[3]);
                    *(u32x4*)(rowp + bj * HALF) = w; } }
    }
};
struct EpiSwiglu {
    static constexpr bool PERM = true, AFTER_DRAIN = false;
    bf16_t* O; int ldc;
    __device__ __forceinline__ void operator()(const f32x4 (&acc)[2][2][4][2], const Unit& u, int wr, int wc, int fr, int fq) const {
        const int row0 = u.pm * BM + wr * 64 + fr, col0 = u.pn * HALF + wc * 32 + 8 * fq;
#pragma unroll
        for (int ai = 0; ai < 2; ++ai)
#pragma unroll
            for (int m = 0; m < 4; ++m) { bf16_t* rowp = O + (size_t)(row0 + ai * HALF + m * 16) * ldc + col0;
                float o[8];
#pragma unroll
                for (int n = 0; n < 2; ++n)
#pragma unroll
                    for (int j = 0; j < 4; ++j) { const float gt = acc[ai][0][m][n][j], up = acc[ai][1][m][n][j]; o[4 * n + j] = fsilu(gt) * up; }
                *(u32x4*)rowp = pack8(o); }
    }
};
struct EpiDec {
    static constexpr bool PERM = true, AFTER_DRAIN = false;
    float* DEC; const float* w0;
    __device__ __forceinline__ void operator()(const f32x4 (&acc)[2][2][4][2], const Unit& u, int wr, int wc, int fr, int fq) const {
        const int row0 = u.pm * BM + wr * 64 + fr; const int seg = u.pn >> 2; const int cs0 = (u.pn & 3) * BM + wc * 32 + 8 * fq;
        float* dbase = DEC + (size_t)seg * M * MIXA;
#pragma unroll
        for (int bj = 0; bj < 2; ++bj) { const int cs = cs0 + bj * HALF;
            const f32x4 wa = *(const f32x4*)(w0 + seg * MIXA + cs), wb = *(const f32x4*)(w0 + seg * MIXA + cs + 4);
#pragma unroll
            for (int ai = 0; ai < 2; ++ai)
#pragma unroll
                for (int m = 0; m < 4; ++m) { float* dp = dbase + (size_t)(row0 + ai * HALF + m * 16) * MIXA + cs;
                    f32x4 o0, o1;
#pragma unroll
                    for (int j = 0; j < 4; ++j) {
                        const float x0 = acc[ai][bj][m][0][j] + wa[j], x1 = acc[ai][bj][m][1][j] + wb[j];
                        o0[j] = -0.6065306597126334f * fsigmoid(x0); o1[j] = -0.6065306597126334f * fsigmoid(x1); }
                    *(f32x4*)dp = o0; *(f32x4*)(dp + 4) = o1; } }
    }
};
struct EpiLr {
    static constexpr bool PERM = true, AFTER_DRAIN = false;
    bf16_t* KM; const bf16_t* KKp; bf16_t* BV; const float* a0; const float* ka;
    __device__ __forceinline__ void operator()(const f32x4 (&acc)[2][2][4][2], const Unit& u, int wr, int wc, int fr, int fq) const {
        const int row0 = u.pm * BM + wr * 64 + fr; const int cs0 = (u.pn & 3) * BM + wc * 32 + 8 * fq;
#pragma unroll
        for (int bj = 0; bj < 2; ++bj)
#pragma unroll
            for (int n = 0; n < 2; ++n) { const int cs = cs0 + bj * HALF + 4 * n;
                const f32x4 aa = *(const f32x4*)(a0 + cs), kav = *(const f32x4*)(ka + cs);
                u32x2 kws[2][4], qws[2][4];
#pragma unroll
                for (int ai = 0; ai < 2; ++ai)
#pragma unroll
                    for (int m = 0; m < 4; ++m) { const size_t off = (size_t)(row0 + ai * HALF + m * 16) * MIXA + cs; kws[ai][m] = *(const u32x2*)(KM + off); qws[ai][m] = *(const u32x2*)(KKp + off); }
#pragma unroll
                for (int ai = 0; ai < 2; ++ai)
#pragma unroll
                    for (int m = 0; m < 4; ++m) { const size_t off = (size_t)(row0 + ai * HALF + m * 16) * MIXA + cs;
                        const u32x2 kw = kws[ai][m], qw = qws[ai][m];
                        const float kv[4] = {bflo(kw.x), bfhi(kw.x), bflo(kw.y), bfhi(kw.y)}, kk[4] = {bflo(qw.x), bfhi(qw.x), bflo(qw.y), bfhi(qw.y)};
                        float km[4], bv[4];
#pragma unroll
                        for (int j = 0; j < 4; ++j) { const float lr = fsigmoid(acc[ai][bj][m][n][j] + aa[j]);
                            km[j] = kv[j] * (1.0f + (lr - 1.0f) * kav[j]); bv[j] = kk[j] * lr; }
                        u32x2 o1, o2; o1.x = pk2(km[0], km[1]); o1.y = pk2(km[2], km[3]); o2.x = pk2(bv[0], bv[1]); o2.y = pk2(bv[2], bv[3]);
                        *(u32x2*)(KM + off) = o1; *(u32x2*)(BV + off) = o2; } }
    }
};
struct EpiRet {
    static constexpr bool PERM = true, AFTER_DRAIN = false;
    bf16_t* O; int ldc; const float* rot;
    __device__ __forceinline__ void operator()(const f32x4 (&acc)[2][2][4][2], const Unit& u, int wr, int wc, int fr, int fq) const {
        const int row0 = u.pm * BM + wr * 64 + fr, col0 = u.pn * BM + wc * 32 + 8 * fq;
        const bool qk = u.pn < 16; const float sc = (u.pn >= 8 && u.pn < 16) ? 0.0625f : 1.0f;
        const int f0 = (wc * 32 + 8 * fq) & 63; const bool use_row = wc < 2;
#pragma unroll
        for (int ai = 0; ai < 2; ++ai)
#pragma unroll
            for (int m = 0; m < 4; ++m) { const int row = row0 + ai * HALF + m * 16; bf16_t* rowp = O + (size_t)row * ldc + col0;
                float o0[8], o1[8];
#pragma unroll
                for (int n = 0; n < 2; ++n)
#pragma unroll
                    for (int j = 0; j < 4; ++j) { o0[4 * n + j] = acc[ai][0][m][n][j]; o1[4 * n + j] = acc[ai][1][m][n][j]; }
                const int t = row % TB;
                if (qk) {
                    if (t >= CTX) { const int s = t - CTX; const int pos = use_row ? (s >> 6) : (s & 63); const f32x4* rp = (const f32x4*)(rot + ((size_t)pos * 64 + f0) * 2);
#pragma unroll
                        for (int i = 0; i < 4; ++i) { const f32x4 cs = rp[i];
                            const float a0 = o0[2 * i], b0 = o1[2 * i], a1 = o0[2 * i + 1], b1 = o1[2 * i + 1];
                            o0[2 * i] = a0 * cs[0] - b0 * cs[1]; o1[2 * i] = a0 * cs[1] + b0 * cs[0];
                            o0[2 * i + 1] = a1 * cs[2] - b1 * cs[3]; o1[2 * i + 1] = a1 * cs[3] + b1 * cs[2]; } }
#pragma unroll
                    for (int i = 0; i < 8; ++i) { o0[i] *= sc; o1[i] *= sc; }
                }
                *(u32x4*)rowp = pack8(o0); *(u32x4*)(rowp + HALF) = pack8(o1); }
    }
};
struct NormX {
    float* xbuf;
    unsigned* cnt;
    unsigned* tmo;
    __device__ __forceinline__ void publish(const float (&ss)[2][4], const Unit& u, int wr, int wc, int fr, int fq, PG8_LAS unsigned char* lds, int wid, int lane) const {
        PG8_LAS float* P = (PG8_LAS float*)lds;
#pragma unroll
        for (int ai = 0; ai < 2; ++ai)
#pragma unroll
            for (int m = 0; m < 4; ++m) { float q = ss[ai][m]; q += __shfl_xor(q, 16); q += __shfl_xor(q, 32);
                if (fq == 0) P[(ai * HALF + wr * 64 + m * 16 + fr) * 4 + wc] = q; }
        asm volatile("s_waitcnt lgkmcnt(0)" ::: "memory"); __builtin_amdgcn_s_barrier(); asm volatile("" ::: "memory");
        const int row = wid * 32 + (lane & 31);
        if (lane < 32) { const f32x4 pq = *(const PG8_LAS f32x4*)(P + row * 4); const float tot = (pq[0] + pq[1]) + (pq[2] + pq[3]);
            __hip_atomic_store((unsigned*)xbuf + ((size_t)(u.pm * BM + row) * 8 + u.pn), __float_as_uint(tot), __ATOMIC_RELAXED, __HIP_MEMORY_SCOPE_AGENT); }
        asm volatile("s_waitcnt vmcnt(0)" ::: "memory");
        if (lane == 0) __hip_atomic_fetch_add(cnt + 64 * u.pm, 1u, __ATOMIC_RELAXED, __HIP_MEMORY_SCOPE_AGENT);
    }
    __device__ __forceinline__ void finish(const Unit& u, PG8_LAS unsigned char* lds, int wid, int lane) const {
        PG8_LAS float* S = (PG8_LAS float*)(lds + 4096);
        const int row = wid * 32 + (lane & 31);
        if (wid == 0) {
            unsigned sp = 0u;
            while ((unsigned)__builtin_amdgcn_readfirstlane((int)__hip_atomic_load(cnt + 64 * u.pm, __ATOMIC_RELAXED, __HIP_MEMORY_SCOPE_AGENT)) < 64u) {
                __builtin_amdgcn_s_sleep(1);
                if ((++sp & 255u) == 0u) { if (__hip_atomic_load(tmo, __ATOMIC_RELAXED, __HIP_MEMORY_SCOPE_AGENT)) break; if (sp > (1u << 20)) { if (lane == 0) atomicAdd(tmo, 1u); break; } } }
        }
        asm volatile("s_waitcnt vmcnt(0) lgkmcnt(0)" ::: "memory"); __builtin_amdgcn_s_barrier(); asm volatile("" ::: "memory");
        if (lane < 32) { const unsigned* slot = (const unsigned*)xbuf + (size_t)(u.pm * BM + row) * 8; float q = 0.f;
#pragma unroll
            for (int t = 0; t < 8; ++t) q += __uint_as_float(__hip_atomic_load(slot + t, __ATOMIC_RELAXED, __HIP_MEMORY_SCOPE_AGENT));
            S[row] = rsqrtf(q * (1.0f / 2048.0f) + 1e-6f); }
        asm volatile("s_waitcnt lgkmcnt(0)" ::: "memory"); __builtin_amdgcn_s_barrier(); asm volatile("" ::: "memory");
    }
};
struct EpiNorm {
    static constexpr bool PERM = true, AFTER_DRAIN = true;
    bf16_t* H; bf16_t* ABF; float* OUT; const float* gatev; const float* ngy; const float* ngn; const float* shiftv; const float* scalev; bool fin; NormX x1, x2;
    __device__ __forceinline__ void operator()(const f32x4 (&)[2][2][4][2], const Unit&, int, int, int, int) const {}
    __device__ __forceinline__ void fused(f32x4 (&acc)[2][2][4][2], const Unit& u, int wr, int wc, int fr, int fq, PG8_LAS unsigned char* lds, int wid, int lane) const {
        const PG8_LAS float* S = (const PG8_LAS float*)(lds + 4096);
        const int b = u.pm / 17, col0 = u.pn * BM + wc * 32 + 8 * fq;
        float ss[2][4];
#pragma unroll
        for (int ai = 0; ai < 2; ++ai)
#pragma unroll
            for (int m = 0; m < 4; ++m) { float q = 0.f;
#pragma unroll
                for (int bj = 0; bj < 2; ++bj)
#pragma unroll
                    for (int n = 0; n < 2; ++n) { const f32x4 x = acc[ai][bj][m][n]; q += (x[0] * x[0] + x[1] * x[1]) + (x[2] * x[2] + x[3] * x[3]); }
                ss[ai][m] = q; }
        x1.publish(ss, u, wr, wc, fr, fq, lds, wid, lane);
        u32x4 hw[2][4][2];
#pragma unroll
        for (int ai = 0; ai < 2; ++ai)
#pragma unroll
            for (int m = 0; m < 4; ++m)
#pragma unroll
                for (int bj = 0; bj < 2; ++bj) hw[ai][m][bj] = *(const u32x4*)(H + ((size_t)u.pm * BM + ai * HALF + wr * 64 + m * 16 + fr) * D + col0 + bj * HALF);
        f32x4 gy[2][2];
#pragma unroll
        for (int bj = 0; bj < 2; ++bj)
#pragma unroll
            for (int n = 0; n < 2; ++n) { const int c = col0 + bj * HALF + 4 * n; gy[bj][n] = *(const f32x4*)(gatev + (size_t)b * 12288 + c) * *(const f32x4*)(ngy + c); }
        x1.finish(u, lds, wid, lane);
        {
#pragma unroll
            for (int ai = 0; ai < 2; ++ai)
#pragma unroll
                for (int m = 0; m < 4; ++m) { const int r = ai * HALF + wr * 64 + m * 16 + fr; const float rs = S[r]; const size_t grow = (size_t)u.pm * BM + r;
#pragma unroll
                    for (int bj = 0; bj < 2; ++bj) { const u32x4 hq = hw[ai][m][bj];
                        f32x4 h0 = {bflo(hq.x), bfhi(hq.x), bflo(hq.y), bfhi(hq.y)}, h1 = {bflo(hq.z), bfhi(hq.z), bflo(hq.w), bfhi(hq.w)};
                        h0 += gy[bj][0] * (acc[ai][bj][m][0] * rs); h1 += gy[bj][1] * (acc[ai][bj][m][1] * rs);
                        if (fin) { float* o = OUT + ((size_t)b * SEQ + ((u.pm % 17) * BM + r - CTX)) * D + col0 + bj * HALF; *(f32x4*)o = h0; *(f32x4*)(o + 4) = h1; }
                        else { u32x4 w; w.x = pk2(h0[0], h0[1]); w.y = pk2(h0[2], h0[3]); w.z = pk2(h1[0], h1[1]); w.w = pk2(h1[2], h1[3]);
                            *(u32x4*)(H + grow * D + col0 + bj * HALF) = w;
                            acc[ai][bj][m][0] = (f32x4){bflo(w.x), bfhi(w.x), bflo(w.y), bfhi(w.y)}; acc[ai][bj][m][1] = (f32x4){bflo(w.z), bfhi(w.z), bflo(w.w), bfhi(w.w)}; } } }
        }
        if (fin) return;
#pragma unroll
        for (int ai = 0; ai < 2; ++ai)
#pragma unroll
            for (int m = 0; m < 4; ++m) { float q = 0.f;
#pragma unroll
                for (int bj = 0; bj < 2; ++bj)
#pragma unroll
                    for (int n = 0; n < 2; ++n) { const f32x4 x = acc[ai][bj][m][n]; q += (x[0] * x[0] + x[1] * x[1]) + (x[2] * x[2] + x[3] * x[3]); }
                ss[ai][m] = q; }
        x2.publish(ss, u, wr, wc, fr, fq, lds, wid, lane);
        f32x4 an[2][2], sh[2][2];
#pragma unroll
        for (int bj = 0; bj < 2; ++bj)
#pragma unroll
            for (int n = 0; n < 2; ++n) { const int c = col0 + bj * HALF + 4 * n;
                an[bj][n] = *(const f32x4*)(ngn + c) * (*(const f32x4*)(scalev + (size_t)b * 12288 + c) + 1.0f); sh[bj][n] = *(const f32x4*)(shiftv + (size_t)b * 12288 + c); }
        x2.finish(u, lds, wid, lane);
        {
#pragma unroll
            for (int ai = 0; ai < 2; ++ai)
#pragma unroll
                for (int m = 0; m < 4; ++m) { const int r = ai * HALF + wr * 64 + m * 16 + fr; const float rs = S[r]; const size_t grow = (size_t)u.pm * BM + r;
#pragma unroll
                    for (int bj = 0; bj < 2; ++bj) { const f32x4 o0 = (acc[ai][bj][m][0] * rs) * an[bj][0] + sh[bj][0], o1 = (acc[ai][bj][m][1] * rs) * an[bj][1] + sh[bj][1];
                        u32x4 w; w.x = pk2(o0[0], o0[1]); w.y = pk2(o0[2], o0[3]); w.z = pk2(o1[0], o1[1]); w.w = pk2(o1[2], o1[3]);
                        *(u32x4*)(ABF + grow * D + col0 + bj * HALF) = w; } }
        }
    }
};
}

#define XB_TMO      128
#define XB_XCNT(j)  (256  + 64 * (j))
#define XB_XSUB(j)  (1280 + 64 * (j))
#define XB_XGEN(j)  (2304 + 64 * (j))
#define XB_TOP      3328
#define XB_TOPGEN   3392
#define XCD_BAR_WORDS 3456
#define XB_SPIN_CAP (1u << 20)
__device__ __forceinline__ unsigned xb_ld(unsigned* p)              { return __hip_atomic_load(p, __ATOMIC_RELAXED, __HIP_MEMORY_SCOPE_AGENT); }
__device__ __forceinline__ unsigned xb_add(unsigned* p, unsigned v) { return __hip_atomic_fetch_add(p, v, __ATOMIC_RELAXED, __HIP_MEMORY_SCOPE_AGENT); }
__device__ __forceinline__ unsigned xb_xcc_id() { return (unsigned)__builtin_amdgcn_s_getreg((3 << 11) | 20) & 0xFu; }
#define XB_SPIN(cond, bar) do { unsigned _sp = 0; while (cond) { __builtin_amdgcn_s_sleep(1); \
    if ((++_sp & 255u) == 0u) { if (xb_ld(&(bar)[XB_TMO])) break; if (_sp > XB_SPIN_CAP) { atomicAdd(&(bar)[XB_TMO], 1u); break; } } } } while (0)
struct XcdBarrier { unsigned* bar; unsigned x; volatile LAS unsigned* st; };
__device__ __forceinline__ XcdBarrier xcd_barrier_post(unsigned* bar, volatile LAS unsigned* st) {
    XcdBarrier b; b.bar = bar; b.x = xb_xcc_id(); b.st = st;
    if (threadIdx.x == 0) (void)xb_add(&bar[XB_XCNT(b.x)], 1u);
    return b;
}
__device__ __forceinline__ void xcd_barrier_complete(unsigned* bar, unsigned x, unsigned& nloc, unsigned& nx) {
    const unsigned G = gridDim.x * gridDim.y * gridDim.z;
    unsigned sum, cnt, mine, sp = 0u;
    for (;;) {
        sum = 0u; cnt = 0u; mine = 0u;
#pragma unroll
        for (unsigned j = 0; j < 16; ++j) { const unsigned c = xb_ld(&bar[XB_XCNT(j)]); sum += c; cnt += (c > 0u) ? 1u : 0u; mine = (j == x) ? c : mine; }
        if (sum == G) break;
        __builtin_amdgcn_s_sleep(1);
        if ((++sp & 255u) == 0u) { if (xb_ld(&bar[XB_TMO])) break; if (sp > XB_SPIN_CAP) { atomicAdd(&bar[XB_TMO], 1u); break; } }
    }
    nloc = mine > 0u ? mine : 1u; nx = cnt > 0u ? cnt : 1u;
}
__device__ __forceinline__ void xcd_barrier(const XcdBarrier& b) {
    asm volatile("s_waitcnt vmcnt(0)" ::: "memory");
    __syncthreads();
    if (threadIdx.x == 0) {
        unsigned* bar = b.bar;
        __builtin_amdgcn_s_waitcnt(0);
        unsigned nloc = b.st[0], nx = b.st[1];
        if (nloc == 0u) { xcd_barrier_complete(bar, b.x, nloc, nx); b.st[0] = nloc; b.st[1] = nx; }
        const unsigned old = xb_add(&bar[XB_XSUB(b.x)], 1u);
        const unsigned gen = old / nloc;
        if (old + 1u == (gen + 1u) * nloc) {
            __builtin_amdgcn_fence(__ATOMIC_RELEASE, "agent");
            asm volatile("s_waitcnt vmcnt(0)" ::: "memory");
            __builtin_amdgcn_fence(__ATOMIC_ACQUIRE, "agent");
            const unsigned og = xb_add(&bar[XB_TOP], 1u);
            const unsigned tg = og / nx;
            if (og + 1u == (tg + 1u) * nx) xb_add(&bar[XB_TOPGEN], 1u);
            else XB_SPIN(xb_ld(&bar[XB_TOPGEN]) == tg, bar);
            xb_add(&bar[XB_XGEN(b.x)], 1u);
            asm volatile("s_waitcnt vmcnt(0)" ::: "memory");
        } else {
            __builtin_amdgcn_fence(__ATOMIC_ACQUIRE, "agent");
            XB_SPIN(xb_ld(&bar[XB_XGEN(b.x)]) == gen, bar);
            asm volatile("s_waitcnt vmcnt(0)" ::: "memory");
        }
    }
    __syncthreads();
}

struct Args {
    const float* in[27];
    float* out; unsigned char* ws;
    int ph_lo, ph_hi;
};
enum { I_X = 0, I_C, I_CTX, I_CCTX, I_MODW, I_MODB, I_NG, I_FWI, I_FWO, I_ABWI, I_ABWO, I_MU, I_W0, I_W2, I_A0, I_A2, I_G2, I_KK, I_KA, I_RK, I_LNW, I_LNB, I_GKUP, I_GKB, I_GLAG, I_RWI, I_RWO };

struct Fr {
    LAS unsigned char* lds; int tid, lane, wave, vcu, G;
};

__device__ __forceinline__ int dst_row(int n, int mode) {
    if (mode == 0) return n;
    return n < DFF ? 256 * (n / 128) + (n % 128) : 256 * ((n - DFF) / 128) + 128 + ((n - DFF) % 128);
}
__device__ __forceinline__ void conv_job(const Fr& F, const float* W, int K, int N, int Npad, bf16* WT, int mode, int wgi, int nWG) {
    LAS float* scr = (LAS float*)F.lds;
    const int tid = F.tid, ntn = Npad / 128, nitems = (K / 128) * ntn;
    const int lr = tid >> 5, lc = 4 * (tid & 31);
    f32x4 reg[8];
    int it = wgi;
    if (it < nitems) { const int k0 = (it / ntn) * 128, n0 = (it % ntn) * 128;
#pragma unroll
        for (int i = 0; i < 8; ++i) reg[i] = (n0 + lc < N) ? __builtin_nontemporal_load((const f32x4*)(W + (size_t)(k0 + lr + 16 * i) * N + n0 + lc)) : (f32x4){0.f, 0.f, 0.f, 0.f}; }
    while (it < nitems) {
        const int k0 = (it / ntn) * 128, n0 = (it % ntn) * 128;
#pragma unroll
        for (int i = 0; i < 8; ++i) *(LAS f32x4*)(scr + (lr + 16 * i) * 132 + lc) = reg[i];
        __syncthreads();
        const int nxt = it + nWG;
        if (nxt < nitems) { const int k1 = (nxt / ntn) * 128, n1 = (nxt % ntn) * 128;
#pragma unroll
            for (int i = 0; i < 8; ++i) reg[i] = (n1 + lc < N) ? __builtin_nontemporal_load((const f32x4*)(W + (size_t)(k1 + lr + 16 * i) * N + n1 + lc)) : (f32x4){0.f, 0.f, 0.f, 0.f}; }
        { const int c = tid & 15;
#pragma unroll
          for (int j = 0; j < 4; ++j) { const int n = (tid >> 4) + 32 * j; const LAS float* sp = scr + (8 * c) * 132 + n;
              u32x4 o; o.x = pk2(sp[0], sp[132]); o.y = pk2(sp[2 * 132], sp[3 * 132]); o.z = pk2(sp[4 * 132], sp[5 * 132]); o.w = pk2(sp[6 * 132], sp[7 * 132]);
              __builtin_nontemporal_store(o, (u32x4*)(WT + (size_t)dst_row(n0 + n, mode) * K + k0 + 8 * c)); } }
        __syncthreads();
        it = nxt;
    }
}
struct ConvJob { const float* W; bf16* WT; int K, N, Npad, mode; };
__device__ __forceinline__ void conv_jobs(const Fr& F, const Args& a, int jlo, int jhi, int wgi, int nWG) {
    unsigned char* ws = a.ws;
    ConvJob jobs[8];
    jobs[0] = {a.in[I_ABWI], (bf16*)(ws + WS_WAB), D, ABCOLS, ZLD0, 0};
    jobs[1] = {a.in[I_ABWO], (bf16*)(ws + WS_WO0), D, D, D, 0};
    jobs[2] = {a.in[I_FWI], (bf16*)(ws + WS_WFI0), D, 2 * DFF, 2 * DFF, 1};
    jobs[3] = {a.in[I_FWO], (bf16*)(ws + WS_WFO0), DFF, D, D, 0};
    jobs[4] = {a.in[I_RWI], (bf16*)(ws + WS_WRI), D, RETC, RETC, 0};
    jobs[5] = {a.in[I_RWO], (bf16*)(ws + WS_WRO), 2 * D, D, D, 0};
    jobs[6] = {a.in[I_FWI] + (size_t)D * 2 * DFF, (bf16*)(ws + WS_WFI1), D, 2 * DFF, 2 * DFF, 1};
    jobs[7] = {a.in[I_FWO] + (size_t)DFF * D, (bf16*)(ws + WS_WFO1), DFF, D, D, 0};
#pragma unroll
    for (int j = 0; j < 8; ++j) {
        if (j < jlo || j >= jhi) continue;
        conv_job(F, jobs[j].W, jobs[j].K, jobs[j].N, jobs[j].Npad, jobs[j].WT, jobs[j].mode, wgi, nWG);
    }
}
__device__ __forceinline__ void conv_dyn(const Fr& F, const Args& a, unsigned* qhead, int jlo, int jhi) {
    unsigned char* ws = a.ws;
    LAS float* scr = (LAS float*)F.lds; volatile LAS int* slot = (volatile LAS int*)(F.lds + 128 * 132 * 4);
    const int tid = F.tid, lr = tid >> 5, lc = 4 * (tid & 31);
    constexpr int NT[8] = {(D / 128) * (ZLD0 / 128), (D / 128) * (D / 128), (D / 128) * (2 * DFF / 128), (DFF / 128) * (D / 128), (D / 128) * (RETC / 128), (2 * D / 128) * (D / 128), (D / 128) * (2 * DFF / 128), (DFF / 128) * (D / 128)};
    int total = 0;
#pragma unroll
    for (int j = 0; j < 8; ++j) if (j >= jlo && j < jhi) total += NT[j];
    const float* W = nullptr; bf16* WT = nullptr; int K = 0, N = 0, Np = 0, mode = 0, k0 = 0, n0 = 0;
    auto decode = [&](int it) {
        int li = it, job = jlo;
#pragma unroll
        for (int j = 0; j < 8; ++j) if (j >= jlo && j < jhi - 1 && job == j && li >= NT[j]) { li -= NT[j]; job = j + 1; }
        switch (job) {
            case 0: W = a.in[I_ABWI]; WT = (bf16*)(ws + WS_WAB); K = D; N = ABCOLS; Np = ZLD0; mode = 0; break;
            case 1: W = a.in[I_ABWO]; WT = (bf16*)(ws + WS_WO0); K = D; N = D; Np = D; mode = 0; break;
            case 2: W = a.in[I_FWI]; WT = (bf16*)(ws + WS_WFI0); K = D; N = 2 * DFF; Np = 2 * DFF; mode = 1; break;
            case 3: W = a.in[I_FWO]; WT = (bf16*)(ws + WS_WFO0); K = DFF; N = D; Np = D; mode = 0; break;
            case 4: W = a.in[I_RWI]; WT = (bf16*)(ws + WS_WRI); K = D; N = RETC; Np = RETC; mode = 0; break;
            case 5: W = a.in[I_RWO]; WT = (bf16*)(ws + WS_WRO); K = 2 * D; N = D; Np = D; mode = 0; break;
            case 6: W = a.in[I_FWI] + (size_t)D * 2 * DFF; WT = (bf16*)(ws + WS_WFI1); K = D; N = 2 * DFF; Np = 2 * DFF; mode = 1; break;
            default: W = a.in[I_FWO] + (size_t)DFF * D; WT = (bf16*)(ws + WS_WFO1); K = DFF; N = D; Np = D; mode = 0; break;
        }
        const int ntn = Np / 128; k0 = (li / ntn) * 128; n0 = (li % ntn) * 128; };
    f32x4 reg[8];
    if (tid == 0) slot[0] = (int)atomicAdd(qhead, 1u);
    __syncthreads();
    int cur = slot[0];
    __syncthreads();
    if (cur < total) { decode(cur);
#pragma unroll
        for (int i = 0; i < 8; ++i) reg[i] = (n0 + lc < N) ? __builtin_nontemporal_load((const f32x4*)(W + (size_t)(k0 + lr + 16 * i) * N + n0 + lc)) : (f32x4){0.f, 0.f, 0.f, 0.f}; }
    while (cur < total) {
        const int ck0 = k0, cn0 = n0, cK = K, cmode = mode; bf16* cWT = WT;
#pragma unroll
        for (int i = 0; i < 8; ++i) *(LAS f32x4*)(scr + (lr + 16 * i) * 132 + lc) = reg[i];
        if (tid == 0) slot[0] = (int)atomicAdd(qhead, 1u);
        __syncthreads();
        const int nxt = slot[0];
        if (nxt < total) { decode(nxt);
#pragma unroll
            for (int i = 0; i < 8; ++i) reg[i] = (n0 + lc < N) ? __builtin_nontemporal_load((const f32x4*)(W + (size_t)(k0 + lr + 16 * i) * N + n0 + lc)) : (f32x4){0.f, 0.f, 0.f, 0.f}; }
        { const int c = tid & 15;
#pragma unroll
          for (int j = 0; j < 4; ++j) { const int n = (tid >> 4) + 32 * j; const LAS float* sp = scr + (8 * c) * 132 + n;
              u32x4 o; o.x = pk2(sp[0], sp[132]); o.y = pk2(sp[2 * 132], sp[3 * 132]); o.z = pk2(sp[4 * 132], sp[5 * 132]); o.w = pk2(sp[6 * 132], sp[7 * 132]);
              __builtin_nontemporal_store(o, (u32x4*)(cWT + (size_t)dst_row(cn0 + n, cmode) * cK + ck0 + 8 * c)); } }
        __syncthreads();
        cur = nxt;
    }
}
__device__ __forceinline__ void p0_prologue(const Fr& F, const Args& a) {
    unsigned char* ws = a.ws;
    conv_jobs(F, a, 0, 1, F.vcu, F.G);
    {
        bf16* WL = (bf16*)(ws + WS_WLO); const float* w2 = a.in[I_W2]; const float* a2 = a.in[I_A2]; const float* g2 = a.in[I_G2];
        for (int idx = F.vcu * NTHR + F.tid; idx < 4096 * 64; idx += F.G * NTHR) {
            const int n = idx & 4095, k0 = (idx >> 12) * 8;
            const int seg = n >> 10, c = n & 1023; float v[8];
#pragma unroll
            for (int j = 0; j < 8; ++j) { const int k = k0 + j; float x = 0.f;
                if (seg < 2) { if (k < 96) x = w2[((size_t)seg * 96 + k) * MIXA + c]; }
                else if (seg == 2) { if (k >= 128 && k < 224) x = a2[(size_t)(k - 128) * MIXA + c]; }
                else { if (k >= 256) x = g2[(size_t)(k - 256) * MIXA + c]; }
                v[j] = x; }
            *(u32x4*)(WL + (size_t)n * 512 + k0) = pack8(v);
        }
    }
    {
        float* rot = (float*)(ws + WS_ROT);
        for (int idx = F.vcu * NTHR + F.tid; idx < 4096; idx += F.G * NTHR) {
            const int pos = idx >> 6, f = idx & 63;
            const float inv = exp2f(-(float)f * (13.287712379549449f / 64.0f));
            const float rev = (float)pos * inv * 0.15915494309189535f;
            rot[2 * idx] = __builtin_amdgcn_cosf(rev); rot[2 * idx + 1] = __builtin_amdgcn_sinf(rev);
        }
    }
    {
        LAS float* sv = (LAS float*)F.lds;
        LAS float* red = sv + 3 * 2048;
        { float xs[12];
#pragma unroll
          for (int it = 0; it < 12; ++it) { const int i = F.tid + it * NTHR; const int w = it >> 2, k = i & 2047; xs[it] = (w < 2) ? a.in[I_C][w * D + k] : a.in[I_CCTX][k]; }
#pragma unroll
          for (int it = 0; it < 12; ++it) sv[F.tid + it * NTHR] = fsilu(xs[it]); }
        __syncthreads();
        float* modv = (float*)(ws + WS_MODV);
        for (int slab = F.vcu; slab < 256; slab += F.G) {
            const int l = slab >> 7, col0 = (slab & 127) * 96;
            const float* Wm = a.in[I_MODW] + (size_t)l * D * 12288;
            const int cq = F.tid % 24, kg = F.tid / 24;
            f32x4 a0 = {0, 0, 0, 0}, a1 = {0, 0, 0, 0}, a2v = {0, 0, 0, 0};
            if (kg < 21) {
#pragma unroll 1
                for (int i0 = 0; i0 < 98; i0 += 7) { f32x4 wv[7];
#pragma unroll
                    for (int j = 0; j < 7; ++j) { const int k = kg + 21 * (i0 + j), kc = k < D ? k : D - 1;
                        wv[j] = __builtin_nontemporal_load((const f32x4*)(Wm + (size_t)kc * 12288 + col0 + 4 * cq)); }
#pragma unroll
                    for (int j = 0; j < 7; ++j) { const int k = kg + 21 * (i0 + j), kc = k < D ? k : D - 1; const float z = k < D ? 1.0f : 0.0f;
                        a0 += wv[j] * (sv[kc] * z); a1 += wv[j] * (sv[2048 + kc] * z); a2v += wv[j] * (sv[4096 + kc] * z); } }
#pragma unroll
                for (int j = 0; j < 4; ++j) { red[(kg * 3 + 0) * 96 + 4 * cq + j] = a0[j]; red[(kg * 3 + 1) * 96 + 4 * cq + j] = a1[j]; red[(kg * 3 + 2) * 96 + 4 * cq + j] = a2v[j]; }
            }
            __syncthreads();
            if (F.tid < 288) { const int w = F.tid / 96, cc = F.tid % 96; float s = 0.f;
                for (int g = 0; g < 21; ++g) s += red[(g * 3 + w) * 96 + cc];
                modv[((size_t)l * 3 + w) * 12288 + col0 + cc] = s + a.in[I_MODB][l * 12288 + col0 + cc]; }
            __syncthreads();
        }
    }
}

struct Row { f32x4 v[8]; };
__device__ __forceinline__ void row_load(Row& r, const float* p, int lane) {
#pragma unroll
    for (int j = 0; j < 8; ++j) r.v[j] = *(const f32x4*)(p + 4 * lane + 256 * j);
}
__device__ __forceinline__ float row_rstd(const Row& r) {
    float s = 0.f;
#pragma unroll
    for (int j = 0; j < 8; ++j) s += (r.v[j][0] * r.v[j][0] + r.v[j][1] * r.v[j][1]) + (r.v[j][2] * r.v[j][2] + r.v[j][3] * r.v[j][3]);
    return rsqrtf(wave_sum(s) * (1.0f / D) + RMS_EPS);
}
struct RowVecs { f32x4 gy[8], an[8], sh[8]; int cached; };
template <bool CTXROW>
__device__ __forceinline__ void rows_row(const Fr& F, const Args& a, int m, int mode, int nsplit, bool hprev_is_input, const float* ngy, const float* gatev, bool fin, const float* ngn,
                                         const float* shiftv, const float* scalev, RowVecs& C) {
    unsigned char* ws = a.ws;
    bf16* H = (bf16*)(ws + WS_H); const bf16* Y = (const bf16*)(ws + WS_MIX + MX_Y); float* YC = (float*)(ws + WS_YC); bf16* ABF = (bf16*)a.out;
    const int lane = F.lane;
    const int b = m / TB, t = m % TB, which = CTXROW ? 2 : b;
    Row y; bool ysum = false;
    if (CTXROW && mode == 1 && nsplit > 0) { ysum = true;
        const float* yc = YC + ((size_t)b * CTX + t) * D;
#pragma unroll
        for (int j = 0; j < 8; ++j) y.v[j] = (f32x4){0.f, 0.f, 0.f, 0.f};
#pragma unroll 1
        for (int sp = 0; sp < nsplit; sp += 4) { Row q0, q1, q2, q3;
            row_load(q0, yc + (size_t)sp * NB * CTX * D, lane);
            if (sp + 1 < nsplit) row_load(q1, yc + (size_t)(sp + 1) * NB * CTX * D, lane);
            if (sp + 2 < nsplit) row_load(q2, yc + (size_t)(sp + 2) * NB * CTX * D, lane);
            if (sp + 3 < nsplit) row_load(q3, yc + (size_t)(sp + 3) * NB * CTX * D, lane);
#pragma unroll
            for (int j = 0; j < 8; ++j) { f32x4 acc4 = q0.v[j];
                if (sp + 1 < nsplit) acc4 += q1.v[j];
                if (sp + 2 < nsplit) acc4 += q2.v[j];
                if (sp + 3 < nsplit) acc4 += q3.v[j];
                y.v[j] += acc4; } }
    }
    if (CTXROW || which != C.cached) { C.cached = which;
        if (mode == 1) { const float* gp = gatev + (size_t)which * 12288;
#pragma unroll
            for (int j = 0; j < 8; ++j) C.gy[j] = *(const f32x4*)(gp + 4 * lane + 256 * j) * *(const f32x4*)(ngy + 4 * lane + 256 * j); }
        if (!fin) { const float* sp = shiftv + (size_t)which * 12288; const float* cp = scalev + (size_t)which * 12288;
#pragma unroll
            for (int j = 0; j < 8; ++j) { C.an[j] = *(const f32x4*)(ngn + 4 * lane + 256 * j) * (*(const f32x4*)(cp + 4 * lane + 256 * j) + 1.0f); C.sh[j] = *(const f32x4*)(sp + 4 * lane + 256 * j); } }
    }
    const float* h0 = CTXROW ? a.in[I_CTX] + ((size_t)b * CTX + t) * D : a.in[I_X] + ((size_t)b * SEQ + (t - CTX)) * D;
    Row h;
    if (mode == 0 || hprev_is_input) row_load(h, h0, lane);
    else {
#pragma unroll
        for (int j = 0; j < 8; ++j) { const u32x2 hw = *(const u32x2*)(H + (size_t)m * D + 4 * lane + 256 * j); h.v[j] = (f32x4){bflo(hw.x), bfhi(hw.x), bflo(hw.y), bfhi(hw.y)}; } }
    if (mode == 1) {
        if (!ysum) {
#pragma unroll
            for (int j = 0; j < 8; ++j) { const u32x2 yw = *(const u32x2*)(Y + (size_t)m * D + 4 * lane + 256 * j); y.v[j] = (f32x4){bflo(yw.x), bfhi(yw.x), bflo(yw.y), bfhi(yw.y)}; } }
        const float rs = row_rstd(y);
#pragma unroll
        for (int j = 0; j < 8; ++j) h.v[j] += C.gy[j] * (y.v[j] * rs);
        if (!fin) {
#pragma unroll
            for (int j = 0; j < 8; ++j) { u32x2 hw; hw.x = pk2(h.v[j][0], h.v[j][1]); hw.y = pk2(h.v[j][2], h.v[j][3]); *(u32x2*)(H + (size_t)m * D + 4 * lane + 256 * j) = hw;
                h.v[j] = (f32x4){bflo(hw.x), bfhi(hw.x), bflo(hw.y), bfhi(hw.y)}; }
        }
    }
    if (fin) {
        float* o = a.out + ((size_t)b * SEQ + (t - CTX)) * D;
#pragma unroll
        for (int j = 0; j < 8; ++j) *(f32x4*)(o + 4 * lane + 256 * j) = h.v[j];
    } else {
        const float rs = row_rstd(h);
#pragma unroll
        for (int j = 0; j < 8; ++j) { const f32x4 o = (h.v[j] * rs) * C.an[j] + C.sh[j];
            u32x2 w; w.x = pk2(o[0], o[1]); w.y = pk2(o[2], o[3]);
            *(u32x2*)(ABF + (size_t)m * D + 4 * lane + 256 * j) = w; }
    }
}
__device__ __forceinline__ void rows_phase(const Fr& F, const Args& a, int mode, int nsplit, bool hprev_is_input, const float* ngy, const float* gatev  ,
                                           bool fin, const float* ngn, const float* shiftv, const float* scalev) {
    const int gw = F.vcu * NWAVES + F.wave, NGW = F.G * NWAVES;
    RowVecs C; C.cached = -1;
    if (!fin) { for (int m = gw; m < M; m += NGW) { if ((m % TB) < CTX) rows_row<true>(F, a, m, mode, nsplit, hprev_is_input, ngy, gatev, fin, ngn, shiftv, scalev, C); } }
    for (int m = gw; m < M; m += NGW) { if ((m % TB) >= CTX) rows_row<false>(F, a, m, mode, nsplit, hprev_is_input, ngy, gatev, fin, ngn, shiftv, scalev, C); }
}

__device__ __forceinline__ void load16s(const bf16* p, bool ok, float (&o)[16]) {
    if (ok) { float t[8]; unpack8(*(const u32x4*)p, t);
#pragma unroll
        for (int i = 0; i < 8; ++i) o[i] = t[i];
        unpack8(*(const u32x4*)(p + 8), t);
#pragma unroll
        for (int i = 0; i < 8; ++i) o[8 + i] = t[i];
    } else {
#pragma unroll
        for (int i = 0; i < 16; ++i) o[i] = 0.f;
    }
}
struct Raw16 { u32x4 a, b; };
__device__ __forceinline__ Raw16 ld16raw(const bf16* p, bool ok) { Raw16 r; const u32x4 z = {0u, 0u, 0u, 0u}; r.a = ok ? *(const u32x4*)p : z; r.b = ok ? *(const u32x4*)(p + 8) : z; return r; }
__device__ __forceinline__ void unpack16(const Raw16& r, float (&o)[16]) { float t[8]; unpack8(r.a, t);
#pragma unroll
    for (int i = 0; i < 8; ++i) o[i] = t[i];
    unpack8(r.b, t);
#pragma unroll
    for (int i = 0; i < 8; ++i) o[8 + i] = t[i]; }
__device__ __forceinline__ void store16(bf16* p, const float (&v)[16]) {
    float t[8];
#pragma unroll
    for (int i = 0; i < 8; ++i) t[i] = v[i];
    *(u32x4*)p = pack8(t);
#pragma unroll
    for (int i = 0; i < 8; ++i) t[i] = v[8 + i];
    *(u32x4*)(p + 8) = pack8(t);
}
__device__ __forceinline__ void prep_phase(const Fr& F, const Args& a) {
    unsigned char* ws = a.ws;
    const bf16* Z = (const bf16*)(ws + WS_ZR);
    bf16* R = (bf16*)(ws + WS_MIX + MX_R); bf16* V = (bf16*)(ws + WS_MIX + MX_V); bf16* Kr = (bf16*)(ws + WS_MIX + MX_K); bf16* KK = (bf16*)(ws + WS_MIX + MX_KK);
    bf16* AL = (bf16*)(ws + WS_MIX + MX_ALO);
    const float* mu = a.in[I_MU]; const float* k_k = a.in[I_KK];
    const int gw = F.vcu * NWAVES + F.wave, NGW = F.G * NWAVES, lane = F.lane;
    for (int m = gw; m < M; m += NGW) {
        const int t = m % TB;
        const bool hp = (t != 0) && (t != CTX), hn = (t != CTX - 1) && (t != TB - 1);
        const bf16* z = Z + (size_t)m * ZLD0; const bf16* zp = z - ZLD0; const bf16* zn = z + ZLD0;
        Raw16 rc[3], rl[3], rr[3];
#pragma unroll
        for (int sec = 0; sec < 3; ++sec) { const int c0 = sec * MIXA + 16 * lane; rc[sec] = ld16raw(z + c0, true); rl[sec] = ld16raw(zp + c0, hp); rr[sec] = ld16raw(zn + c0, hn); }
        const u32x4 zero4 = {0u, 0u, 0u, 0u};
        const int lcol = 3072 + 8 * (lane < 56 ? lane : 0);
        const u32x4 lc = *(const u32x4*)(z + lcol), ll = hp ? *(const u32x4*)(zp + lcol) : zero4, lr = hn ? *(const u32x4*)(zn + lcol) : zero4;
#pragma unroll
        for (int sec = 0; sec < 3; ++sec) {
            const int c0 = sec * MIXA + 16 * lane;
            float zc[16], zl[16], zr[16], o[16];
            unpack16(rc[sec], zc); unpack16(rl[sec], zl); unpack16(rr[sec], zr);
#pragma unroll
            for (int q = 0; q < 4; ++q) { const f32x4 mv = *(const f32x4*)(mu + c0 + 4 * q);
#pragma unroll
                for (int i = 0; i < 4; ++i) { const int e = 4 * q + i; o[e] = zc[e] + (0.5f * (zl[e] + zr[e]) - zc[e]) * mv[i]; } }
            if (sec == 0) store16(R + (size_t)m * MIXA + 16 * lane, o);
            else if (sec == 2) store16(V + (size_t)m * MIXA + 16 * lane, o);
            else {
                store16(Kr + (size_t)m * MIXA + 16 * lane, o);
                float kq[16]; float ss = 0.f;
#pragma unroll
                for (int q = 0; q < 4; ++q) { const f32x4 kv = *(const f32x4*)(k_k + 16 * lane + 4 * q);
#pragma unroll
                    for (int i = 0; i < 4; ++i) { const int e = 4 * q + i; kq[e] = o[e] * kv[i]; ss += kq[e] * kq[e]; } }
                ss = quad_sum(ss);
                const float inv = 1.0f / fmaxf(sqrtf(ss), 1e-12f);
#pragma unroll
                for (int e = 0; e < 16; ++e) kq[e] *= inv;
                store16(KK + (size_t)m * MIXA + 16 * lane, kq);
            }
        }
        bf16* al = AL + (size_t)m * 512;
        if (lane < 56) {
            float c8[8], l8[8], r8[8], v[8]; unpack8(lc, c8); unpack8(ll, l8); unpack8(lr, r8);
            const f32x4 m0 = *(const f32x4*)(mu + lcol), m1 = *(const f32x4*)(mu + lcol + 4);
#pragma unroll
            for (int e = 0; e < 8; ++e) { const float x = c8[e] + (0.5f * (l8[e] + r8[e]) - c8[e]) * (e < 4 ? m0[e & 3] : m1[e & 3]);
                v[e] = lane < 12 ? tanhf(x) : (lane < 24 ? x : fsigmoid(x)); }
            bf16* dst = lane < 12 ? al + 8 * lane : (lane < 24 ? al + 128 + 8 * (lane - 12) : al + 256 + 8 * (lane - 24));
            *(u32x4*)dst = pack8(v);
        } else { bf16* dst = lane < 60 ? al + 96 + 8 * (lane - 56) : al + 224 + 8 * (lane - 60); *(u32x4*)dst = zero4; }
    }
}

template <int KS>
__device__ __forceinline__ void mma16(f32x4& acc, const LAS bf16* A, int lda, int arow, const LAS bf16* Bt, int ldb, int brow, int lane) {
    const LAS bf16* ap = A + (size_t)(arow + (lane & 15)) * lda + 8 * (lane >> 4);
    const LAS bf16* bp = Bt + (size_t)(brow + (lane & 15)) * ldb + 8 * (lane >> 4);
#pragma unroll
    for (int ks = 0; ks < KS; ++ks) {
        const bf16x8 av = *(const LAS bf16x8*)(ap + ks * 32), bv = *(const LAS bf16x8*)(bp + ks * 32);
        acc = __builtin_amdgcn_mfma_f32_16x16x32_bf16(av, bv, acc, 0, 0, 0);
    }
}
template <int LD>
__device__ __forceinline__ void tr_frags64(const LAS bf16* T, int col0, int lane, bf16x8& f0, bf16x8& f1) {
    const unsigned addr = (unsigned)(size_t)(T + (8 * (lane >> 4) + ((lane & 15) >> 2)) * LD + col0 + 4 * (lane & 3));
    u32x2 a0, a1, a2, a3;
    asm volatile("ds_read_b64_tr_b16 %0, %4\n\tds_read_b64_tr_b16 %1, %4 offset:%5\n\tds_read_b64_tr_b16 %2, %4 offset:%6\n\tds_read_b64_tr_b16 %3, %4 offset:%7\n\ts_waitcnt lgkmcnt(0)\n\ts_nop 1"
                 : "=&v"(a0), "=&v"(a1), "=&v"(a2), "=&v"(a3) : "v"(addr), "i"(4 * LD * 2), "i"(32 * LD * 2), "i"(36 * LD * 2) : "memory");
    const u32x4 w0 = {a0.x, a0.y, a1.x, a1.y}, w1 = {a2.x, a2.y, a3.x, a3.y};
    f0 = __builtin_bit_cast(bf16x8, w0); f1 = __builtin_bit_cast(bf16x8, w1);
}
template <int LD>
__device__ __forceinline__ void tr_frags64x2(const LAS bf16* T0, int c0, const LAS bf16* T1, int c1, int lane, bf16x8 (&f)[2][2]) {
    const int ro = (8 * (lane >> 4) + ((lane & 15) >> 2)) * LD + 4 * (lane & 3);
    const unsigned a0 = (unsigned)(size_t)(T0 + ro + c0), a1 = (unsigned)(size_t)(T1 + ro + c1);
    u32x2 r[8];
    asm volatile("ds_read_b64_tr_b16 %0, %8\n\tds_read_b64_tr_b16 %1, %8 offset:%10\n\tds_read_b64_tr_b16 %2, %8 offset:%11\n\tds_read_b64_tr_b16 %3, %8 offset:%12\n\t"
                 "ds_read_b64_tr_b16 %4, %9\n\tds_read_b64_tr_b16 %5, %9 offset:%10\n\tds_read_b64_tr_b16 %6, %9 offset:%11\n\tds_read_b64_tr_b16 %7, %9 offset:%12\n\ts_waitcnt lgkmcnt(0)\n\ts_nop 1"
                 : "=&v"(r[0]), "=&v"(r[1]), "=&v"(r[2]), "=&v"(r[3]), "=&v"(r[4]), "=&v"(r[5]), "=&v"(r[6]), "=&v"(r[7])
                 : "v"(a0), "v"(a1), "i"(4 * LD * 2), "i"(32 * LD * 2), "i"(36 * LD * 2) : "memory");
#pragma unroll
    for (int i = 0; i < 2; ++i) { const u32x4 w0 = {r[4 * i].x, r[4 * i].y, r[4 * i + 1].x, r[4 * i + 1].y}, w1 = {r[4 * i + 2].x, r[4 * i + 2].y, r[4 * i + 3].x, r[4 * i + 3].y};
        f[i][0] = __builtin_bit_cast(bf16x8, w0); f[i][1] = __builtin_bit_cast(bf16x8, w1); }
}
template <int LD>
__device__ __forceinline__ void tr_frags64x4(const LAS bf16* T0, int c0, const LAS bf16* T1, int c1, const LAS bf16* T2, int c2, const LAS bf16* T3, int c3, int lane, bf16x8 (&f)[4][2]) {
    const int ro = (8 * (lane >> 4) + ((lane & 15) >> 2)) * LD + 4 * (lane & 3);
    const unsigned a0 = (unsigned)(size_t)(T0 + ro + c0), a1 = (unsigned)(size_t)(T1 + ro + c1), a2 = (unsigned)(size_t)(T2 + ro + c2), a3 = (unsigned)(size_t)(T3 + ro + c3);
    u32x2 r[16];
    asm volatile("ds_read_b64_tr_b16 %0, %16\n\tds_read_b64_tr_b16 %1, %16 offset:%20\n\tds_read_b64_tr_b16 %2, %16 offset:%21\n\tds_read_b64_tr_b16 %3, %16 offset:%22\n\t"
                 "ds_read_b64_tr_b16 %4, %17\n\tds_read_b64_tr_b16 %5, %17 offset:%20\n\tds_read_b64_tr_b16 %6, %17 offset:%21\n\tds_read_b64_tr_b16 %7, %17 offset:%22\n\t"
                 "ds_read_b64_tr_b16 %8, %18\n\tds_read_b64_tr_b16 %9, %18 offset:%20\n\tds_read_b64_tr_b16 %10, %18 offset:%21\n\tds_read_b64_tr_b16 %11, %18 offset:%22\n\t"
                 "ds_read_b64_tr_b16 %12, %19\n\tds_read_b64_tr_b16 %13, %19 offset:%20\n\tds_read_b64_tr_b16 %14, %19 offset:%21\n\tds_read_b64_tr_b16 %15, %19 offset:%22\n\ts_waitcnt lgkmcnt(0)\n\ts_nop 1"
                 : "=&v"(r[0]), "=&v"(r[1]), "=&v"(r[2]), "=&v"(r[3]), "=&v"(r[4]), "=&v"(r[5]), "=&v"(r[6]), "=&v"(r[7]),
                   "=&v"(r[8]), "=&v"(r[9]), "=&v"(r[10]), "=&v"(r[11]), "=&v"(r[12]), "=&v"(r[13]), "=&v"(r[14]), "=&v"(r[15])
                 : "v"(a0), "v"(a1), "v"(a2), "v"(a3), "i"(4 * LD * 2), "i"(32 * LD * 2), "i"(36 * LD * 2) : "memory");
#pragma unroll
    for (int i = 0; i < 4; ++i) { const u32x4 w0 = {r[4 * i].x, r[4 * i].y, r[4 * i + 1].x, r[4 * i + 1].y}, w1 = {r[4 * i + 2].x, r[4 * i + 2].y, r[4 * i + 3].x, r[4 * i + 3].y};
        f[i][0] = __builtin_bit_cast(bf16x8, w0); f[i][1] = __builtin_bit_cast(bf16x8, w1); }
}
__device__ __forceinline__ int chunk_tok(int d, int ci, int p) { const int uc = (d == 0) ? ci : (ci < 4 ? 3 - ci : 71 - ci); return (d == 0) ? uc * 64 + p : uc * 64 + 63 - p; }
__device__ __forceinline__ float dpp_allreduce4(float x) {
    x += __int_as_float(__builtin_amdgcn_update_dpp(0, __float_as_int(x), 0xB1, 0xF, 0xF, false));
    x += __int_as_float(__builtin_amdgcn_update_dpp(0, __float_as_int(x), 0x4E, 0xF, 0xF, false));
    return x;
}
__device__ __forceinline__ float quad_bcast(float v, int src) {
    const int iv = __float_as_int(v);
    const int r = src == 0 ? __builtin_amdgcn_update_dpp(0, iv, 0x00, 0xF, 0xF, false) : src == 1 ? __builtin_amdgcn_update_dpp(0, iv, 0x55, 0xF, 0xF, false)
                : src == 2 ? __builtin_amdgcn_update_dpp(0, iv, 0xAA, 0xF, 0xF, false) : __builtin_amdgcn_update_dpp(0, iv, 0xFF, 0xF, 0xF, false);
    return __int_as_float(r);
}
__device__ __forceinline__ void rwkv_pre_phase(const Fr& F, const Args& a, int wgi, int nWG) {
    unsigned char* ws = a.ws;
    const bf16* R = (const bf16*)(ws + WS_MIX + MX_R); const bf16* V = (const bf16*)(ws + WS_MIX + MX_V); const bf16* Km = (const bf16*)(ws + WS_MIX + MX_K);
    const bf16* KK = (const bf16*)(ws + WS_MIX + MX_KK); const bf16* BV = (const bf16*)(ws + WS_MIX + MX_BV);
    constexpr int LT = 72;
    LAS bf16* AT = (LAS bf16*)F.lds; LAS bf16* BT = AT + 64 * LT; LAS bf16* KT = BT + 64 * LT; LAS bf16* RT = KT + 64 * LT; LAS bf16* VM = RT + 64 * LT;
    LAS float* ATF = (LAS float*)(VM + 64 * LT); LAS float* LAB = ATF + 4096;
    LAS bf16* LKA = (LAS bf16*)(LAB + 64 * 68); LAS bf16* LBR = LKA + 64 * LT; LAS bf16* LKR = LBR + 64 * LT;
    LAS float* RHZ = (LAS float*)(LKR + 64 * LT);
    LAS bf16* XI = (LAS bf16*)(RHZ + 4096); LAS bf16* ZI = XI + 64 * LT;
    LAS float* WC = (LAS float*)(ZI + 64 * LT);
    LAS float* LW = RHZ; LAS float* SEG = (LAS float*)XI;
    const int tid = F.tid, lane = F.lane, w = F.wave;
    u32x4 nrr = {0, 0, 0, 0}, nkr = nrr, nvr = nrr, nar = nrr, nbr = nrr; f32x4 nlw0 = {0.f, 0.f, 0.f, 0.f}, nlw1 = nlw0;
    auto issue_loads = [&](int it2) {
        const int d_ = it2 / (int)RW_ITEMS, it_ = it2 % (int)RW_ITEMS, bh_ = it_ / (TB / 64), ci_ = it_ % (TB / 64);
        const size_t off = ((size_t)(bh_ >> 4) * TB + chunk_tok(d_, ci_, tid >> 3)) * MIXA + (bh_ & 15) * 64 + (tid & 7) * 8;
        const float* lwd = (const float*)(ws + WS_MIX + MX_DEC) + (size_t)d_ * M * MIXA;
        nrr = *(const u32x4*)(R + off); nkr = *(const u32x4*)(Km + off); nvr = *(const u32x4*)(V + off); nar = *(const u32x4*)(KK + off); nbr = *(const u32x4*)(BV + off);
        nlw0 = *(const f32x4*)(lwd + off); nlw1 = *(const f32x4*)(lwd + off + 4);
    };
    if (wgi < 2 * (int)RW_ITEMS) issue_loads(wgi);
    for (int item2 = wgi; item2 < 2 * (int)RW_ITEMS; item2 += nWG) {
        const int d = item2 / (int)RW_ITEMS, item = item2 % (int)RW_ITEMS;
        unsigned char* ob = d ? (ws + WS_H) : (ws + WS_RWG);
        bf16* GO = (bf16*)ob; bf16* PO = (bf16*)(ob + RW_ITEMS * 8192); bf16* YO = (bf16*)(ob + 2 * RW_ITEMS * 8192); bf16* QO = (bf16*)(ob + 3 * RW_ITEMS * 8192);
        const int bh = item / (TB / 64), ci = item % (TB / 64), b = bh >> 4, h = bh & 15;
        const size_t rowb = (size_t)b * TB;
        const int p = tid >> 3, c8 = (tid & 7) * 8;
        const u32x4 rr = nrr, kr = nkr, vr = nvr, ar = nar, br = nbr; const f32x4 lw0 = nlw0, lw1 = nlw1;
        if (item2 + nWG < 2 * (int)RW_ITEMS) issue_loads(item2 + nWG);
        *(LAS f32x4*)(LW + p * 64 + c8) = lw0; *(LAS f32x4*)(LW + p * 64 + c8 + 4) = lw1;
        __syncthreads();
        {
            const int col = tid & 63, seg = tid >> 6; float pf[8];
#pragma unroll
            for (int q = 0; q < 8; ++q) pf[q] = LW[(8 * seg + q) * 64 + col];
#pragma unroll
            for (int q = 1; q < 8; ++q) pf[q] += pf[q - 1];
            SEG[seg * 64 + col] = pf[7];
            __syncthreads();
            float offs = 0.f;
#pragma unroll
            for (int s2 = 0; s2 < 7; ++s2) { const float sv = SEG[s2 * 64 + col]; offs += (s2 < seg) ? sv : 0.f; }
#pragma unroll
            for (int q = 0; q < 8; ++q) LW[(8 * seg + q) * 64 + col] = pf[q] + offs;
        }
        __syncthreads();
        {
            const f32x4 c0 = *(const LAS f32x4*)(LW + p * 64 + c8), c1 = *(const LAS f32x4*)(LW + p * 64 + c8 + 4);
            float r8[8], k8[8], a8[8], b8[8], at[8];
            unpack8(rr, r8); unpack8(kr, k8); unpack8(ar, a8); unpack8(br, b8);
#pragma unroll
            for (int i = 0; i < 8; ++i) { const float cum = i < 4 ? c0[i & 3] : c1[i & 3], lwr = i < 4 ? lw0[i & 3] : lw1[i & 3];
                const float Wt = fexp(cum), iWt = fexp(-cum), Wp = fexp(cum - lwr);
                at[i] = -a8[i] * Wp; b8[i] *= iWt; k8[i] *= iWt; r8[i] *= Wt;
                if (p == 63) WC[c8 + i] = Wt; }
            *(LAS u32x4*)(AT + p * LT + c8) = pack8(at); *(LAS u32x4*)(BT + p * LT + c8) = pack8(b8); *(LAS u32x4*)(KT + p * LT + c8) = pack8(k8); *(LAS u32x4*)(RT + p * LT + c8) = pack8(r8);
            *(LAS u32x4*)(VM + p * LT + c8) = vr;
        }
        __syncthreads();
        {
            const int g = w >> 1; const LAS bf16* Am = (g < 2) ? AT : RT; const LAS bf16* Bm = (g & 1) ? KT : BT;
            bf16x8 bfr[4][2];
#pragma unroll
            for (int nt = 0; nt < 4; ++nt) { const LAS bf16* bp = Bm + (size_t)(16 * nt + (lane & 15)) * LT + 8 * (lane >> 4); bfr[nt][0] = *(const LAS bf16x8*)bp; bfr[nt][1] = *(const LAS bf16x8*)(bp + 32); }
#pragma unroll
            for (int e2 = 0; e2 < 2; ++e2) { const int mt = (w & 1) * 2 + e2;
                const LAS bf16* ap = Am + (size_t)(16 * mt + (lane & 15)) * LT + 8 * (lane >> 4); const bf16x8 a0 = *(const LAS bf16x8*)ap, a1 = *(const LAS bf16x8*)(ap + 32);
#pragma unroll
                for (int nt = 0; nt < 4; ++nt) { f32x4 acc = {0.f, 0.f, 0.f, 0.f};
                    if (nt <= mt) { acc = __builtin_amdgcn_mfma_f32_16x16x32_bf16(a0, bfr[nt][0], acc, 0, 0, 0); acc = __builtin_amdgcn_mfma_f32_16x16x32_bf16(a1, bfr[nt][1], acc, 0, 0, 0); }
#pragma unroll
                    for (int r = 0; r < 4; ++r) { const int t = 16 * mt + 4 * (lane >> 4) + r, i = 16 * nt + (lane & 15);
                        const bool keep = (g < 2) ? (i < t) : (i <= t); const float val = keep ? acc[r] : 0.f;
                        if (g == 0) LAB[i * 68 + (t & 3) * 16 + (t >> 2)] = val;
                        else { LAS bf16* dst = (g == 1) ? LKA : (g == 2 ? LBR : LKR); dst[t * LT + i] = f2bf(val); } } } }
        }
        __syncthreads();
        LAS bf16* TI = (LAS bf16*)ATF;
        LAS bf16* RZ = (LAS bf16*)RHZ;
        if (w < 4) {
            const int col = w * 16 + (lane >> 2), part = lane & 3;
            f32x2 x[8];
#pragma unroll
            for (int j = 0; j < 8; ++j) { x[j][0] = (8 * j + part == col) ? 1.f : 0.f; x[j][1] = (8 * j + 4 + part == col) ? 1.f : 0.f; }
#pragma unroll
            for (int t = 0; t < 64; ++t) {
                const float xs = quad_bcast(x[t >> 3][(t >> 2) & 1], t & 3); const f32x2 xv = {xs, xs};
#pragma unroll
                for (int j4 = (t >> 4); j4 < 4; ++j4) { const f32x4 l = *(const LAS f32x4*)(LAB + t * 68 + part * 16 + 4 * j4);
                    x[2 * j4] += (f32x2){l[0], l[1]} * xv; x[2 * j4 + 1] += (f32x2){l[2], l[3]} * xv; }
            }
#pragma unroll
            for (int j = 0; j < 8; ++j) { TI[(8 * j + part) * LT + col] = f2bf(x[j][0]); TI[(8 * j + 4 + part) * LT + col] = f2bf(x[j][1]); }
        } else {
            const int w4 = w - 4;
            bf16x8 vf0, vf1; tr_frags64<LT>(VM, 16 * w4, lane, vf0, vf1);
#pragma unroll
            for (int nt = 0; nt < 4; ++nt) { f32x4 acc = {0.f, 0.f, 0.f, 0.f};
                const LAS bf16* bp = LKA + (size_t)(16 * nt + (lane & 15)) * LT + 8 * (lane >> 4);
                acc = __builtin_amdgcn_mfma_f32_16x16x32_bf16(vf0, *(const LAS bf16x8*)bp, acc, 0, 0, 0);
                acc = __builtin_amdgcn_mfma_f32_16x16x32_bf16(vf1, *(const LAS bf16x8*)(bp + 32), acc, 0, 0, 0);
                u32x2 o; o.x = pk2(acc[0], acc[1]); o.y = pk2(acc[2], acc[3]);
                *(LAS u32x2*)(RZ + (16 * nt + (lane & 15)) * LT + 16 * w4 + 4 * (lane >> 4)) = o; }
        }
        __syncthreads();
        {
            const LAS bf16* src = (w < 4) ? AT : RZ; LAS bf16* dst = (w < 4) ? XI : ZI; const int ct = w & 3;
            bf16x8 af0, af1; tr_frags64<LT>(src, 16 * ct, lane, af0, af1);
#pragma unroll
            for (int nt = 0; nt < 4; ++nt) { f32x4 acc = {0.f, 0.f, 0.f, 0.f};
                const LAS bf16* bp = TI + (size_t)(16 * nt + (lane & 15)) * LT + 8 * (lane >> 4);
                acc = __builtin_amdgcn_mfma_f32_16x16x32_bf16(af0, *(const LAS bf16x8*)bp, acc, 0, 0, 0);
                acc = __builtin_amdgcn_mfma_f32_16x16x32_bf16(af1, *(const LAS bf16x8*)(bp + 32), acc, 0, 0, 0);
                u32x2 o; o.x = pk2(acc[0], acc[1]); o.y = pk2(acc[2], acc[3]);
                *(LAS u32x2*)(dst + (16 * nt + (lane & 15)) * LT + 16 * ct + 4 * (lane >> 4)) = o; }
        }
        __syncthreads();
        {
            const int mq = w >> 1; const size_t ib = (size_t)item * 4096;
#pragma unroll
            for (int e2 = 0; e2 < 2; ++e2) { const int mt = (w & 1) * 2 + e2; const int rr0 = 16 * mt + 4 * (lane >> 4);
                if (mq == 0) {
                    bf16x8 xf0, xf1; tr_frags64<LT>(XI, 16 * mt, lane, xf0, xf1);
#pragma unroll
                    for (int nt = 0; nt < 4; ++nt) { const int cc = 16 * nt + (lane & 15); f32x4 acc = {0.f, 0.f, 0.f, 0.f};
                        const LAS bf16* bp = LBR + (size_t)cc * LT + 8 * (lane >> 4);
                        acc = __builtin_amdgcn_mfma_f32_16x16x32_bf16(xf0, *(const LAS bf16x8*)bp, acc, 0, 0, 0);
                        acc = __builtin_amdgcn_mfma_f32_16x16x32_bf16(xf1, *(const LAS bf16x8*)(bp + 32), acc, 0, 0, 0);
                        const u32x2 rw = *(const LAS u32x2*)(RT + cc * LT + rr0);
                        u32x2 o; o.x = pk2(acc[0] + bflo(rw.x), acc[1] + bfhi(rw.x)); o.y = pk2(acc[2] + bflo(rw.y), acc[3] + bfhi(rw.y));
                        *(u32x2*)(GO + ib + (size_t)cc * 64 + rr0) = o; }
                } else if (mq == 1) {
                    bf16x8 f[2][2]; tr_frags64x2<LT>(ZI, 16 * mt, VM, 16 * mt, lane, f);
#pragma unroll
                    for (int nt = 0; nt < 4; ++nt) { const int cc = 16 * nt + (lane & 15); f32x4 acc = {0.f, 0.f, 0.f, 0.f};
                        const LAS bf16* bp = LBR + (size_t)cc * LT + 8 * (lane >> 4); const LAS bf16* cp = LKR + (size_t)cc * LT + 8 * (lane >> 4);
                        acc = __builtin_amdgcn_mfma_f32_16x16x32_bf16(f[0][0], *(const LAS bf16x8*)bp, acc, 0, 0, 0);
                        acc = __builtin_amdgcn_mfma_f32_16x16x32_bf16(f[0][1], *(const LAS bf16x8*)(bp + 32), acc, 0, 0, 0);
                        acc = __builtin_amdgcn_mfma_f32_16x16x32_bf16(f[1][0], *(const LAS bf16x8*)cp, acc, 0, 0, 0);
                        acc = __builtin_amdgcn_mfma_f32_16x16x32_bf16(f[1][1], *(const LAS bf16x8*)(cp + 32), acc, 0, 0, 0);
                        u32x2 o; o.x = pk2(acc[0], acc[1]); o.y = pk2(acc[2], acc[3]);
                        *(u32x2*)(YO + ib + (size_t)cc * 64 + rr0) = o; }
                } else if (mq == 2) {
                    bf16x8 xf0, xf1; tr_frags64<LT>(XI, 16 * mt, lane, xf0, xf1);
                    bf16x8 g[4][2]; tr_frags64x4<LT>(BT, 0, BT, 16, BT, 32, BT, 48, lane, g);
#pragma unroll
                    for (int nt = 0; nt < 4; ++nt) { const int cc = 16 * nt + (lane & 15); f32x4 acc = {0.f, 0.f, 0.f, 0.f};
                        acc = __builtin_amdgcn_mfma_f32_16x16x32_bf16(xf0, g[nt][0], acc, 0, 0, 0);
                        acc = __builtin_amdgcn_mfma_f32_16x16x32_bf16(xf1, g[nt][1], acc, 0, 0, 0);
                        const float wc = WC[cc];
                        u32x2 o; o.x = pk2(wc * (acc[0] + (rr0 == cc ? 1.f : 0.f)), wc * (acc[1] + (rr0 + 1 == cc ? 1.f : 0.f)));
                        o.y = pk2(wc * (acc[2] + (rr0 + 2 == cc ? 1.f : 0.f)), wc * (acc[3] + (rr0 + 3 == cc ? 1.f : 0.f)));
                        *(u32x2*)(PO + ib + (size_t)cc * 64 + rr0) = o; }
                } else {
                    bf16x8 fa[2][2]; tr_frags64x2<LT>(BT, 16 * mt, KT, 16 * mt, lane, fa);
                    bf16x8 gz[4][2], gv[4][2]; tr_frags64x4<LT>(ZI, 0, ZI, 16, ZI, 32, ZI, 48, lane, gz); tr_frags64x4<LT>(VM, 0, VM, 16, VM, 32, VM, 48, lane, gv);
                    const f32x4 wc = *(const LAS f32x4*)(WC + rr0);
#pragma unroll
                    for (int nt = 0; nt < 4; ++nt) { const int cc = 16 * nt + (lane & 15); f32x4 acc = {0.f, 0.f, 0.f, 0.f};
                        acc = __builtin_amdgcn_mfma_f32_16x16x32_bf16(fa[0][0], gz[nt][0], acc, 0, 0, 0);
                        acc = __builtin_amdgcn_mfma_f32_16x16x32_bf16(fa[0][1], gz[nt][1], acc, 0, 0, 0);
                        acc = __builtin_amdgcn_mfma_f32_16x16x32_bf16(fa[1][0], gv[nt][0], acc, 0, 0, 0);
                        acc = __builtin_amdgcn_mfma_f32_16x16x32_bf16(fa[1][1], gv[nt][1], acc, 0, 0, 0);
                        u32x2 o; o.x = pk2(wc[0] * acc[0], wc[1] * acc[1]); o.y = pk2(wc[2] * acc[2], wc[3] * acc[3]);
                        *(u32x2*)(QO + ib + (size_t)cc * 64 + rr0) = o; }
                }
            }
        }
        __syncthreads();
    }
}
__device__ __forceinline__ void rwkv_seq_phase(const Fr& F, const Args& a, int wgi, int nWG) {
    unsigned char* ws = a.ws;
    constexpr int LT = 72, SLOT = 32768, RING0 = 2 * 64 * LT * 2;
    LAS bf16* SH = (LAS bf16*)F.lds; LAS bf16* SL = SH + 64 * LT;
    LAS unsigned char* ring = F.lds + RING0;
    const int tid = F.tid, lane = F.lane, w = F.wave, fr = lane & 15, fq = lane >> 4;
    for (int ch = wgi; ch < 2 * NB * 16; ch += nWG) {
        const int d = ch >> 5, bh = ch & 31, b = bh >> 4, h = bh & 15; const size_t rowb = (size_t)b * TB;
        const unsigned char* ob = d ? (ws + WS_H) : (ws + WS_RWG);
        bf16* YA = (bf16*)(ws + WS_MIX + MX_YA) + (size_t)d * M * MIXA;
        for (int i = tid; i < 2 * 64 * LT / 2; i += NTHR) ((LAS unsigned*)SH)[i] = 0u;
        const unsigned srcoff = (unsigned)((tid >> 3) * 128 + (((tid & 7) ^ ((tid >> 3) & 7)) * 16));
        auto issue = [&](int ci_) { const int ci = ci_ < TB / 64 ? ci_ : TB / 64 - 1;
            const unsigned char* src = ob + ((size_t)bh * (TB / 64) + ci) * 8192 + srcoff; LAS unsigned char* dst = ring + (ci_ & 3) * SLOT + w * 1024;
#pragma unroll
            for (int j = 0; j < 4; ++j)
                __builtin_amdgcn_global_load_lds((const unsigned*)(src + (size_t)j * RW_ITEMS * 8192), (LAS unsigned*)(dst + j * 8192), 16, 0, 0); };
        issue(0); issue(1); issue(2);
        asm volatile("s_waitcnt lgkmcnt(0)" ::: "memory");
        for (int ci = 0; ci < TB / 64; ++ci) {
            if (ci < 2) asm volatile("s_waitcnt vmcnt(8)" ::: "memory"); else asm volatile("s_waitcnt vmcnt(12)" ::: "memory");
            __builtin_amdgcn_s_barrier();
            asm volatile("" ::: "memory");
            issue(ci + 3);
            const LAS unsigned char* slot = ring + (ci & 3) * SLOT;
            f32x4 sn[2];
#pragma unroll
            for (int e = 0; e < 2; ++e) { const int tile = 2 * w + e, mt = tile >> 2, nt = tile & 3;
                const int rt = 16 * nt + fr, rk = 16 * mt + fr;
                const LAS unsigned char* gr = slot + rt * 128; const LAS unsigned char* pr = slot + 8192 + rk * 128;
                const bf16x8 g0 = *(const LAS bf16x8*)(gr + (((fq) ^ (rt & 7)) * 16)), g1 = *(const LAS bf16x8*)(gr + (((fq + 4) ^ (rt & 7)) * 16));
                const bf16x8 p0 = *(const LAS bf16x8*)(pr + (((fq) ^ (rk & 7)) * 16)), p1 = *(const LAS bf16x8*)(pr + (((fq + 4) ^ (rk & 7)) * 16));
                const int cpos = ((2 * mt + (fq >> 1)) ^ (rt & 7)) * 16 + (fq & 1) * 8;
                const u32x2 yl = *(const LAS u32x2*)(slot + 16384 + rt * 128 + cpos), ql = *(const LAS u32x2*)(slot + 24576 + rt * 128 + cpos);
                f32x4 acc = {bflo(yl.x), bfhi(yl.x), bflo(yl.y), bfhi(yl.y)};
                const LAS bf16* sh = SH + (size_t)(16 * mt + fr) * LT + 8 * fq; const LAS bf16* sl = SL + (size_t)(16 * mt + fr) * LT + 8 * fq;
                acc = __builtin_amdgcn_mfma_f32_16x16x32_bf16(*(const LAS bf16x8*)sh, g0, acc, 0, 0, 0);
                acc = __builtin_amdgcn_mfma_f32_16x16x32_bf16(*(const LAS bf16x8*)(sh + 32), g1, acc, 0, 0, 0);
                acc = __builtin_amdgcn_mfma_f32_16x16x32_bf16(*(const LAS bf16x8*)sl, g0, acc, 0, 0, 0);
                acc = __builtin_amdgcn_mfma_f32_16x16x32_bf16(*(const LAS bf16x8*)(sl + 32), g1, acc, 0, 0, 0);
                u32x2 o; o.x = pk2(acc[0], acc[1]); o.y = pk2(acc[2], acc[3]);
                *(u32x2*)(YA + (rowb + chunk_tok(d, ci, rt)) * MIXA + h * 64 + 16 * mt + 4 * fq) = o;
                f32x4 s2 = {bflo(ql.x), bfhi(ql.x), bflo(ql.y), bfhi(ql.y)};
                const LAS bf16* th = SH + (size_t)(16 * nt + fr) * LT + 8 * fq; const LAS bf16* tl = SL + (size_t)(16 * nt + fr) * LT + 8 * fq;
                s2 = __builtin_amdgcn_mfma_f32_16x16x32_bf16(p0, *(const LAS bf16x8*)th, s2, 0, 0, 0);
                s2 = __builtin_amdgcn_mfma_f32_16x16x32_bf16(p1, *(const LAS bf16x8*)(th + 32), s2, 0, 0, 0);
                s2 = __builtin_amdgcn_mfma_f32_16x16x32_bf16(p0, *(const LAS bf16x8*)tl, s2, 0, 0, 0);
                s2 = __builtin_amdgcn_mfma_f32_16x16x32_bf16(p1, *(const LAS bf16x8*)(tl + 32), s2, 0, 0, 0);
                sn[e] = s2; }
            asm volatile("s_waitcnt lgkmcnt(0)" ::: "memory");
            __builtin_amdgcn_s_barrier();
            asm volatile("" ::: "memory");
#pragma unroll
            for (int e = 0; e < 2; ++e) { const int tile = 2 * w + e, mt = tile >> 2, nt = tile & 3;
                u32x2 hi; hi.x = pk2(sn[e][0], sn[e][1]); hi.y = pk2(sn[e][2], sn[e][3]);
                u32x2 lo; lo.x = pk2(sn[e][0] - bflo(hi.x), sn[e][1] - bfhi(hi.x)); lo.y = pk2(sn[e][2] - bflo(hi.y), sn[e][3] - bfhi(hi.y));
                *(LAS u32x2*)(SH + (size_t)(16 * nt + fr) * LT + 16 * mt + 4 * fq) = hi; *(LAS u32x2*)(SL + (size_t)(16 * nt + fr) * LT + 16 * mt + 4 * fq) = lo; }
            asm volatile("s_waitcnt lgkmcnt(0)" ::: "memory");
        }
        asm volatile("s_waitcnt vmcnt(0)" ::: "memory");
        __builtin_amdgcn_s_barrier();
        asm volatile("" ::: "memory");
    }
}

__device__ __forceinline__ void gla_pre_phase(const Fr& F, const Args& a, int wgi, int nWG) {
    unsigned char* ws = a.ws;
    const bf16* Z = (const bf16*)(ws + WS_ZR); bf16* YB = (bf16*)(ws + WS_MIX + MX_YB);
    bf16* GQI = (bf16*)((unsigned char*)a.out + DO_GQI); bf16* GKI = (bf16*)(ws + WS_GKI); float* GDL = (float*)(ws + WS_GDL);
    const float* gk_up = a.in[I_GKUP]; const float* gk_b = a.in[I_GKB];
    constexpr int DK = 128, LQ = DK + 24, LV = 256 + 8, LT = 72;
    LAS bf16* QIN = (LAS bf16*)F.lds; LAS bf16* KIN = QIN + 64 * LQ; LAS bf16* VI = KIN + 64 * LQ; LAS bf16* ATT = VI + 64 * LV;
    LAS float* BC = (LAS float*)(ATT + 64 * LT); LAS float* QS = BC + 64 * DK; LAS float* GD = QS + 4 * DK;
    const int tid = F.tid, lane = F.lane, w = F.wave;
    const float qscale = 0.08838834764831845f;
    for (int item = wgi; item < (int)GLA_ITEMS; item += nWG) {
        const int ci = item % (TB / 64), d = (item / (TB / 64)) & 1, h = (item / (2 * (TB / 64))) & 3, b = item / (8 * (TB / 64));
        const size_t rowb = (size_t)b * TB;
        const int col = tid & (DK - 1);
        float gku[16];
#pragma unroll
        for (int j = 0; j < 16; ++j) gku[j] = gk_up[((size_t)d * 16 + j) * 512 + h * DK + col];
        const float gkb = gk_b[d * 512 + h * DK + col];
        u32x4 qreg[2], kreg[2], vreg[4], gdreg = {0, 0, 0, 0};
#pragma unroll
        for (int it = 0; it < 2; ++it) { const int idx = tid + it * NTHR; const int p = idx >> 4, kc = (idx & 15) * 8; const bf16* zr = Z + (rowb + chunk_tok(d, ci, p)) * ZLD0;
            qreg[it] = *(const u32x4*)(zr + GQ + h * DK + kc); kreg[it] = *(const u32x4*)(zr + GK + h * DK + kc); }
#pragma unroll
        for (int it = 0; it < 4; ++it) { const int idx = tid + it * NTHR; const int p = idx >> 5, vc = (idx & 31) * 8;
            vreg[it] = *(const u32x4*)(Z + (rowb + chunk_tok(d, ci, p)) * ZLD0 + GV + h * 256 + vc); }
        if (tid < 128) { const int p = tid >> 1, hf = tid & 1; gdreg = *(const u32x4*)(Z + (rowb + chunk_tok(d, ci, p)) * ZLD0 + GGD + 8 * hf); }
        if (tid < 128) { const int p = tid >> 1, hf = tid & 1; float t8[8]; unpack8(gdreg, t8);
            *(LAS f32x4*)(GD + p * 16 + 8 * hf) = (f32x4){t8[0], t8[1], t8[2], t8[3]}; *(LAS f32x4*)(GD + p * 16 + 8 * hf + 4) = (f32x4){t8[4], t8[5], t8[6], t8[7]}; }
        __syncthreads();
        {
            const int qq = tid / DK; float bc[16];
#pragma unroll
            for (int pp = 0; pp < 16; ++pp) { const int p = 16 * qq + pp; float x = gkb;
                const f32x4 g0 = *(const LAS f32x4*)(GD + p * 16), g1 = *(const LAS f32x4*)(GD + p * 16 + 4), g2 = *(const LAS f32x4*)(GD + p * 16 + 8), g3 = *(const LAS f32x4*)(GD + p * 16 + 12);
#pragma unroll
                for (int j = 0; j < 4; ++j) { x += g0[j] * gku[j]; x += g1[j] * gku[4 + j]; x += g2[j] * gku[8 + j]; x += g3[j] * gku[12 + j]; }
                bc[pp] = flogsigmoid(x) * (1.0f / 16.0f); }
#pragma unroll
            for (int pp = 1; pp < 16; ++pp) bc[pp] += bc[pp - 1];
            QS[qq * DK + col] = bc[15];
            __syncthreads();
            float offs = 0.f;
#pragma unroll
            for (int q2 = 0; q2 < 3; ++q2) { const float sv = QS[q2 * DK + col]; offs += (q2 < qq) ? sv : 0.f; }
#pragma unroll
            for (int pp = 0; pp < 16; ++pp) BC[(16 * qq + pp) * DK + col] = bc[pp] + offs;
        }
        __syncthreads();
#pragma unroll
        for (int it = 0; it < 2; ++it) { const int idx = tid + it * NTHR; const int p = idx >> 4, kc = (idx & 15) * 8;
            float q8[8], k8[8]; unpack8(qreg[it], q8); unpack8(kreg[it], k8);
            const f32x4 b0 = *(const LAS f32x4*)(BC + p * DK + kc), b1 = *(const LAS f32x4*)(BC + p * DK + kc + 4);
#pragma unroll
            for (int i = 0; i < 8; ++i) { const float bc = i < 4 ? b0[i & 3] : b1[i & 3]; q8[i] *= fexp(bc) * qscale; k8[i] *= fexp(-bc); }
            const u32x4 qw = pack8(q8), kw = pack8(k8);
            *(LAS u32x4*)(QIN + p * LQ + kc) = qw; *(LAS u32x4*)(KIN + p * LQ + kc) = kw;
            *(u32x4*)(GQI + (size_t)item * 8192 + p * DK + kc) = qw; *(u32x4*)(GKI + (size_t)item * 8192 + p * DK + kc) = kw; }
#pragma unroll
        for (int it = 0; it < 4; ++it) { const int idx = tid + it * NTHR; const int p = idx >> 5, vc = (idx & 31) * 8; *(LAS u32x4*)(VI + p * LV + vc) = vreg[it]; }
        if (tid < DK) GDL[(size_t)item * DK + tid] = fexp(BC[63 * DK + tid]);
        __syncthreads();
        { const int mt = w >> 1;
#pragma unroll
          for (int e = 0; e < 2; ++e) { const int nt = (w & 1) * 2 + e; f32x4 acc = {0.f, 0.f, 0.f, 0.f};
              if (nt <= mt) mma16<DK / 32>(acc, QIN, LQ, 16 * mt, KIN, LQ, 16 * nt, lane);
#pragma unroll
              for (int r = 0; r < 4; ++r) { const int i = 16 * mt + 4 * (lane >> 4) + r, j = 16 * nt + (lane & 15);
                  ATT[i * LT + j] = f2bf(j <= i ? acc[r] : 0.f); } } }
        __syncthreads();
        { bf16x8 af[4][2];
#pragma unroll
          for (int mt = 0; mt < 4; ++mt) { const LAS bf16* ap = ATT + (size_t)(16 * mt + (lane & 15)) * LT + 8 * (lane >> 4); af[mt][0] = *(const LAS bf16x8*)ap; af[mt][1] = *(const LAS bf16x8*)(ap + 32); }
          bf16x8 vf[2][2]; tr_frags64x2<LV>(VI, 32 * w, VI, 32 * w + 16, lane, vf);
          bf16* yb = YB + (size_t)d * M * MIXA;
#pragma unroll
          for (int e = 0; e < 2; ++e)
#pragma unroll
              for (int mt = 0; mt < 4; ++mt) { f32x4 acc = {0.f, 0.f, 0.f, 0.f};
                  acc = __builtin_amdgcn_mfma_f32_16x16x32_bf16(vf[e][0], af[mt][0], acc, 0, 0, 0);
                  acc = __builtin_amdgcn_mfma_f32_16x16x32_bf16(vf[e][1], af[mt][1], acc, 0, 0, 0);
                  u32x2 o; o.x = pk2(acc[0], acc[1]); o.y = pk2(acc[2], acc[3]);
                  *(u32x2*)(yb + (rowb + chunk_tok(d, ci, 16 * mt + (lane & 15))) * MIXA + h * 256 + 32 * w + 16 * e + 4 * (lane >> 4)) = o; } }
        __syncthreads();
    }
}
__device__ __forceinline__ void gla_seq_phase(const Fr& F, const Args& a, int wgi, int nWG) {
    unsigned char* ws = a.ws;
    const bf16* Z = (const bf16*)(ws + WS_ZR); bf16* OC2 = (bf16*)(ws + WS_MIX + MX_DEC);
    const bf16* GQI = (const bf16*)((const unsigned char*)a.out + DO_GQI); const bf16* GKI = (const bf16*)(ws + WS_GKI); const float* GDL = (const float*)(ws + WS_GDL);
    constexpr int DK = 128, LQ = DK + 24, SLOT = 37888, RING0 = 32 * LQ * 2;
    LAS bf16* ST = (LAS bf16*)F.lds; LAS unsigned char* ring = F.lds + RING0;
    static_assert(RING0 % 16 == 0 && RING0 + 4 * SLOT <= LDS_BYTES - 16, "GLA recurrence LDS map");
    const int tid = F.tid, lane = F.lane, w = F.wave, fr = lane & 15, fq = lane >> 4;
    for (int unit = wgi; unit < 128; unit += nWG) {
        const int vs = unit & 7, d = (unit >> 3) & 1, h = (unit >> 4) & 3, b = unit >> 6;
        const size_t rowb = (size_t)b * TB; const size_t it0 = (size_t)((b * 4 + h) * 2 + d) * (TB / 64);
        bf16* oc = OC2 + (size_t)d * M * MIXA;
        f32x4 S[2] = {{0.f, 0.f, 0.f, 0.f}, {0.f, 0.f, 0.f, 0.f}};
        const int vt = w >> 2, nt = w & 3;
        auto issue = [&](int ci_) { const int ci = ci_ < TB / 64 ? ci_ : TB / 64 - 1; const size_t ib = (it0 + ci) * 8192;
            LAS unsigned char* dst = ring + (ci_ & 3) * SLOT;
#pragma unroll
            for (int j = 0; j < 2; ++j) { const int lin = j * 8192 + tid * 16; const int r = lin >> 8, pp = (lin >> 4) & 15; const int sp = pp ^ (r & 7);
                __builtin_amdgcn_global_load_lds((const unsigned*)((const unsigned char*)GKI + ib * 2 + r * 256 + sp * 16), (LAS unsigned*)(dst + j * 8192 + w * 1024), 16, 0, 0);
                __builtin_amdgcn_global_load_lds((const unsigned*)((const unsigned char*)GQI + ib * 2 + r * 256 + sp * 16), (LAS unsigned*)(dst + 16384 + j * 8192 + w * 1024), 16, 0, 0); }
            { const int t2 = tid & 255; const int r = t2 >> 2, pc = t2 & 3;
              __builtin_amdgcn_global_load_lds((const unsigned*)(Z + (rowb + chunk_tok(d, ci, r)) * ZLD0 + GV + h * 256 + vs * 32 + pc * 8), (LAS unsigned*)(dst + 32768 + (w & 3) * 1024), 16, 0, 0); }
            { const int t3 = lane & 31;
              __builtin_amdgcn_global_load_lds((const unsigned*)(GDL + (it0 + ci) * DK + t3 * 4), (LAS unsigned*)(dst + 36864), 16, 0, 0); }
        };
        issue(0); issue(1); issue(2);
#pragma unroll
        for (int e = 0; e < 2; ++e) *(LAS u32x2*)(ST + (16 * e + fr) * LQ + 16 * w + 4 * fq) = (u32x2){0u, 0u};
        asm volatile("s_waitcnt lgkmcnt(0)" ::: "memory");
        for (int ci = 0; ci < TB / 64; ++ci) {
            asm volatile("s_waitcnt vmcnt(12)" ::: "memory");
            __builtin_amdgcn_s_barrier();
            asm volatile("" ::: "memory");
            issue(ci + 3);
            const LAS unsigned char* slot = ring + (ci & 3) * SLOT;
            { f32x4 acc = {0.f, 0.f, 0.f, 0.f};
              const LAS bf16* sp = ST + (size_t)(16 * vt + fr) * LQ + 8 * fq; const int rt = 16 * nt + fr; const LAS unsigned char* qr = slot + 16384 + rt * 256;
#pragma unroll
              for (int ks = 0; ks < 4; ++ks) acc = __builtin_amdgcn_mfma_f32_16x16x32_bf16(*(const LAS bf16x8*)(sp + 32 * ks), *(const LAS bf16x8*)(qr + (((fq + 4 * ks) ^ (rt & 7)) * 16)), acc, 0, 0, 0);
              u32x2 o; o.x = pk2(acc[0], acc[1]); o.y = pk2(acc[2], acc[3]);
              *(u32x2*)(oc + (rowb + chunk_tok(d, ci, rt)) * MIXA + h * 256 + vs * 32 + 16 * vt + 4 * fq) = o; }
            { const int g = lane >> 4, q = (lane & 15) >> 2, pq = lane & 3;
              const LAS unsigned char* kb = slot + (8 * g + q) * 256 + (pq & 1) * 8; const int pc = 2 * w + (pq >> 1);
              const unsigned ka0 = (unsigned)(size_t)(kb + ((pc ^ q) * 16)), ka1 = (unsigned)(size_t)(kb + 4 * 256 + ((pc ^ (q + 4)) * 16));
              u32x2 r0, r1, r2, r3;
              asm volatile("ds_read_b64_tr_b16 %0, %4\n\tds_read_b64_tr_b16 %1, %5\n\tds_read_b64_tr_b16 %2, %4 offset:8192\n\tds_read_b64_tr_b16 %3, %5 offset:8192\n\ts_waitcnt lgkmcnt(0)\n\ts_nop 1"
                           : "=&v"(r0), "=&v"(r1), "=&v"(r2), "=&v"(r3) : "v"(ka0), "v"(ka1) : "memory");
              const u32x4 k0w = {r0.x, r0.y, r1.x, r1.y}, k1w = {r2.x, r2.y, r3.x, r3.y};
              const bf16x8 kf0 = __builtin_bit_cast(bf16x8, k0w), kf1 = __builtin_bit_cast(bf16x8, k1w);
              bf16x8 f[2][2]; tr_frags64x2<32>((const LAS bf16*)(slot + 32768), 0, (const LAS bf16*)(slot + 32768), 16, lane, f);
              const f32x4 dl = *(const LAS f32x4*)(slot + 36864 + (16 * w + 4 * fq) * 4);
#pragma unroll
              for (int e = 0; e < 2; ++e) {
                  S[e] = __builtin_amdgcn_mfma_f32_16x16x32_bf16(kf0, f[e][0], S[e], 0, 0, 0);
                  S[e] = __builtin_amdgcn_mfma_f32_16x16x32_bf16(kf1, f[e][1], S[e], 0, 0, 0);
                  S[e] = S[e] * dl; } }
            asm volatile("s_waitcnt lgkmcnt(0)" ::: "memory");
            __builtin_amdgcn_s_barrier();
            asm volatile("" ::: "memory");
#pragma unroll
            for (int e = 0; e < 2; ++e) { u32x2 pw; pw.x = pk2(S[e][0], S[e][1]); pw.y = pk2(S[e][2], S[e][3]);
                *(LAS u32x2*)(ST + (16 * e + fr) * LQ + 16 * w + 4 * fq) = pw; }
            asm volatile("s_waitcnt lgkmcnt(0)" ::: "memory");
        }
        asm volatile("s_waitcnt vmcnt(0)" ::: "memory");
        __builtin_amdgcn_s_barrier();
        asm volatile("" ::: "memory");
    }
}

__device__ __forceinline__ void ret_intra_phase(const Fr& F, const bf16* Z, bf16* OI) {
    constexpr int LQ = 256 + 24, LV = 512 + 8, LT = 72;
    LAS bf16* QI = (LAS bf16*)F.lds; LAS bf16* KI = QI + 64 * LQ; LAS bf16* VI = KI + 64 * LQ; LAS bf16* ATT = VI + 64 * LV;
    const int tid = F.tid, lane = F.lane, w = F.wave;
    u32x4 pq[4], pk[4], pv[8];
    auto fetch = [&](int item) { const int uc = 4 + (item & 63), h = (item >> 6) & 7, b = item >> 9; const size_t row0 = (size_t)b * TB + uc * 64;
#pragma unroll
        for (int it = 0; it < 4; ++it) { const int idx = tid + it * NTHR; const int p = idx >> 5, kc = (idx & 31) * 8; const bf16* zr = Z + (row0 + p) * RETC + h * 256 + kc;
            pq[it] = *(const u32x4*)(zr); pk[it] = *(const u32x4*)(zr + D); }
#pragma unroll
        for (int it = 0; it < 8; ++it) { const int idx = tid + it * NTHR; const int p = idx >> 6, vc = (idx & 63) * 8;
            pv[it] = *(const u32x4*)(Z + (row0 + p) * RETC + 2 * D + h * 512 + vc); } };
    if (F.vcu < NB * 8 * 64) fetch(F.vcu);
    for (int item = F.vcu; item < NB * 8 * 64; item += F.G) {
        const int uc = 4 + (item & 63), h = (item >> 6) & 7, b = item >> 9;
        const size_t row0 = (size_t)b * TB + uc * 64;
        const float l2g = log1pf(-exp2f(-5.0f - (float)h)) * 1.4426950408889634f;
#pragma unroll
        for (int it = 0; it < 4; ++it) { const int idx = tid + it * NTHR; const int p = idx >> 5, kc = (idx & 31) * 8;
            *(LAS u32x4*)(QI + p * LQ + kc) = pq[it]; *(LAS u32x4*)(KI + p * LQ + kc) = pk[it]; }
#pragma unroll
        for (int it = 0; it < 8; ++it) { const int idx = tid + it * NTHR; const int p = idx >> 6, vc = (idx & 63) * 8;
            *(LAS u32x4*)(VI + p * LV + vc) = pv[it]; }
        __syncthreads();
        if (item + F.G < NB * 8 * 64) fetch(item + F.G);
        { const int mt = w >> 1;
#pragma unroll
          for (int e = 0; e < 2; ++e) { const int nt = (w & 1) * 2 + e; f32x4 acc = {0.f, 0.f, 0.f, 0.f};
              mma16<8>(acc, QI, LQ, 16 * mt, KI, LQ, 16 * nt, lane);
#pragma unroll
              for (int r = 0; r < 4; ++r) { const int i = 16 * mt + 4 * (lane >> 4) + r, j = 16 * nt + (lane & 15); const int dd = i > j ? i - j : j - i;
                  ATT[i * LT + j] = f2bf(acc[r] * (dd == 0 ? 2.0f : __builtin_amdgcn_exp2f((float)dd * l2g))); } } }
        __syncthreads();
        {
            bf16x8 af[4][2];
#pragma unroll
            for (int mt = 0; mt < 4; ++mt) { const LAS bf16* ap = ATT + (size_t)(16 * mt + (lane & 15)) * LT + 8 * (lane >> 4); af[mt][0] = *(const LAS bf16x8*)ap; af[mt][1] = *(const LAS bf16x8*)(ap + 32); }
#pragma unroll
            for (int vt = 0; vt < 4; ++vt) { bf16x8 vf0, vf1; tr_frags64<LV>(VI, 64 * w + 16 * vt, lane, vf0, vf1);
#pragma unroll
                for (int mt = 0; mt < 4; ++mt) { f32x4 acc = {0.f, 0.f, 0.f, 0.f};
                    acc = __builtin_amdgcn_mfma_f32_16x16x32_bf16(vf0, af[mt][0], acc, 0, 0, 0);
                    acc = __builtin_amdgcn_mfma_f32_16x16x32_bf16(vf1, af[mt][1], acc, 0, 0, 0);
                    u32x2 o; o.x = pk2(acc[0], acc[1]); o.y = pk2(acc[2], acc[3]);
                    *(u32x2*)(OI + (row0 + 16 * mt + (lane & 15)) * 4096 + h * 512 + 64 * w + 16 * vt + 4 * (lane >> 4)) = o; } }
        }
        __syncthreads();
    }
}
__device__ __forceinline__ void ret_scan_phase(const Fr& F, const bf16* Z, bf16* OUT) {
    constexpr int LQ = 256 + 24, LV = 64 + 8;
    LAS bf16* QI = (LAS bf16*)F.lds; LAS bf16* KI = QI + 64 * LQ; LAS bf16* ST = KI + 2 * 64 * LQ; LAS bf16* VI = ST + 64 * LQ;
    static_assert((4 * 64 * LQ + 2 * 64 * LV) * 2 <= LDS_BYTES - 16, "retention scan LDS map");
    const int tid = F.tid, lane = F.lane, w = F.wave;
    for (int unit = F.vcu; unit < NB * 8 * 2 * 8; unit += F.G) {
        const int vs = unit & 7, d = (unit >> 3) & 1, h = (unit >> 4) & 7, b = unit >> 7;
        const size_t rowb = (size_t)b * TB;
        bf16* out = OUT + (size_t)d * M * 4096;
        const float l2g = log1pf(-exp2f(-5.0f - (float)h)) * 1.4426950408889634f;
        const float g64 = __builtin_amdgcn_exp2f(64.0f * l2g);
        const float vsc = __builtin_amdgcn_exp2f((float)(63 - (tid >> 3)) * l2g);
        f32x4 S[2][4];
#pragma unroll
        for (int i = 0; i < 2; ++i)
#pragma unroll
            for (int j = 0; j < 4; ++j) S[i][j] = (f32x4){0.f, 0.f, 0.f, 0.f};
        struct Pre { u32x4 q[4], k[4], v; };
        Pre PA, PB;
        auto tok_of = [&](int ci, int p) { const int uc = (d == 0) ? ci : (ci < 4 ? 3 - ci : 71 - ci); return (d == 0) ? uc * 64 + p : uc * 64 + 63 - p; };
        auto prefetch = [&](int ci_, Pre& P) { const int ci = ci_ < TB / 64 ? ci_ : TB / 64 - 1;
#pragma unroll
            for (int it = 0; it < 4; ++it) { const int idx = tid + it * NTHR; const int p = idx >> 5, kc = (idx & 31) * 8; const bf16* zr = Z + (rowb + tok_of(ci, p)) * RETC + h * 256 + kc;
                P.q[it] = *(const u32x4*)(zr); P.k[it] = *(const u32x4*)(zr + D); }
            { const int p = tid >> 3, vc = (tid & 7) * 8; P.v = *(const u32x4*)(Z + (rowb + tok_of(ci, p)) * RETC + 2 * D + h * 512 + vs * 64 + vc); }
        };
        auto stage_kv = [&](int buf, const Pre& P) {
            LAS bf16* KB = KI + buf * (64 * LQ); LAS bf16* VB = VI + buf * (64 * LV);
#pragma unroll
            for (int it = 0; it < 4; ++it) { const int idx = tid + it * NTHR; const int p = idx >> 5, kc = (idx & 31) * 8; *(LAS u32x4*)(KB + p * LQ + kc) = P.k[it]; }
            { const int p = tid >> 3, vc = (tid & 7) * 8; float v8[8]; unpack8(P.v, v8);
#pragma unroll
              for (int i = 0; i < 8; ++i) v8[i] *= vsc;
              *(LAS u32x4*)(VB + p * LV + vc) = pack8(v8); } };
        auto step = [&](int ci, Pre& P, Pre& Pn) {
            const bool do_out = ci >= 4; const int buf = ci & 1;
            const LAS bf16* KB = KI + buf * (64 * LQ); const LAS bf16* VB = VI + buf * (64 * LV);
            if (do_out) {
#pragma unroll
                for (int it = 0; it < 4; ++it) { const int idx = tid + it * NTHR; const int p = idx >> 5, kc = (idx & 31) * 8; *(LAS u32x4*)(QI + p * LQ + kc) = P.q[it]; } }
#pragma unroll
            for (int ki = 0; ki < 2; ++ki)
#pragma unroll
                for (int vt = 0; vt < 4; ++vt) { u32x2 pw; pw.x = pk2(S[ki][vt][0], S[ki][vt][1]); pw.y = pk2(S[ki][vt][2], S[ki][vt][3]);
                    *(LAS u32x2*)(ST + (16 * vt + (lane & 15)) * LQ + 16 * (2 * w + ki) + 4 * (lane >> 4)) = pw; }
            __syncthreads();
            prefetch(ci + 2, P);
            __builtin_amdgcn_s_waitcnt(0xF79);
            stage_kv(buf ^ 1, Pn);
            if (do_out) {
                const int vt = w >> 1;
#pragma unroll
                for (int e = 0; e < 2; ++e) { const int nt = 2 * (w & 1) + e; f32x4 acc = {0.f, 0.f, 0.f, 0.f};
                    mma16<8>(acc, ST, LQ, 16 * vt, QI, LQ, 16 * nt, lane);
                    const int p = 16 * nt + (lane & 15); const float sc = __builtin_amdgcn_exp2f((float)(p + 1) * l2g);
                    u32x2 o; o.x = pk2(acc[0] * sc, acc[1] * sc); o.y = pk2(acc[2] * sc, acc[3] * sc);
                    *(u32x2*)(out + (rowb + tok_of(ci, p)) * 4096 + h * 512 + vs * 64 + 16 * vt + 4 * (lane >> 4)) = o; }
            }
            {
                bf16x8 vf[4][2]; tr_frags64x4<LV>(VB, 0, VB, 16, VB, 32, VB, 48, lane, vf);
                bf16x8 kf[2][2]; tr_frags64x2<LQ>(KB, 16 * (2 * w), KB, 16 * (2 * w + 1), lane, kf);
#pragma unroll
                for (int ki = 0; ki < 2; ++ki) {
#pragma unroll
                    for (int vt = 0; vt < 4; ++vt) {
#pragma unroll
                        for (int r = 0; r < 4; ++r) S[ki][vt][r] *= g64;
                        S[ki][vt] = __builtin_amdgcn_mfma_f32_16x16x32_bf16(kf[ki][0], vf[vt][0], S[ki][vt], 0, 0, 0);
                        S[ki][vt] = __builtin_amdgcn_mfma_f32_16x16x32_bf16(kf[ki][1], vf[vt][1], S[ki][vt], 0, 0, 0); } }
            }
            __syncthreads();
        };
        prefetch(0, PA); prefetch(1, PB);
        __builtin_amdgcn_s_waitcnt(0xF79);
        stage_kv(0, PA);
        static_assert((TB / 64) % 2 == 0, "the chunk loop is unrolled by two");
#pragma unroll 1
        for (int ci = 0; ci < TB / 64; ci += 2) { step(ci, PA, PB); step(ci + 1, PB, PA); }
        __builtin_amdgcn_s_waitcnt(0xF70);
    }
}

__device__ __forceinline__ void finish0_phase(const Fr& F, const Args& a) {
    unsigned char* ws = a.ws;
    const bf16* Z = (const bf16*)(ws + WS_ZR);
    const bf16* R = (const bf16*)(ws + WS_MIX + MX_R); const bf16* V = (const bf16*)(ws + WS_MIX + MX_V); const bf16* Km = (const bf16*)(ws + WS_MIX + MX_K); const bf16* Gg = (const bf16*)(ws + WS_MIX + MX_G);
    const bf16* YA = (const bf16*)(ws + WS_MIX + MX_YA); const bf16* YB = (const bf16*)(ws + WS_MIX + MX_YB); const bf16* OC2 = (const bf16*)(ws + WS_MIX + MX_DEC);
    bf16* A2 = (bf16*)a.out;
    const float* rk = a.in[I_RK]; const float* lnw = a.in[I_LNW]; const float* lnb = a.in[I_LNB]; const float* glag = a.in[I_GLAG];
    const int gw = F.vcu * NWAVES + F.wave, NGW = F.G * NWAVES, lane = F.lane;
    for (int m = gw; m < M; m += NGW) {
        const size_t ro = (size_t)m * MIXA + 16 * lane;
        const Raw16 qy0 = ld16raw(YA + ro, true), qy1 = ld16raw(YA + (size_t)M * MIXA + ro, true), qr = ld16raw(R + ro, true), qk = ld16raw(Km + ro, true), qv = ld16raw(V + ro, true), qg = ld16raw(Gg + ro, true);
        const Raw16 pb0 = ld16raw(YB + ro, true), pb1 = ld16raw(YB + (size_t)M * MIXA + ro, true), pgt = ld16raw(Z + (size_t)m * ZLD0 + GR + 16 * lane, true), pc0 = ld16raw(OC2 + ro, true), pc1 = ld16raw(OC2 + (size_t)M * MIXA + ro, true);
        {
            float y0[16], y1[16], y[16], r[16], k[16], v[16], g[16], o[16];
            unpack16(qy0, y0); unpack16(qy1, y1); unpack16(qr, r); unpack16(qk, k); unpack16(qv, v); unpack16(qg, g);
            float s = 0.f, bs = 0.f;
#pragma unroll
            for (int q = 0; q < 4; ++q) { const f32x4 rkv = *(const f32x4*)(rk + 16 * lane + 4 * q);
#pragma unroll
                for (int i = 0; i < 4; ++i) { const int e = 4 * q + i; y[e] = y0[e] + y1[e]; s += y[e]; bs += r[e] * k[e] * rkv[i]; } }
            s = quad_sum(s); bs = quad_sum(bs);
            const float mean = s * (1.0f / 64.0f); float q2 = 0.f;
#pragma unroll
            for (int e = 0; e < 16; ++e) { const float dd = y[e] - mean; q2 += dd * dd; }
            q2 = quad_sum(q2);
            const float rstd = rsqrtf(q2 * (1.0f / 64.0f) + GN_EPS);
#pragma unroll
            for (int q = 0; q < 4; ++q) { const f32x4 lw = *(const f32x4*)(lnw + 16 * lane + 4 * q), lb = *(const f32x4*)(lnb + 16 * lane + 4 * q);
#pragma unroll
                for (int i = 0; i < 4; ++i) { const int e = 4 * q + i; o[e] = ((y[e] - mean) * rstd * lw[i] + lb[i] + bs * v[e]) * g[e]; } }
            store16(A2 + (size_t)m * D + 16 * lane, o);
        }
        {
            float y0[16], y1[16], y[16], gt[16], o[16];
            unpack16(pb0, y0); unpack16(pb1, y1); unpack16(pgt, gt);
            float c0[16], c1[16]; unpack16(pc0, c0); unpack16(pc1, c1);
            float s = 0.f;
#pragma unroll
            for (int e = 0; e < 16; ++e) { y[e] = (y0[e] + y1[e]) + (c0[e] + c1[e]); s += y[e] * y[e]; }
            s = row16_sum(s);
            const float rstd = rsqrtf(s * (1.0f / 256.0f) + RMS_EPS);
#pragma unroll
            for (int q = 0; q < 4; ++q) { const f32x4 gg = *(const f32x4*)(glag + ((16 * lane) & 255) + 4 * q);
#pragma unroll
                for (int i = 0; i < 4; ++i) { const int e = 4 * q + i; o[e] = y[e] * rstd * gg[i] * fsilu(gt[e]); } }
            store16(A2 + (size_t)m * D + MIXA + 16 * lane, o);
        }
    }
}
__device__ __forceinline__ void finish1_phase(const Fr& F, const Args& a) {
    unsigned char* ws = a.ws;
    const bf16* Z = (const bf16*)(ws + WS_ZR); const bf16* OC = (const bf16*)(ws + WS_MIX + MX_OC); bf16* A3 = (bf16*)(ws + WS_MIX + MX_A3);
    const int gw = F.vcu * NWAVES + F.wave, NGW = F.G * NWAVES, lane = F.lane;
    for (int m = gw; m < M; m += NGW) {
        if ((m % TB) < CTX) continue;
#pragma unroll
        for (int hb = 0; hb < 2; ++hb) {
            u32x4 q0[4], q1[4], q2[4], qg[4];
#pragma unroll
            for (int j = 0; j < 4; ++j) { const int h = 4 * hb + j; const size_t off = (size_t)m * 4096 + h * 512 + 8 * lane;
                q0[j] = *(const u32x4*)(OC + off); q1[j] = *(const u32x4*)(OC + (size_t)M * 4096 + off); q2[j] = *(const u32x4*)(A3 + off);
                qg[j] = *(const u32x4*)(Z + (size_t)m * RETC + 8192 + h * 512 + 8 * lane); }
#pragma unroll
            for (int j = 0; j < 4; ++j) { const int h = 4 * hb + j; const size_t off = (size_t)m * 4096 + h * 512 + 8 * lane;
                float o0[8], o1[8], o2[8], g[8], o[8];
                unpack8(q0[j], o0); unpack8(q1[j], o1); unpack8(q2[j], o2); unpack8(qg[j], g);
                float s = 0.f;
#pragma unroll
                for (int e = 0; e < 8; ++e) { o[e] = (o0[e] + o1[e]) + o2[e]; s += o[e] * o[e]; }
                const float rstd = rsqrtf(wave_sum(s) * (1.0f / 512.0f) + RMS_EPS);
#pragma unroll
                for (int e = 0; e < 8; ++e) o[e] = o[e] * rstd * fsilu(g[e]);
                *(u32x4*)(A3 + off) = pack8(o); }
        }
    }
}

constexpr int N_PHASES = 23;
__global__ void __launch_bounds__(NTHR, 2) mega(Args a) {
    extern __shared__ __attribute__((aligned(16))) unsigned char lds_raw[];
    Fr F; F.lds = (LAS unsigned char*)lds_raw; F.tid = threadIdx.x; F.lane = F.tid & 63; F.wave = __builtin_amdgcn_readfirstlane(F.tid >> 6);
    F.G = gridDim.x; { const int bx = blockIdx.x; F.vcu = (F.G % 8 == 0) ? (bx % 8) * (F.G / 8) + bx / 8 : bx; }
    const int wave0 = F.wave;
#define REFRAME() do { const int _l = lane_id_opaque(); int _w = wave0; asm volatile("" : "+s"(_w)); F.lane = _l; F.wave = _w; F.tid = _w * 64 + _l; } while (0)
    unsigned char* ws = a.ws;
    const int lo = a.ph_lo, hi = a.ph_hi;
#if MK_ONE_LAUNCH
    volatile LAS unsigned* bst = (volatile LAS unsigned*)(F.lds + LDS_BYTES - 16);
    if (F.tid < 4) bst[F.tid] = 0u;
    __syncthreads();
    XcdBarrier bar = xcd_barrier_post((unsigned*)(ws + WS_CTL) + 4096, bst);
#define GRID_BAR() xcd_barrier(bar)
#else
#define GRID_BAR() do { } while (0)
#endif
#define IN(k) (lo <= (k) && (k) < hi)
#if MK_ONE_LAUNCH
#define SEAM(k) do { if (IN(k) && IN((k) + 1)) { GRID_BAR(); } } while (0)
#else
#define SEAM(k) do { } while (0)
#endif
    const float* modv = (const float*)(ws + WS_MODV);
    const float* ng = a.in[I_NG];
    bf16* ABF = (bf16*)a.out;
    const int bx = blockIdx.x;

    if (IN(0)) { REFRAME(); p0_prologue(F, a); } SEAM(0);
    if (IN(1)) { REFRAME(); rows_phase(F, a, 0, 0, true, nullptr, nullptr, false, ng + 0 * D, modv + 0 * D, modv + 1 * D); } SEAM(1);
    if (IN(2)) { REFRAME(); pg8::Gemm g{ABF, (const bf16*)(ws + WS_WAB), D, D, D}; pg8::StaticOrder S; S.init(M / 256, ZLD0 / 256, F.G, bx, 0, D / 64);
        pg8::EpiBf16 E{(bf16*)(ws + WS_ZR), ZLD0, 0}; pg8::gemm_phase(F.lds, g, S, E, F.tid);
        REFRAME(); __syncthreads(); conv_dyn(F, a, (unsigned*)(ws + WS_CTL) + 2048, 1, 3); } SEAM(2);
    if (IN(3)) { REFRAME(); prep_phase(F, a); } SEAM(3);
    if (IN(4)) { REFRAME();
        pg8::Gemm g{(const bf16*)(ws + WS_MIX + MX_ALO), (const bf16*)(ws + WS_WLO), 512, 512, 256};
        { pg8::StaticOrder S; S.init(M / 256, 8, F.G, bx, 0, 4, 0, 0); pg8::EpiDec E{(float*)(ws + WS_MIX + MX_DEC), a.in[I_W0]}; pg8::gemm_phase(F.lds, g, S, E, F.tid); }
        REFRAME();
        { pg8::StaticOrder S; S.init(M / 256, 4, F.G, (bx + 16) % F.G, 0, 4, 8, 0);
          pg8::EpiLr E{(bf16*)(ws + WS_MIX + MX_K), (const bf16*)(ws + WS_MIX + MX_KK), (bf16*)(ws + WS_MIX + MX_BV), a.in[I_A0], a.in[I_KA]}; pg8::gemm_phase(F.lds, g, S, E, F.tid); }
        REFRAME();
        { pg8::StaticOrder S; S.init(M / 256, 4, F.G, (bx + 16 + 136) % F.G, 0, 4, 12, 256); pg8::EpiBf16 E{(bf16*)(ws + WS_MIX + MX_G), MIXA, 12 * 256}; pg8::gemm_phase(F.lds, g, S, E, F.tid); }
    } SEAM(4);
    if (IN(5)) { REFRAME();
        if (F.vcu < 208) rwkv_pre_phase(F, a, F.vcu, 208);
        else gla_pre_phase(F, a, F.vcu - 208, F.G - 208);
    } SEAM(5);
    if (IN(6)) { REFRAME();
        if (F.vcu < 64) rwkv_seq_phase(F, a, F.vcu, 64);
        else if (F.vcu < 192) gla_seq_phase(F, a, F.vcu - 64, 128);
        REFRAME(); __syncthreads();
        conv_dyn(F, a, (unsigned*)(ws + WS_CTL) + 2112, 4, 5);
    } SEAM(6);
    if (IN(9)) { REFRAME(); finish0_phase(F, a); } SEAM(9);
    if (IN(10)) { REFRAME(); pg8::Gemm g{ABF, (const bf16*)(ws + WS_WO0), D, D, D}; pg8::StaticOrder S; S.init(32, D / 256, F.G, bx, 3, D / 64, 0, 0, 8);
        pg8::EpiF32 E{(bf16*)(ws + WS_MIX + MX_Y), D, (float*)(ws + WS_YC)}; pg8::gemm_phase(F.lds, g, S, E, F.tid); } SEAM(10);
    if (IN(11)) { REFRAME(); rows_phase(F, a, 1, 8, true, ng + 1 * D, modv + 2 * D, false, ng + 2 * D, modv + 3 * D, modv + 4 * D); } SEAM(11);
    if (IN(12)) { REFRAME(); pg8::Gemm g{ABF, (const bf16*)(ws + WS_WFI0), D, D, D}; pg8::StaticOrder S; S.init(M / 256, 2 * DFF / 256, F.G, bx, 0, D / 64);
        pg8::EpiSwiglu E{(bf16*)(ws + WS_ZR), DFF}; pg8::gemm_phase(F.lds, g, S, E, F.tid);
        REFRAME(); __syncthreads(); conv_dyn(F, a, (unsigned*)(ws + WS_CTL) + 2304, 3, 4); } SEAM(12);
    if (IN(13)) { REFRAME(); pg8::Gemm g{(const bf16*)(ws + WS_ZR), (const bf16*)(ws + WS_WFO0), DFF, DFF, DFF}; pg8::StaticOrder S; S.init(32, D / 256, F.G, bx, 3, DFF / 64, 0, 0, 11);
        pg8::EpiF32 E{(bf16*)(ws + WS_MIX + MX_Y), D, (float*)(ws + WS_YC)}; pg8::gemm_phase(F.lds, g, S, E, F.tid);
        REFRAME(); __syncthreads(); conv_dyn(F, a, (unsigned*)(ws + WS_CTL) + 2432, 5, 6); } SEAM(13);
    if (IN(14)) { REFRAME(); rows_phase(F, a, 1, 11, false, ng + 3 * D, modv + 5 * D, false, ng + 4 * D, modv + 3 * 12288 + 0 * D, modv + 3 * 12288 + 1 * D); } SEAM(14);
    if (IN(15)) { REFRAME(); pg8::Gemm g{ABF, (const bf16*)(ws + WS_WRI), D, D, D}; pg8::StaticOrder S; S.init(M / 256, RETC / 256, F.G, bx, 0, D / 64);
        pg8::EpiRet E{(bf16*)(ws + WS_ZR), RETC, (const float*)(ws + WS_ROT)}; pg8::gemm_phase(F.lds, g, S, E, F.tid);
        REFRAME(); __syncthreads(); conv_dyn(F, a, (unsigned*)(ws + WS_CTL) + 2176, 6, 7); } SEAM(15);
    if (IN(16)) { REFRAME();
        ret_intra_phase(F, (const bf16*)(ws + WS_ZR), (bf16*)(ws + WS_MIX + MX_A3));
        REFRAME(); __syncthreads();
        ret_scan_phase(F, (const bf16*)(ws + WS_ZR), (bf16*)(ws + WS_MIX + MX_OC)); } SEAM(16);
    if (IN(17)) { REFRAME(); finish1_phase(F, a); } SEAM(17);
    const bool fuse_rows = (F.G == 256) && MK_ONE_LAUNCH;
    unsigned* xcnt = (unsigned*)(ws + WS_CTL + 65536); float* xslot = (float*)(ws + WS_CTL + 131072); unsigned* xtmo = (unsigned*)(ws + WS_CTL) + 4096 + XB_TMO;
    if (IN(18)) { REFRAME(); pg8::Gemm g{(const bf16*)(ws + WS_MIX + MX_A3), (const bf16*)(ws + WS_WRO), 2 * D, 2 * D, 2 * D}; pg8::StaticOrder S; S.init(32, D / 256, F.G, bx, 1, 2 * D / 64);
        if (fuse_rows) {
            pg8::NormX x1{xslot, xcnt, xtmo}, x2{xslot + 34 * 256 * 8, xcnt + 34 * 64, xtmo};
            pg8::EpiNorm E{(bf16*)(ws + WS_H), ABF, nullptr, modv + 3 * 12288 + 2 * D, ng + 5 * D, ng + 6 * D, modv + 3 * 12288 + 3 * D, modv + 3 * 12288 + 4 * D, false, x1, x2};
            pg8::gemm_phase(F.lds, g, S, E, F.tid);
        } else { pg8::EpiF32 E{(bf16*)(ws + WS_MIX + MX_Y), D, (float*)(ws + WS_YC)}; pg8::gemm_phase(F.lds, g, S, E, F.tid); } } SEAM(18);
    if (!fuse_rows) { if (IN(19)) { REFRAME(); rows_phase(F, a, 1, 0, false, ng + 5 * D, modv + 3 * 12288 + 2 * D, false, ng + 6 * D, modv + 3 * 12288 + 3 * D, modv + 3 * 12288 + 4 * D); } SEAM(19); }
    if (IN(20)) { REFRAME(); pg8::Gemm g{ABF, (const bf16*)(ws + WS_WFI1), D, D, D}; pg8::StaticOrder S; S.init(32, 2 * DFF / 256, F.G, bx, 1, D / 64);
        pg8::EpiSwiglu E{(bf16*)(ws + WS_ZR), DFF}; pg8::gemm_phase(F.lds, g, S, E, F.tid);
        REFRAME(); __syncthreads(); conv_dyn(F, a, (unsigned*)(ws + WS_CTL) + 2240, 7, 8); } SEAM(20);
    if (IN(21)) { REFRAME(); pg8::Gemm g{(const bf16*)(ws + WS_ZR), (const bf16*)(ws + WS_WFO1), DFF, DFF, DFF}; pg8::StaticOrder S; S.init(32, D / 256, F.G, bx, 1, DFF / 64);
        if (fuse_rows) {
            pg8::NormX x1{xslot + 2 * 34 * 256 * 8, xcnt + 2 * 34 * 64, xtmo};
            pg8::EpiNorm E{(bf16*)(ws + WS_H), nullptr, a.out, modv + 3 * 12288 + 5 * D, ng + 7 * D, nullptr, nullptr, nullptr, true, x1, x1};
            pg8::gemm_phase(F.lds, g, S, E, F.tid);
        } else { pg8::EpiF32 E{(bf16*)(ws + WS_MIX + MX_Y), D, (float*)(ws + WS_YC)}; pg8::gemm_phase(F.lds, g, S, E, F.tid); } }
    if (!fuse_rows) { SEAM(21);
    if (IN(22)) { REFRAME(); rows_phase(F, a, 1, 0, false, ng + 7 * D, modv + 3 * 12288 + 5 * D, true, nullptr, nullptr, nullptr); } }
#undef IN
#undef SEAM
}


extern "C" void kernel_launch(void* const* d_in, const int* in_sizes, int n_in, void* d_out, int out_size, void* d_ws, size_t ws_size, hipStream_t stream) {
    static int grid = 0;
    if (grid == 0) {
        if (n_in != 27 || ws_size < WS_END) { fprintf(stderr, "kernel_launch: unexpected n_in %d or ws_size %zu (need %zu)\n", n_in, ws_size, (size_t)WS_END); grid = -1; return; }
        int dev = 0, cus = 0, per_cu = 0;
        (void)hipGetDevice(&dev); (void)hipDeviceGetAttribute(&cus, hipDeviceAttributeMultiprocessorCount, dev);
        if (hipFuncSetAttribute((const void*)mega, hipFuncAttributeMaxDynamicSharedMemorySize, LDS_BYTES) != hipSuccess) { fprintf(stderr, "kernel_launch: hipFuncSetAttribute failed\n"); grid = -1; return; }
        if (hipOccupancyMaxActiveBlocksPerMultiprocessor(&per_cu, (const void*)mega, NTHR, LDS_BYTES) != hipSuccess || per_cu < 1) { fprintf(stderr, "kernel_launch: occupancy query says %d\n", per_cu); per_cu = 1; }
        (void)hipGetLastError();
        grid = cus;
    }
    if (grid < 0) return;
    Args a{};
    for (int i = 0; i < 27; ++i) a.in[i] = (const float*)d_in[i];
    a.out = (float*)d_out; a.ws = (unsigned char*)d_ws;
#if MK_ONE_LAUNCH
    (void)hipMemsetAsync((char*)d_ws + WS_CTL, 0, 128 * 1024, stream);
    a.ph_lo = 0; a.ph_hi = N_PHASES;
    void* args[] = {&a};
    hipError_t e = hipLaunchCooperativeKernel((const void*)mega, dim3(grid), dim3(NTHR), args, LDS_BYTES, stream);
    if (e != hipSuccess) fprintf(stderr, "cooperative launch failed: %s (grid %d)\n", hipGetErrorString(e), grid);
#else
    for (int p = 0; p < N_PHASES; ++p) {
        a.ph_lo = p; a.ph_hi = p + 1;
        hipLaunchKernelGGL(mega, dim3(grid), dim3(NTHR), LDS_BYTES, stream, a);
    }
#endif
}
```

```cpp
#include <hip/hip_runtime.h>
#include <hip/hip_cooperative_groups.h>
#include <cstdio>
#include <cstdint>
namespace cg = cooperative_groups;

#ifndef MK_ONE_LAUNCH
#define MK_ONE_LAUNCH 1
#endif

#define LAS __attribute__((address_space(3)))
typedef unsigned short bf16;
typedef short bf16x8 __attribute__((ext_vector_type(8)));
typedef float f32x4 __attribute__((ext_vector_type(4)));
typedef float f32x2 __attribute__((ext_vector_type(2)));
typedef unsigned u32x4 __attribute__((ext_vector_type(4)));
typedef unsigned u32x2 __attribute__((ext_vector_type(2)));

constexpr int D = 2048, NB = 2, SEQ = 4096, CTX = 256, TB = CTX + SEQ  , M = NB * TB  ;
constexpr int DFF = 5632, MIXA = 1024, ACOLS = 3520, ABCOLS = 6608, ZLD0 = 6656, RETC = 12288;
constexpr int GQ = 3520, GK = 4032, GV = 4544, GR = 5568, GGD = 6592;
constexpr float RMS_EPS = 1e-6f, GN_EPS = 64e-5f;
constexpr int NWAVES = 8, NTHR = 512;
constexpr int LDS_BYTES = 160 * 1024;

constexpr size_t MiB = 1u << 20;
constexpr size_t SZ_WAB = (size_t)ZLD0 * D * 2, SZ_WO0 = (size_t)D * D * 2, SZ_WFI = (size_t)2 * DFF * D * 2, SZ_WFO = (size_t)D * DFF * 2,
                 SZ_WRI = (size_t)RETC * D * 2, SZ_WRO = (size_t)D * 2 * D * 2, SZ_WLO = (size_t)4096 * 512 * 2;
constexpr size_t WS_CTL = 0;
constexpr size_t WS_WAB = 1 * MiB;
constexpr size_t WS_WO0 = WS_WAB + SZ_WAB;
constexpr size_t WS_WFI0 = WS_WO0 + SZ_WO0;
constexpr size_t WS_WFI1 = WS_WFI0 + SZ_WFI;
constexpr size_t WS_WFO0 = WS_WFI1 + SZ_WFI;
constexpr size_t WS_WFO1 = WS_WFO0 + SZ_WFO;
constexpr size_t WS_WRI = WS_WFO1 + SZ_WFO;
constexpr size_t WS_WRO = WS_WRI + SZ_WRI;
constexpr size_t WS_WLO = WS_WRO + SZ_WRO;
constexpr size_t WS_MODV = WS_WLO + SZ_WLO;
constexpr size_t WS_ROT = WS_MODV + 512 * 1024;
constexpr size_t WS_H = WS_ROT + 512 * 1024;
constexpr size_t SZ_H = (size_t)M * D * 4;
constexpr size_t WS_ZR = WS_H + SZ_H;
constexpr size_t SZ_ZR = (size_t)M * RETC * 2;
constexpr size_t RW_ITEMS = (size_t)NB * 16 * (TB / 64);
constexpr size_t WS_RWG = WS_ZR + (size_t)M * ZLD0 * 2;
constexpr size_t WS_RWP = WS_RWG + RW_ITEMS * 8192;
constexpr size_t WS_RWY = WS_RWP + RW_ITEMS * 8192;
constexpr size_t WS_RWQ = WS_RWY + RW_ITEMS * 8192;
constexpr size_t GLA_ITEMS = (size_t)NB * 4 * 2 * (TB / 64);
constexpr size_t WS_GKI = WS_RWQ + RW_ITEMS * 8192;
constexpr size_t WS_GDL = WS_GKI + GLA_ITEMS * 16384;
constexpr size_t DO_GQI = (size_t)M * D * 2;
static_assert(WS_GDL + GLA_ITEMS * 512 <= WS_ZR + SZ_ZR, "RWKV chunk operators (direction 0) + GLA k_in must fit in the tail of the Z region");
static_assert(DO_GQI + GLA_ITEMS * 16384 <= (size_t)NB * SEQ * D * 4, "GLA q_in must fit in d_out behind ABF");
static_assert(RW_ITEMS * 8192 * 4 <= SZ_H, "RWKV chunk operators (direction 1) live in the residual-stream buffer H, which is first written after the mixer");
constexpr size_t WS_MIX = WS_ZR + SZ_ZR;
constexpr size_t SZ_T = (size_t)M * MIXA * 2;
constexpr size_t MX_Y = 0;
constexpr size_t MX_R = 0, MX_V = SZ_T, MX_K = 2 * SZ_T, MX_KK = 3 * SZ_T, MX_BV = 4 * SZ_T, MX_G = 5 * SZ_T;
constexpr size_t MX_DEC = 6 * SZ_T;
constexpr size_t MX_ALO = MX_DEC + 4 * SZ_T;
constexpr size_t MX_YA = MX_ALO + SZ_T / 2;
constexpr size_t MX_YB = MX_YA + 2 * SZ_T;
constexpr size_t SZ_MIX0 = MX_YB + 2 * SZ_T;
constexpr size_t MX_YC = 80 * MiB;
constexpr size_t WS_YC = WS_MIX + MX_YC;
static_assert(MX_YC >= (size_t)M * D * 4 && MX_YC + (size_t)11 * NB * CTX * D * 4 <= SZ_MIX0, "split-K slabs inside the mixer scratch, above Y");
constexpr size_t MX_OC = 0;
constexpr size_t MX_A3 = (size_t)2 * M * 4096 * 2;
constexpr size_t SZ_MIX1 = MX_A3 + (size_t)M * 4096 * 2;
constexpr size_t SZ_MIX = SZ_MIX0 > SZ_MIX1 ? SZ_MIX0 : SZ_MIX1;
constexpr size_t WS_END = WS_MIX + SZ_MIX;
static_assert(WS_END <= (size_t)768 * MiB, "workspace map exceeds 768 MiB");
static_assert((size_t)M * D * 2 <= (size_t)NB * SEQ * D * 4, "ABF must fit in d_out");

__device__ __forceinline__ float bf2f(unsigned v) { return __uint_as_float(v << 16); }
__device__ __forceinline__ float bflo(unsigned w) { return __uint_as_float(w << 16); }
__device__ __forceinline__ float bfhi(unsigned w) { return __uint_as_float(w & 0xffff0000u); }
typedef __bf16 bf16x2_t __attribute__((ext_vector_type(2)));
__device__ __forceinline__ unsigned pk2(float lo, float hi) { const f32x2 v = {lo, hi}; const bf16x2_t r = __builtin_convertvector(v, bf16x2_t); return __builtin_bit_cast(unsigned, r); }
__device__ __forceinline__ bf16 f2bf(float f) { return (bf16)(pk2(f, 0.f) & 0xffffu); }
__device__ __forceinline__ int lane_id_opaque() { int l; asm volatile("v_mbcnt_lo_u32_b32 %0, -1, 0\n\tv_mbcnt_hi_u32_b32 %0, -1, %0" : "=v"(l)); return l; }
__device__ __forceinline__ float wave_sum(float v) {
    v += __int_as_float(__builtin_amdgcn_update_dpp(0, __float_as_int(v), 0xB1, 0xF, 0xF, false));
    v += __int_as_float(__builtin_amdgcn_update_dpp(0, __float_as_int(v), 0x4E, 0xF, 0xF, false));
    v += __int_as_float(__builtin_amdgcn_update_dpp(0, __float_as_int(v), 0x141, 0xF, 0xF, false));
    v += __int_as_float(__builtin_amdgcn_update_dpp(0, __float_as_int(v), 0x140, 0xF, 0xF, false));
    const int iv = __float_as_int(v);
    return (__int_as_float(__builtin_amdgcn_readlane(iv, 0)) + __int_as_float(__builtin_amdgcn_readlane(iv, 16))) + (__int_as_float(__builtin_amdgcn_readlane(iv, 32)) + __int_as_float(__builtin_amdgcn_readlane(iv, 48)));
}
__device__ __forceinline__ float quad_sum(float v) {
    v += __int_as_float(__builtin_amdgcn_update_dpp(0, __float_as_int(v), 0xB1, 0xF, 0xF, false));
    v += __int_as_float(__builtin_amdgcn_update_dpp(0, __float_as_int(v), 0x4E, 0xF, 0xF, false));
    return v;
}
__device__ __forceinline__ float row16_sum(float v) {
    v = quad_sum(v);
    v += __int_as_float(__builtin_amdgcn_update_dpp(0, __float_as_int(v), 0x141, 0xF, 0xF, false));
    v += __int_as_float(__builtin_amdgcn_update_dpp(0, __float_as_int(v), 0x140, 0xF, 0xF, false));
    return v;
}
__device__ __forceinline__ float fexp(float x) { return __builtin_amdgcn_exp2f(x * 1.4426950408889634f); }
__device__ __forceinline__ float flog(float x) { return __builtin_amdgcn_logf(x) * 0.6931471805599453f; }
__device__ __forceinline__ float fsigmoid(float x) { return __builtin_amdgcn_rcpf(1.0f + fexp(-x)); }
__device__ __forceinline__ float fsilu(float x) { return x * __builtin_amdgcn_rcpf(1.0f + fexp(-x)); }
__device__ __forceinline__ float flogsigmoid(float x) { return -(fmaxf(-x, 0.f) + flog(1.0f + fexp(-fabsf(x)))); }
__device__ __forceinline__ void unpack8(const u32x4 w, float (&o)[8]) {
    o[0] = bflo(w.x); o[1] = bfhi(w.x); o[2] = bflo(w.y); o[3] = bfhi(w.y); o[4] = bflo(w.z); o[5] = bfhi(w.z); o[6] = bflo(w.w); o[7] = bfhi(w.w);
}
__device__ __forceinline__ u32x4 pack8(const float (&v)[8]) { u32x4 w; w.x = pk2(v[0], v[1]); w.y = pk2(v[2], v[3]); w.z = pk2(v[4], v[5]); w.w = pk2(v[6], v[7]); return w; }

namespace pg8 {
#define PG8_LAS __attribute__((address_space(3)))
typedef unsigned short bf16_t;
constexpr int BM = 256, BK = 64, HALF = 128, HTB = HALF * BK * 2, STAGE_BYTES = 8 * HTB, NXCD = 8, WGM = 4;
__host__ __device__ __forceinline__ int lds_byte(int r, int c) { const int st = (r >> 4) * 2 + (c >> 5), rr = r & 15, cc = c & 31, ob = rr * 64 + cc * 2; return st * 1024 + (ob ^ (((ob >> 9) & 1) << 5)); }
__host__ __device__ __forceinline__ void stage_rc(int b, int& R, int& C) { const int st = b / 1024, sb = b % 1024, swz = sb ^ (((sb >> 9) & 1) << 5); R = (st >> 1) * 16 + swz / 64; C = (st & 1) * 32 + (swz % 64) / 2; }
__host__ __device__ __forceinline__ int perm32(int rho) { const int n = rho >> 4, i = rho & 15; return 8 * (i >> 2) + 4 * n + (i & 3); }

struct Unit { int pm, pn, ko, nk, part; };
struct Gemm { const bf16_t* A; const bf16_t* Bt; int lda, ldb, K; };

struct StaticOrder {
    int nM, nN, nwg, G, c, mode, pn0, ko, nk, S;
    __device__ void init(int nM_, int nN_, int G_, int c_, int mode_, int nk_, int pn0_ = 0, int ko_ = 0, int S_ = 1) { nM = nM_; nN = nN_; nwg = nM * nN; G = G_; c = c_; mode = mode_; pn0 = pn0_; ko = ko_; nk = nk_; S = S_; }
    __device__ bool next(int i, Unit& u) const {
        const long L = (long)i * G + c;
        if (mode == 3 && L >= nwg) {
            const int j = (int)(L - nwg); if (j >= 16 * S) return false;
            const int tile = j / S, part = j % S;
            u.pm = (tile >> 3) ? 17 : 0; u.pn = tile & 7; u.nk = nk / S; u.ko = part * (nk / S) * 64; u.part = part + 1; return true;
        }
        if (L >= nwg) return false;
        int wgid = (int)L; { const int q = nwg / NXCD, r = nwg % NXCD, xcd = wgid % NXCD, off = wgid / NXCD; wgid = (xcd < r ? xcd * (q + 1) : r * (q + 1) + (xcd - r) * q) + off; }
        const int nig = WGM * nN, gid = wgid / nig, fm = gid * WGM, gsz = (nM - fm) < WGM ? (nM - fm) : WGM;
        u.pm = fm + ((wgid % nig) % gsz); u.pn = (wgid % nig) / gsz + pn0; u.ko = ko; u.nk = nk; u.part = 0;
        if (mode == 1 || mode == 3) u.pm = u.pm + 1 + (u.pm >= 16 ? 1 : 0);
        return true;
    }
};

template <class Epi, class Sched, bool ALIGN_EPI = true>
__device__ __forceinline__ void gemm_phase(PG8_LAS unsigned char* lds, const Gemm g, const Sched& S, const Epi& E, const int tid) {
    const int wid = __builtin_amdgcn_readfirstlane(tid >> 6), lane = tid & 63, wr = wid >> 2, wc = wid & 3, fr = lane & 15, fq = lane >> 4;
    unsigned voffA[2], voffB[2];
#pragma unroll
    for (int i = 0; i < 2; ++i) { int R, C; stage_rc(tid * 16 + i * 8192, R, C); const int Rb = Epi::PERM ? ((R & ~31) + perm32(R & 31)) : R;
        voffA[i] = (unsigned)(R * g.lda + C) * 2u; voffB[i] = (unsigned)(Rb * g.ldb + C) * 2u; }
    const size_t kstep = (size_t)(BK * 2);
    const size_t hstepA = (size_t)HALF * g.lda * 2, hstepB = (size_t)HALF * g.ldb * 2;
    const size_t tstepA = 2 * hstepA, tstepB = 2 * hstepB;
    const unsigned ldsw = (unsigned)wid * 1024u;
    const int aoff = lds_byte(wr * 64 + fr, fq * 8), boff = lds_byte(wc * 32 + fr, fq * 8);
#define PG8_SA(b, h) (((b) * 2 + (h)) * HTB)
#define PG8_SB(b, h) ((4 + (b) * 2 + (h)) * HTB)
#define PG8_STAGE(bufoff, gbase, voff) do { _Pragma("unroll") for (int _i = 0; _i < 2; ++_i) \
        __builtin_amdgcn_global_load_lds((const unsigned*)((const char*)(gbase) + (voff)[_i]), (PG8_LAS unsigned*)(lds + (bufoff) + ldsw + _i * 8192), 16, 0, 0); } while (0)
#define PG8_LDA(dst, b, h) do { _Pragma("unroll") for (int m = 0; m < 4; ++m) _Pragma("unroll") for (int k = 0; k < 2; ++k) dst[m][k] = *(const PG8_LAS bf16x8*)(lds + PG8_SA(b, h) + aoff + m * 2048 + k * 1024); } while (0)
#define PG8_LDB(dst, b, h) do { _Pragma("unroll") for (int n = 0; n < 2; ++n) _Pragma("unroll") for (int k = 0; k < 2; ++k) dst[n][k] = *(const PG8_LAS bf16x8*)(lds + PG8_SB(b, h) + boff + n * 2048 + k * 1024); } while (0)
#define PG8_MMA(ai, bj, At, Bt) do { __builtin_amdgcn_s_setprio(1); _Pragma("unroll") for (int m = 0; m < 4; ++m) _Pragma("unroll") for (int n = 0; n < 2; ++n) _Pragma("unroll") for (int k = 0; k < 2; ++k) \
        acc[ai][bj][m][n] = __builtin_amdgcn_mfma_f32_16x16x32_bf16(Bt[n][k], At[m][k], acc[ai][bj][m][n], 0, 0, 0); __builtin_amdgcn_s_setprio(0); } while (0)
#define PG8_WAIT_V(n) asm volatile("s_waitcnt vmcnt(" #n ")" ::: "memory")
#define PG8_WAIT_L(n) asm volatile("s_waitcnt lgkmcnt(" #n ")" ::: "memory")
#define PG8_BAR __builtin_amdgcn_s_barrier()
#define PG8_SCHED __builtin_amdgcn_sched_barrier(0)
    Unit cur, nxt; int ui = 0;
    if (!S.next(0, cur)) return;
    f32x4 acc[2][2][4][2];
#pragma unroll
    for (int a = 0; a < 2; ++a)
#pragma unroll
        for (int b = 0; b < 2; ++b)
#pragma unroll
            for (int m = 0; m < 4; ++m)
#pragma unroll
                for (int n = 0; n < 2; ++n) acc[a][b][m][n] = (f32x4){0.f, 0.f, 0.f, 0.f};
    bf16x8 At[4][2], B0[2][2], B1[2][2];
    const char* cA = (const char*)g.A + (size_t)cur.pm * tstepA + (size_t)cur.ko * 2; const char* cB = (const char*)g.Bt + (size_t)cur.pn * tstepB + (size_t)cur.ko * 2;
    PG8_STAGE(PG8_SB(0, 0), cB, voffB); PG8_STAGE(PG8_SB(0, 1), cB + hstepB, voffB); PG8_STAGE(PG8_SA(0, 0), cA, voffA); PG8_STAGE(PG8_SA(0, 1), cA + hstepA, voffA);
    if (wr == 1) PG8_BAR;
    PG8_WAIT_V(2); PG8_BAR;
    PG8_STAGE(PG8_SB(1, 0), cB + kstep, voffB); PG8_STAGE(PG8_SA(1, 0), cA + kstep, voffA); PG8_STAGE(PG8_SB(1, 1), cB + hstepB + kstep, voffB);
    PG8_WAIT_V(6); PG8_BAR;
    for (;;) {
        const bool has_next = S.next(ui + 1, nxt);
        const char* nA = has_next ? (const char*)g.A + (size_t)nxt.pm * tstepA + (size_t)nxt.ko * 2 : cA; const char* nB = has_next ? (const char*)g.Bt + (size_t)nxt.pn * tstepB + (size_t)nxt.ko * 2 : cB;
        const int nt = cur.nk;
        for (int t = 0; t < nt; t += 2) {
            const bool last = (t == nt - 2);
            const char* a1 = cA + (size_t)(t + 1) * kstep;
            const char* a2 = last ? nA : cA + (size_t)(t + 2) * kstep; const char* b2 = last ? nB : cB + (size_t)(t + 2) * kstep;
            const char* a3 = a2 + kstep; const char* b3 = b2 + kstep;
            PG8_LDB(B0, 0, 0); PG8_LDB(B1, 0, 1); PG8_SCHED; PG8_LDA(At, 0, 0); PG8_STAGE(PG8_SA(1, 1), a1 + hstepA, voffA);
            PG8_WAIT_V(8); PG8_WAIT_L(0); PG8_BAR; PG8_MMA(0, 0, At, B0); PG8_MMA(0, 1, At, B1); PG8_BAR; PG8_SCHED;
            PG8_LDA(At, 0, 1); PG8_STAGE(PG8_SB(0, 0), b2, voffB); PG8_STAGE(PG8_SB(0, 1), b2 + hstepB, voffB); PG8_STAGE(PG8_SA(0, 0), a2, voffA);
            PG8_WAIT_V(8); PG8_WAIT_L(0); PG8_BAR; PG8_MMA(1, 0, At, B0); PG8_MMA(1, 1, At, B1); PG8_BAR; PG8_SCHED;
            PG8_LDB(B0, 1, 0); PG8_LDB(B1, 1, 1); PG8_SCHED; PG8_LDA(At, 1, 0); PG8_STAGE(PG8_SA(0, 1), a2 + hstepA, voffA);
            PG8_WAIT_V(8); PG8_WAIT_L(0); PG8_BAR; PG8_MMA(0, 0, At, B0); PG8_MMA(0, 1, At, B1); PG8_BAR; PG8_SCHED;
            PG8_LDA(At, 1, 1); PG8_STAGE(PG8_SB(1, 0), b3, voffB); PG8_STAGE(PG8_SB(1, 1), b3 + hstepB, voffB); PG8_STAGE(PG8_SA(1, 0), a3, voffA);
            PG8_WAIT_V(8); PG8_WAIT_L(0); PG8_BAR; PG8_MMA(1, 0, At, B0); PG8_MMA(1, 1, At, B1); PG8_BAR; PG8_SCHED;
        }
        if constexpr (ALIGN_EPI) { if (wr == 0) PG8_BAR; }
        if constexpr (!Epi::AFTER_DRAIN) { const int l2 = lane_id_opaque(); E(acc, cur, wr, wc, l2 & 15, l2 >> 4); }
        if (!has_next) break;
#pragma unroll
        for (int a = 0; a < 2; ++a)
#pragma unroll
            for (int b = 0; b < 2; ++b)
#pragma unroll
                for (int m = 0; m < 4; ++m)
#pragma unroll
                    for (int n = 0; n < 2; ++n) acc[a][b][m][n] = (f32x4){0.f, 0.f, 0.f, 0.f};
        cur = nxt; cA = nA; cB = nB; ++ui;
        if constexpr (ALIGN_EPI) { if (wr == 1) PG8_BAR; }
    }
    PG8_WAIT_V(0);
    if constexpr (!ALIGN_EPI) { if (wr == 0) PG8_BAR; }
    PG8_BAR;
    if constexpr (Epi::AFTER_DRAIN) { const int l2 = lane_id_opaque(); E.fused(acc, cur, wr, wc, l2 & 15, l2 >> 4, lds, wid, l2); }
#undef PG8_SA
#undef PG8_SB
#undef PG8_STAGE
#undef PG8_LDA
#undef PG8_LDB
#undef PG8_MMA
#undef PG8_WAIT_V
#undef PG8_WAIT_L
#undef PG8_BAR
#undef PG8_SCHED
}

struct EpiF32 {
    static constexpr bool PERM = true, AFTER_DRAIN = false;
    bf16_t* C; int ldc; float* YC;
    __device__ __forceinline__ void operator()(const f32x4 (&acc)[2][2][4][2], const Unit& u, int wr, int wc, int fr, int fq) const {
        const int col0 = u.pn * BM + wc * 32 + 8 * fq;
        if (u.part) {
            const int row0 = (u.pm ? CTX : 0) + wr * 64 + fr; float* slab = YC + (size_t)(u.part - 1) * NB * CTX * ldc;
#pragma unroll
            for (int ai = 0; ai < 2; ++ai)
#pragma unroll
                for (int m = 0; m < 4; ++m) { float* rowp = slab + (size_t)(row0 + ai * HALF + m * 16) * ldc + col0;
#pragma unroll
                    for (int bj = 0; bj < 2; ++bj)
#pragma unroll
                        for (int n = 0; n < 2; ++n) *(f32x4*)(rowp + bj * HALF + 4 * n) = acc[ai][bj][m][n]; }
        } else {
            const int row0 = u.pm * BM + wr * 64 + fr;
#pragma unroll
            for (int ai = 0; ai < 2; ++ai)
#pragma unroll
                for (int m = 0; m < 4; ++m) { bf16_t* rowp = C + (size_t)(row0 + ai * HALF + m * 16) * ldc + col0;
#pragma unroll
                    for (int bj = 0; bj < 2; ++bj) { const f32x4 v0 = acc[ai][bj][m][0], v1 = acc[ai][bj][m][1];
                        u32x4 w; w.x = pk2(v0[0], v0[1]); w.y = pk2(v0[2], v0[3]); w.z = pk2(v1[0], v1[1]); w.w = pk2(v1[2], v1[3]);
                        *(u32x4*)(rowp + bj * HALF) = w; } }
        }
    }
};
struct EpiBf16 {
    static constexpr bool PERM = true, AFTER_DRAIN = false;
    bf16_t* O; int ldc; int coff;
    __device__ __forceinline__ void operator()(const f32x4 (&acc)[2][2][4][2], const Unit& u, int wr, int wc, int fr, int fq) const {
        const int row0 = u.pm * BM + wr * 64 + fr, col0 = u.pn * BM - coff + wc * 32 + 8 * fq;
#pragma unroll
        for (int ai = 0; ai < 2; ++ai)
#pragma unroll
            for (int m = 0; m < 4; ++m) { bf16_t* rowp = O + (size_t)(row0 + ai * HALF + m * 16) * ldc + col0;
#pragma unroll
                for (int bj = 0; bj < 2; ++bj) { const f32x4 v0 = acc[ai][bj][m][0], v1 = acc[ai][bj][m][1];
                    u32x4 w; w.x = pk2(v0[0], v0[1]); w.y = pk2(v0[2], v0[3]); w.z = pk2(v1[0], v1[1]); w.w = pk2(v1[2], v1[3]);
                    *(u32x4*)(rowp + bj * HALF) = w; } }
    }
};
struct EpiSwiglu {
    static constexpr bool PERM = true, AFTER_DRAIN = false;
    bf16_t* O; int ldc;
    __device__ __forceinline__ void operator()(const f32x4 (&acc)[2][2][4][2], const Unit& u, int wr, int wc, int fr, int fq) const {
        const int row0 = u.pm * BM + wr * 64 + fr, col0 = u.pn * HALF + wc * 32 + 8 * fq;
#pragma unroll
        for (int ai = 0; ai < 2; ++ai)
#pragma unroll
            for (int m = 0; m < 4; ++m) { bf16_t* rowp = O + (size_t)(row0 + ai * HALF + m * 16) * ldc + col0;
                float o[8];
#pragma unroll
                for (int n = 0; n < 2; ++n)
#pragma unroll
                    for (int j = 0; j < 4; ++j) { const float gt = acc[ai][0][m][n][j], up = acc[ai][1][m][n][j]; o[4 * n + j] = fsilu(gt) * up; }
                *(u32x4*)rowp = pack8(o); }
    }
};
struct EpiDec {
    static constexpr bool PERM = true, AFTER_DRAIN = false;
    float* DEC; const float* w0;
    __device__ __forceinline__ void operator()(const f32x4 (&acc)[2][2][4][2], const Unit& u, int wr, int wc, int fr, int fq) const {
        const int row0 = u.pm * BM + wr * 64 + fr; const int seg = u.pn >> 2; const int cs0 = (u.pn & 3) * BM + wc * 32 + 8 * fq;
        float* dbase = DEC + (size_t)seg * M * MIXA;
#pragma unroll
        for (int bj = 0; bj < 2; ++bj) { const int cs = cs0 + bj * HALF;
            const f32x4 wa = *(const f32x4*)(w0 + seg * MIXA + cs), wb = *(const f32x4*)(w0 + seg * MIXA + cs + 4);
#pragma unroll
            for (int ai = 0; ai < 2; ++ai)
#pragma unroll
                for (int m = 0; m < 4; ++m) { float* dp = dbase + (size_t)(row0 + ai * HALF + m * 16) * MIXA + cs;
                    f32x4 o0, o1;
#pragma unroll
                    for (int j = 0; j < 4; ++j) {
                        const float x0 = acc[ai][bj][m][0][j] + wa[j], x1 = acc[ai][bj][m][1][j] + wb[j];
                        o0[j] = -0.6065306597126334f * fsigmoid(x0); o1[j] = -0.6065306597126334f * fsigmoid(x1); }
                    *(f32x4*)dp = o0; *(f32x4*)(dp + 4) = o1; } }
    }
};
struct EpiLr {
    static constexpr bool PERM = true, AFTER_DRAIN = false;
    bf16_t* KM; const bf16_t* KKp; bf16_t* BV; const float* a0; const float* ka;
    __device__ __forceinline__ void operator()(const f32x4 (&acc)[2][2][4][2], const Unit& u, int wr, int wc, int fr, int fq) const {
        const int row0 = u.pm * BM + wr * 64 + fr; const int cs0 = (u.pn & 3) * BM + wc * 32 + 8 * fq;
#pragma unroll
        for (int bj = 0; bj < 2; ++bj)
#pragma unroll
            for (int n = 0; n < 2; ++n) { const int cs = cs0 + bj * HALF + 4 * n;
                const f32x4 aa = *(const f32x4*)(a0 + cs), kav = *(const f32x4*)(ka + cs);
                u32x2 kws[2][4], qws[2][4];
#pragma unroll
                for (int ai = 0; ai < 2; ++ai)
#pragma unroll
                    for (int m = 0; m < 4; ++m) { const size_t off = (size_t)(row0 + ai * HALF + m * 16) * MIXA + cs; kws[ai][m] = *(const u32x2*)(KM + off); qws[ai][m] = *(const u32x2*)(KKp + off); }
#pragma unroll
                for (int ai = 0; ai < 2; ++ai)
#pragma unroll
                    for (int m = 0; m < 4; ++m) { const size_t off = (size_t)(row0 + ai * HALF + m * 16) * MIXA + cs;
                        const u32x2 kw = kws[ai][m], qw = qws[ai][m];
                        const float kv[4] = {bflo(kw.x), bfhi(kw.x), bflo(kw.y), bfhi(kw.y)}, kk[4] = {bflo(qw.x), bfhi(qw.x), bflo(qw.y), bfhi(qw.y)};
                        float km[4], bv[4];
#pragma unroll
                        for (int j = 0; j < 4; ++j) { const float lr = fsigmoid(acc[ai][bj][m][n][j] + aa[j]);
                            km[j] = kv[j] * (1.0f + (lr - 1.0f) * kav[j]); bv[j] = kk[j] * lr; }
                        u32x2 o1, o2; o1.x = pk2(km[0], km[1]); o1.y = pk2(km[2], km[3]); o2.x = pk2(bv[0], bv[1]); o2.y = pk2(bv[2], bv[3]);
                        *(u32x2*)(KM + off) = o1; *(u32x2*)(BV + off) = o2; } }
    }
};
struct EpiRet {
    static constexpr bool PERM = true, AFTER_DRAIN = false;
    bf16_t* O; int ldc; const float* rot;
    __device__ __forceinline__ void operator()(const f32x4 (&acc)[2][2][4][2], const Unit& u, int wr, int wc, int fr, int fq) const {
        const int row0 = u.pm * BM + wr * 64 + fr, col0 = u.pn * BM + wc * 32 + 8 * fq;
        const bool qk = u.pn < 16; const float sc = (u.pn >= 8 && u.pn < 16) ? 0.0625f : 1.0f;
        const int f0 = (wc * 32 + 8 * fq) & 63; const bool use_row = wc < 2;
#pragma unroll
        for (int ai = 0; ai < 2; ++ai)
#pragma unroll
            for (int m = 0; m < 4; ++m) { const int row = row0 + ai * HALF + m * 16; bf16_t* rowp = O + (size_t)row * ldc + col0;
                float o0[8], o1[8];
#pragma unroll
                for (int n = 0; n < 2; ++n)
#pragma unroll
                    for (int j = 0; j < 4; ++j) { o0[4 * n + j] = acc[ai][0][m][n][j]; o1[4 * n + j] = acc[ai][1][m][n][j]; }
                const int t = row % TB;
                if (qk) {
                    if (t >= CTX) { const int s = t - CTX; const int pos = use_row ? (s >> 6) : (s & 63); const f32x4* rp = (const f32x4*)(rot + ((size_t)pos * 64 + f0) * 2);
#pragma unroll
                        for (int i = 0; i < 4; ++i) { const f32x4 cs = rp[i];
                            const float a0 = o0[2 * i], b0 = o1[2 * i], a1 = o0[2 * i + 1], b1 = o1[2 * i + 1];
                            o0[2 * i] = a0 * cs[0] - b0 * cs[1]; o1[2 * i] = a0 * cs[1] + b0 * cs[0];
                            o0[2 * i + 1] = a1 * cs[2] - b1 * cs[3]; o1[2 * i + 1] = a1 * cs[3] + b1 * cs[2]; } }
#pragma unroll
                    for (int i = 0; i < 8; ++i) { o0[i] *= sc; o1[i] *= sc; }
                }
                *(u32x4*)rowp = pack8(o0); *(u32x4*)(rowp + HALF) = pack8(o1); }
    }
};
struct NormX {
    float* xbuf;
    unsigned* cnt;
    unsigned* tmo;
    __device__ __forceinline__ void publish(const float (&ss)[2][4], const Unit& u, int wr, int wc, int fr, int fq, PG8_LAS unsigned char* lds, int wid, int lane) const {
        PG8_LAS float* P = (PG8_LAS float*)lds;
#pragma unroll
        for (int ai = 0; ai < 2; ++ai)
#pragma unroll
            for (int m = 0; m < 4; ++m) { float q = ss[ai][m]; q += __shfl_xor(q, 16); q += __shfl_xor(q, 32);
                if (fq == 0) P[(ai * HALF + wr * 64 + m * 16 + fr) * 4 + wc] = q; }
        asm volatile("s_waitcnt lgkmcnt(0)" ::: "memory"); __builtin_amdgcn_s_barrier(); asm volatile("" ::: "memory");
        const int row = wid * 32 + (lane & 31);
        if (lane < 32) { const f32x4 pq = *(const PG8_LAS f32x4*)(P + row * 4); const float tot = (pq[0] + pq[1]) + (pq[2] + pq[3]);
            __hip_atomic_store((unsigned*)xbuf + ((size_t)(u.pm * BM + row) * 8 + u.pn), __float_as_uint(tot), __ATOMIC_RELAXED, __HIP_MEMORY_SCOPE_AGENT); }
        asm volatile("s_waitcnt vmcnt(0)" ::: "memory");
        if (lane == 0) __hip_atomic_fetch_add(cnt + 64 * u.pm, 1u, __ATOMIC_RELAXED, __HIP_MEMORY_SCOPE_AGENT);
    }
    __device__ __forceinline__ void finish(const Unit& u, PG8_LAS unsigned char* lds, int wid, int lane) const {
        PG8_LAS float* S = (PG8_LAS float*)(lds + 4096);
        const int row = wid * 32 + (lane & 31);
        if (wid == 0) {
            unsigned sp = 0u;
            while ((unsigned)__builtin_amdgcn_readfirstlane((int)__hip_atomic_load(cnt + 64 * u.pm, __ATOMIC_RELAXED, __HIP_MEMORY_SCOPE_AGENT)) < 64u) {
                __builtin_amdgcn_s_sleep(1);
                if ((++sp & 255u) == 0u) { if (__hip_atomic_load(tmo, __ATOMIC_RELAXED, __HIP_MEMORY_SCOPE_AGENT)) break; if (sp > (1u << 20)) { if (lane == 0) atomicAdd(tmo, 1u); break; } } }
        }
        asm volatile("s_waitcnt vmcnt(0) lgkmcnt(0)" ::: "memory"); __builtin_amdgcn_s_barrier(); asm volatile("" ::: "memory");
        if (lane < 32) { const unsigned* slot = (const unsigned*)xbuf + (size_t)(u.pm * BM + row) * 8; float q = 0.f;
#pragma unroll
            for (int t = 0; t < 8; ++t) q += __uint_as_float(__hip_atomic_load(slot + t, __ATOMIC_RELAXED, __HIP_MEMORY_SCOPE_AGENT));
            S[row] = rsqrtf(q * (1.0f / 2048.0f) + 1e-6f); }
        asm volatile("s_waitcnt lgkmcnt(0)" ::: "memory"); __builtin_amdgcn_s_barrier(); asm volatile("" ::: "memory");
    }
};
struct EpiNorm {
    static constexpr bool PERM = true, AFTER_DRAIN = true;
    bf16_t* H; bf16_t* ABF; float* OUT; const float* gatev; const float* ngy; const float* ngn; const float* shiftv; const float* scalev; bool fin; NormX x1, x2;
    __device__ __forceinline__ void operator()(const f32x4 (&)[2][2][4][2], const Unit&, int, int, int, int) const {}
    __device__ __forceinline__ void fused(f32x4 (&acc)[2][2][4][2], const Unit& u, int wr, int wc, int fr, int fq, PG8_LAS unsigned char* lds, int wid, int lane) const {
        const PG8_LAS float* S = (const PG8_LAS float*)(lds + 4096);
        const int b = u.pm / 17, col0 = u.pn * BM + wc * 32 + 8 * fq;
        float ss[2][4];
#pragma unroll
        for (int ai = 0; ai < 2; ++ai)
#pragma unroll
            for (int m = 0; m < 4; ++m) { float q = 0.f;
#pragma unroll
                for (int bj = 0; bj < 2; ++bj)
#pragma unroll
                    for (int n = 0; n < 2; ++n) { const f32x4 x = acc[ai][bj][m][n]; q += (x[0] * x[0] + x[1] * x[1]) + (x[2] * x[2] + x[3] * x[3]); }
                ss[ai][m] = q; }
        x1.publish(ss, u, wr, wc, fr, fq, lds, wid, lane);
        u32x4 hw[2][4][2];
#pragma unroll
        for (int ai = 0; ai < 2; ++ai)
#pragma unroll
            for (int m = 0; m < 4; ++m)
#pragma unroll
                for (int bj = 0; bj < 2; ++bj) hw[ai][m][bj] = *(const u32x4*)(H + ((size_t)u.pm * BM + ai * HALF + wr * 64 + m * 16 + fr) * D + col0 + bj * HALF);
        f32x4 gy[2][2];
#pragma unroll
        for (int bj = 0; bj < 2; ++bj)
#pragma unroll
            for (int n = 0; n < 2; ++n) { const int c = col0 + bj * HALF + 4 * n; gy[bj][n] = *(const f32x4*)(gatev + (size_t)b * 12288 + c) * *(const f32x4*)(ngy + c); }
        x1.finish(u, lds, wid, lane);
        {
#pragma unroll
            for (int ai = 0; ai < 2; ++ai)
#pragma unroll
                for (int m = 0; m < 4; ++m) { const int r = ai * HALF + wr * 64 + m * 16 + fr; const float rs = S[r]; const size_t grow = (size_t)u.pm * BM + r;
#pragma unroll
                    for (int bj = 0; bj < 2; ++bj) { const u32x4 hq = hw[ai][m][bj];
                        f32x4 h0 = {bflo(hq.x), bfhi(hq.x), bflo(hq.y), bfhi(hq.y)}, h1 = {bflo(hq.z), bfhi(hq.z), bflo(hq.w), bfhi(hq.w)};
                        h0 += gy[bj][0] * (acc[ai][bj][m][0] * rs); h1 += gy[bj][1] * (acc[ai][bj][m][1] * rs);
                        if (fin) { float* o = OUT + ((size_t)b * SEQ + ((u.pm % 17) * BM + r - CTX)) * D + col0 + bj * HALF; *(f32x4*)o = h0; *(f32x4*)(o + 4) = h1; }
                        else { u32x4 w; w.x = pk2(h0[0], h0[1]); w.y = pk2(h0[2], h0[3]); w.z = pk2(h1[0], h1[1]); w.w = pk2(h1[2], h1[3]);
                            *(u32x4*)(H + grow * D + col0 + bj * HALF) = w;
                            acc[ai][bj][m][0] = (f32x4){bflo(w.x), bfhi(w.x), bflo(w.y), bfhi(w.y)}; acc[ai][bj][m][1] = (f32x4){bflo(w.z), bfhi(w.z), bflo(w.w), bfhi(w.w)}; } } }
        }
        if (fin) return;
#pragma unroll
        for (int ai = 0; ai < 2; ++ai)
#pragma unroll
            for (int m = 0; m < 4; ++m) { float q = 0.f;
#pragma unroll
                for (int bj = 0; bj < 2; ++bj)
#pragma unroll
                    for (int n = 0; n < 2; ++n) { const f32x4 x = acc[ai][bj][m][n]; q += (x[0] * x[0] + x[1] * x[1]) + (x[2] * x[2] + x[3] * x[3]); }
                ss[ai][m] = q; }
        x2.publish(ss, u, wr, wc, fr, fq, lds, wid, lane);
        f32x4 an[2][2], sh[2][2];
#pragma unroll
        for (int bj = 0; bj < 2; ++bj)
#pragma unroll
            for (int n = 0; n < 2; ++n) { const int c = col0 + bj * HALF + 4 * n;
                an[bj][n] = *(const f32x4*)(ngn + c) * (*(const f32x4*)(scalev + (size_t)b * 12288 + c) + 1.0f); sh[bj][n] = *(const f32x4*)(shiftv + (size_t)b * 12288 + c); }
        x2.finish(u, lds, wid, lane);
        {
#pragma unroll
            for (int ai = 0; ai < 2; ++ai)
#pragma unroll
                for (int m = 0; m < 4; ++m) { const int r = ai * HALF + wr * 64 + m * 16 + fr; const float rs = S[r]; const size_t grow = (size_t)u.pm * BM + r;
#pragma unroll
                    for (int bj = 0; bj < 2; ++bj) { const f32x4 o0 = (acc[ai][bj][m][0] * rs) * an[bj][0] + sh[bj][0], o1 = (acc[ai][bj][m][1] * rs) * an[bj][1] + sh[bj][1];
                        u32x4 w; w.x = pk2(o0[0], o0[1]); w.y = pk2(o0[2], o0[3]); w.z = pk2(o1[0], o1[1]); w.w = pk2(o1[2], o1[3]);
                        *(u32x4*)(ABF + grow * D + col0 + bj * HALF) = w; } }
        }
    }
};
}

#define XB_TMO      128
#define XB_XCNT(j)  (256  + 64 * (j))
#define XB_XSUB(j)  (1280 + 64 * (j))
#define XB_XGEN(j)  (2304 + 64 * (j))
#define XB_TOP      3328
#define XB_TOPGEN   3392
#define XCD_BAR_WORDS 3456
#define XB_SPIN_CAP (1u << 20)
__device__ __forceinline__ unsigned xb_ld(unsigned* p)              { return __hip_atomic_load(p, __ATOMIC_RELAXED, __HIP_MEMORY_SCOPE_AGENT); }
__device__ __forceinline__ unsigned xb_add(unsigned* p, unsigned v) { return __hip_atomic_fetch_add(p, v, __ATOMIC_RELAXED, __HIP_MEMORY_SCOPE_AGENT); }
__device__ __forceinline__ unsigned xb_xcc_id() { return (unsigned)__builtin_amdgcn_s_getreg((3 << 11) | 20) & 0xFu; }
#define XB_SPIN(cond, bar) do { unsigned _sp = 0; while (cond) { __builtin_amdgcn_s_sleep(1); \
    if ((++_sp & 255u) == 0u) { if (xb_ld(&(bar)[XB_TMO])) break; if (_sp > XB_SPIN_CAP) { atomicAdd(&(bar)[XB_TMO], 1u); break; } } } } while (0)
struct XcdBarrier { unsigned* bar; unsigned x; volatile LAS unsigned* st; };
__device__ __forceinline__ XcdBarrier xcd_barrier_post(unsigned* bar, volatile LAS unsigned* st) {
    XcdBarrier b; b.bar = bar; b.x = xb_xcc_id(); b.st = st;
    if (threadIdx.x == 0) (void)xb_add(&bar[XB_XCNT(b.x)], 1u);
    return b;
}
__device__ __forceinline__ void xcd_barrier_complete(unsigned* bar, unsigned x, unsigned& nloc, unsigned& nx) {
    const unsigned G = gridDim.x * gridDim.y * gridDim.z;
    unsigned sum, cnt, mine, sp = 0u;
    for (;;) {
        sum = 0u; cnt = 0u; mine = 0u;
#pragma unroll
        for (unsigned j = 0; j < 16; ++j) { const unsigned c = xb_ld(&bar[XB_XCNT(j)]); sum += c; cnt += (c > 0u) ? 1u : 0u; mine = (j == x) ? c : mine; }
        if (sum == G) break;
        __builtin_amdgcn_s_sleep(1);
        if ((++sp & 255u) == 0u) { if (xb_ld(&bar[XB_TMO])) break; if (sp > XB_SPIN_CAP) { atomicAdd(&bar[XB_TMO], 1u); break; } }
    }
    nloc = mine > 0u ? mine : 1u; nx = cnt > 0u ? cnt : 1u;
}
__device__ __forceinline__ void xcd_barrier(const XcdBarrier& b) {
    asm volatile("s_waitcnt vmcnt(0)" ::: "memory");
    __syncthreads();
    if (threadIdx.x == 0) {
        unsigned* bar = b.bar;
        __builtin_amdgcn_s_waitcnt(0);
        unsigned nloc = b.st[0], nx = b.st[1];
        if (nloc == 0u) { xcd_barrier_complete(bar, b.x, nloc, nx); b.st[0] = nloc; b.st[1] = nx; }
        const unsigned old = xb_add(&bar[XB_XSUB(b.x)], 1u);
        const unsigned gen = old / nloc;
        if (old + 1u == (gen + 1u) * nloc) {
            __builtin_amdgcn_fence(__ATOMIC_RELEASE, "agent");
            asm volatile("s_waitcnt vmcnt(0)" ::: "memory");
            __builtin_amdgcn_fence(__ATOMIC_ACQUIRE, "agent");
            const unsigned og = xb_add(&bar[XB_TOP], 1u);
            const unsigned tg = og / nx;
            if (og + 1u == (tg + 1u) * nx) xb_add(&bar[XB_TOPGEN], 1u);
            else XB_SPIN(xb_ld(&bar[XB_TOPGEN]) == tg, bar);
            xb_add(&bar[XB_XGEN(b.x)], 1u);
            asm volatile("s_waitcnt vmcnt(0)" ::: "memory");
        } else {
            __builtin_amdgcn_fence(__ATOMIC_ACQUIRE, "agent");
            XB_SPIN(xb_ld(&bar[XB_XGEN(b.x)]) == gen, bar);
            asm volatile("s_waitcnt vmcnt(0)" ::: "memory");
        }
    }
    __syncthreads();
}

struct Args {
    const float* in[27];
    float* out; unsigned char* ws;
    int ph_lo, ph_hi;
};
enum { I_X = 0, I_C, I_CTX, I_CCTX, I_MODW, I_MODB, I_NG, I_FWI, I_FWO, I_ABWI, I_ABWO, I_MU, I_W0, I_W2, I_A0, I_A2, I_G2, I_KK, I_KA, I_RK, I_LNW, I_LNB, I_GKUP, I_GKB, I_GLAG, I_RWI, I_RWO };

struct Fr {
    LAS unsigned char* lds; int tid, lane, wave, vcu, G;
};

__device__ __forceinline__ int dst_row(int n, int mode) {
    if (mode == 0) return n;
    return n < DFF ? 256 * (n / 128) + (n % 128) : 256 * ((n - DFF) / 128) + 128 + ((n - DFF) % 128);
}
__device__ __forceinline__ void conv_job(const Fr& F, const float* W, int K, int N, int Npad, bf16* WT, int mode, int wgi, int nWG) {
    LAS float* scr = (LAS float*)F.lds;
    const int tid = F.tid, ntn = Npad / 128, nitems = (K / 128) * ntn;
    const int lr = tid >> 5, lc = 4 * (tid & 31);
    f32x4 reg[8];
    int it = wgi;
    if (it < nitems) { const int k0 = (it / ntn) * 128, n0 = (it % ntn) * 128;
#pragma unroll
        for (int i = 0; i < 8; ++i) reg[i] = (n0 + lc < N) ? __builtin_nontemporal_load((const f32x4*)(W + (size_t)(k0 + lr + 16 * i) * N + n0 + lc)) : (f32x4){0.f, 0.f, 0.f, 0.f}; }
    while (it < nitems) {
        const int k0 = (it / ntn) * 128, n0 = (it % ntn) * 128;
#pragma unroll
        for (int i = 0; i < 8; ++i) *(LAS f32x4*)(scr + (lr + 16 * i) * 132 + lc) = reg[i];
        __syncthreads();
        const int nxt = it + nWG;
        if (nxt < nitems) { const int k1 = (nxt / ntn) * 128, n1 = (nxt % ntn) * 128;
#pragma unroll
            for (int i = 0; i < 8; ++i) reg[i] = (n1 + lc < N) ? __builtin_nontemporal_load((const f32x4*)(W + (size_t)(k1 + lr + 16 * i) * N + n1 + lc)) : (f32x4){0.f, 0.f, 0.f, 0.f}; }
        { const int c = tid & 15;
#pragma unroll
          for (int j = 0; j < 4; ++j) { const int n = (tid >> 4) + 32 * j; const LAS float* sp = scr + (8 * c) * 132 + n;
              u32x4 o; o.x = pk2(sp[0], sp[132]); o.y = pk2(sp[2 * 132], sp[3 * 132]); o.z = pk2(sp[4 * 132], sp[5 * 132]); o.w = pk2(sp[6 * 132], sp[7 * 132]);
              __builtin_nontemporal_store(o, (u32x4*)(WT + (size_t)dst_row(n0 + n, mode) * K + k0 + 8 * c)); } }
        __syncthreads();
        it = nxt;
    }
}
struct ConvJob { const float* W; bf16* WT; int K, N, Npad, mode; };
__device__ __forceinline__ void conv_jobs(const Fr& F, const Args& a, int jlo, int jhi, int wgi, int nWG) {
    unsigned char* ws = a.ws;
    ConvJob jobs[8];
    jobs[0] = {a.in[I_ABWI], (bf16*)(ws + WS_WAB), D, ABCOLS, ZLD0, 0};
    jobs[1] = {a.in[I_ABWO], (bf16*)(ws + WS_WO0), D, D, D, 0};
    jobs[2] = {a.in[I_FWI], (bf16*)(ws + WS_WFI0), D, 2 * DFF, 2 * DFF, 1};
    jobs[3] = {a.in[I_FWO], (bf16*)(ws + WS_WFO0), DFF, D, D, 0};
    jobs[4] = {a.in[I_RWI], (bf16*)(ws + WS_WRI), D, RETC, RETC, 0};
    jobs[5] = {a.in[I_RWO], (bf16*)(ws + WS_WRO), 2 * D, D, D, 0};
    jobs[6] = {a.in[I_FWI] + (size_t)D * 2 * DFF, (bf16*)(ws + WS_WFI1), D, 2 * DFF, 2 * DFF, 1};
    jobs[7] = {a.in[I_FWO] + (size_t)DFF * D, (bf16*)(ws + WS_WFO1), DFF, D, D, 0};
#pragma unroll
    for (int j = 0; j < 8; ++j) {
        if (j < jlo || j >= jhi) continue;
        conv_job(F, jobs[j].W, jobs[j].K, jobs[j].N, jobs[j].Npad, jobs[j].WT, jobs[j].mode, wgi, nWG);
    }
}
__device__ __forceinline__ void conv_dyn(const Fr& F, const Args& a, unsigned* qhead, int jlo, int jhi) {
    unsigned char* ws = a.ws;
    LAS float* scr = (LAS float*)F.lds; volatile LAS int* slot = (volatile LAS int*)(F.lds + 128 * 132 * 4);
    const int tid = F.tid, lr = tid >> 5, lc = 4 * (tid & 31);
    constexpr int NT[8] = {(D / 128) * (ZLD0 / 128), (D / 128) * (D / 128), (D / 128) * (2 * DFF / 128), (DFF / 128) * (D / 128), (D / 128) * (RETC / 128), (2 * D / 128) * (D / 128), (D / 128) * (2 * DFF / 128), (DFF / 128) * (D / 128)};
    int total = 0;
#pragma unroll
    for (int j = 0; j < 8; ++j) if (j >= jlo && j < jhi) total += NT[j];
    const float* W = nullptr; bf16* WT = nullptr; int K = 0, N = 0, Np = 0, mode = 0, k0 = 0, n0 = 0;
    auto decode = [&](int it) {
        int li = it, job = jlo;
#pragma unroll
        for (int j = 0; j < 8; ++j) if (j >= jlo && j < jhi - 1 && job == j && li >= NT[j]) { li -= NT[j]; job = j + 1; }
        switch (job) {
            case 0: W = a.in[I_ABWI]; WT = (bf16*)(ws + WS_WAB); K = D; N = ABCOLS; Np = ZLD0; mode = 0; break;
            case 1: W = a.in[I_ABWO]; WT = (bf16*)(ws + WS_WO0); K = D; N = D; Np = D; mode = 0; break;
            case 2: W = a.in[I_FWI]; WT = (bf16*)(ws + WS_WFI0); K = D; N = 2 * DFF; Np = 2 * DFF; mode = 1; break;
            case 3: W = a.in[I_FWO]; WT = (bf16*)(ws + WS_WFO0); K = DFF; N = D; Np = D; mode = 0; break;
            case 4: W = a.in[I_RWI]; WT = (bf16*)(ws + WS_WRI); K = D; N = RETC; Np = RETC; mode = 0; break;
            case 5: W = a.in[I_RWO]; WT = (bf16*)(ws + WS_WRO); K = 2 * D; N = D; Np = D; mode = 0; break;
            case 6: W = a.in[I_FWI] + (size_t)D * 2 * DFF; WT = (bf16*)(ws + WS_WFI1); K = D; N = 2 * DFF; Np = 2 * DFF; mode = 1; break;
            default: W = a.in[I_FWO] + (size_t)DFF * D; WT = (bf16*)(ws + WS_WFO1); K = DFF; N = D; Np = D; mode = 0; break;
        }
        const int ntn = Np / 128; k0 = (li / ntn) * 128; n0 = (li % ntn) * 128; };
    f32x4 reg[8];
    if (tid == 0) slot[0] = (int)atomicAdd(qhead, 1u);
    __syncthreads();
    int cur = slot[0];
    __syncthreads();
    if (cur < total) { decode(cur);
#pragma unroll
        for (int i = 0; i < 8; ++i) reg[i] = (n0 + lc < N) ? __builtin_nontemporal_load((const f32x4*)(W + (size_t)(k0 + lr + 16 * i) * N + n0 + lc)) : (f32x4){0.f, 0.f, 0.f, 0.f}; }
    while (cur < total) {
        const int ck0 = k0, cn0 = n0, cK = K, cmode = mode; bf16* cWT = WT;
#pragma unroll
        for (int i = 0; i < 8; ++i) *(LAS f32x4*)(scr + (lr + 16 * i) * 132 + lc) = reg[i];
        if (tid == 0) slot[0] = (int)atomicAdd(qhead, 1u);
        __syncthreads();
        const int nxt = slot[0];
        if (nxt < total) { decode(nxt);
#pragma unroll
            for (int i = 0; i < 8; ++i) reg[i] = (n0 + lc < N) ? __builtin_nontemporal_load((const f32x4*)(W + (size_t)(k0 + lr + 16 * i) * N + n0 + lc)) : (f32x4){0.f, 0.f, 0.f, 0.f}; }
        { const int c = tid & 15;
#pragma unroll
          for (int j = 0; j < 4; ++j) { const int n = (tid >> 4) + 32 * j; const LAS float* sp = scr + (8 * c) * 132 + n;
              u32x4 o; o.x = pk2(sp[0], sp[132]); o.y = pk2(sp[2 * 132], sp[3 * 132]); o.z = pk2(sp[4 * 132], sp[5 * 132]); o.w = pk2(sp[6 * 132], sp[7 * 132]);
              __builtin_nontemporal_store(o, (u32x4*)(cWT + (size_t)dst_row(cn0 + n, cmode) * cK + ck0 + 8 * c)); } }
        __syncthreads();
        cur = nxt;
    }
}
__device__ __forceinline__ void p0_prologue(const Fr& F, const Args& a) {
    unsigned char* ws = a.ws;
    conv_jobs(F, a, 0, 1, F.vcu, F.G);
    {
        bf16* WL = (bf16*)(ws + WS_WLO); const float* w2 = a.in[I_W2]; const float* a2 = a.in[I_A2]; const float* g2 = a.in[I_G2];
        for (int idx = F.vcu * NTHR + F.tid; idx < 4096 * 64; idx += F.G * NTHR) {
            const int n = idx & 4095, k0 = (idx >> 12) * 8;
            const int seg = n >> 10, c = n & 1023; float v[8];
#pragma unroll
            for (int j = 0; j < 8; ++j) { const int k = k0 + j; float x = 0.f;
                if (seg < 2) { if (k < 96) x = w2[((size_t)seg * 96 + k) * MIXA + c]; }
                else if (seg == 2) { if (k >= 128 && k < 224) x = a2[(size_t)(k - 128) * MIXA + c]; }
                else { if (k >= 256) x = g2[(size_t)(k - 256) * MIXA + c]; }
                v[j] = x; }
            *(u32x4*)(WL + (size_t)n * 512 + k0) = pack8(v);
        }
    }
    {
        float* rot = (float*)(ws + WS_ROT);
        for (int idx = F.vcu * NTHR + F.tid; idx < 4096; idx += F.G * NTHR) {
            const int pos = idx >> 6, f = idx & 63;
            const float inv = exp2f(-(float)f * (13.287712379549449f / 64.0f));
            const float rev = (float)pos * inv * 0.15915494309189535f;
            rot[2 * idx] = __builtin_amdgcn_cosf(rev); rot[2 * idx + 1] = __builtin_amdgcn_sinf(rev);
        }
    }
    {
        LAS float* sv = (LAS float*)F.lds;
        LAS float* red = sv + 3 * 2048;
        { float xs[12];
#pragma unroll
          for (int it = 0; it < 12; ++it) { const int i = F.tid + it * NTHR; const int w = it >> 2, k = i & 2047; xs[it] = (w < 2) ? a.in[I_C][w * D + k] : a.in[I_CCTX][k]; }
#pragma unroll
          for (int it = 0; it < 12; ++it) sv[F.tid + it * NTHR] = fsilu(xs[it]); }
        __syncthreads();
        float* modv = (float*)(ws + WS_MODV);
        for (int slab = F.vcu; slab < 256; slab += F.G) {
            const int l = slab >> 7, col0 = (slab & 127) * 96;
            const float* Wm = a.in[I_MODW] + (size_t)l * D * 12288;
            const int cq = F.tid % 24, kg = F.tid / 24;
            f32x4 a0 = {0, 0, 0, 0}, a1 = {0, 0, 0, 0}, a2v = {0, 0, 0, 0};
            if (kg < 21) {
#pragma unroll 1
                for (int i0 = 0; i0 < 98; i0 += 7) { f32x4 wv[7];
#pragma unroll
                    for (int j = 0; j < 7; ++j) { const int k = kg + 21 * (i0 + j), kc = k < D ? k : D - 1;
                        wv[j] = __builtin_nontemporal_load((const f32x4*)(Wm + (size_t)kc * 12288 + col0 + 4 * cq)); }
#pragma unroll
                    for (int j = 0; j < 7; ++j) { const int k = kg + 21 * (i0 + j), kc = k < D ? k : D - 1; const float z = k < D ? 1.0f : 0.0f;
                        a0 += wv[j] * (sv[kc] * z); a1 += wv[j] * (sv[2048 + kc] * z); a2v += wv[j] * (sv[4096 + kc] * z); } }
#pragma unroll
                for (int j = 0; j < 4; ++j) { red[(kg * 3 + 0) * 96 + 4 * cq + j] = a0[j]; red[(kg * 3 + 1) * 96 + 4 * cq + j] = a1[j]; red[(kg * 3 + 2) * 96 + 4 * cq + j] = a2v[j]; }
            }
            __syncthreads();
            if (F.tid < 288) { const int w = F.tid / 96, cc = F.tid % 96; float s = 0.f;
                for (int g = 0; g < 21; ++g) s += red[(g * 3 + w) * 96 + cc];
                modv[((size_t)l * 3 + w) * 12288 + col0 + cc] = s + a.in[I_MODB][l * 12288 + col0 + cc]; }
            __syncthreads();
        }
    }
}

struct Row { f32x4 v[8]; };
__device__ __forceinline__ void row_load(Row& r, const float* p, int lane) {
#pragma unroll
    for (int j = 0; j < 8; ++j) r.v[j] = *(const f32x4*)(p + 4 * lane + 256 * j);
}
__device__ __forceinline__ float row_rstd(const Row& r) {
    float s = 0.f;
#pragma unroll
    for (int j = 0; j < 8; ++j) s += (r.v[j][0] * r.v[j][0] + r.v[j][1] * r.v[j][1]) + (r.v[j][2] * r.v[j][2] + r.v[j][3] * r.v[j][3]);
    return rsqrtf(wave_sum(s) * (1.0f / D) + RMS_EPS);
}
struct RowVecs { f32x4 gy[8], an[8], sh[8]; int cached; };
template <bool CTXROW>
__device__ __forceinline__ void rows_row(const Fr& F, const Args& a, int m, int mode, int nsplit, bool hprev_is_input, const float* ngy, const float* gatev, bool fin, const float* ngn,
                                         const float* shiftv, const float* scalev, RowVecs& C) {
    unsigned char* ws = a.ws;
    bf16* H = (bf16*)(ws + WS_H); const bf16* Y = (const bf16*)(ws + WS_MIX + MX_Y); float* YC = (float*)(ws + WS_YC); bf16* ABF = (bf16*)a.out;
    const int lane = F.lane;
    const int b = m / TB, t = m % TB, which = CTXROW ? 2 : b;
    Row y; bool ysum = false;
    if (CTXROW && mode == 1 && nsplit > 0) { ysum = true;
        const float* yc = YC + ((size_t)b * CTX + t) * D;
#pragma unroll
        for (int j = 0; j < 8; ++j) y.v[j] = (f32x4){0.f, 0.f, 0.f, 0.f};
#pragma unroll 1
        for (int sp = 0; sp < nsplit; sp += 4) { Row q0, q1, q2, q3;
            row_load(q0, yc + (size_t)sp * NB * CTX * D, lane);
            if (sp + 1 < nsplit) row_load(q1, yc + (size_t)(sp + 1) * NB * CTX * D, lane);
            if (sp + 2 < nsplit) row_load(q2, yc + (size_t)(sp + 2) * NB * CTX * D, lane);
            if (sp + 3 < nsplit) row_load(q3, yc + (size_t)(sp + 3) * NB * CTX * D, lane);
#pragma unroll
            for (int j = 0; j < 8; ++j) { f32x4 acc4 = q0.v[j];
                if (sp + 1 < nsplit) acc4 += q1.v[j];
                if (sp + 2 < nsplit) acc4 += q2.v[j];
                if (sp + 3 < nsplit) acc4 += q3.v[j];
                y.v[j] += acc4; } }
    }
    if (CTXROW || which != C.cached) { C.cached = which;
        if (mode == 1) { const float* gp = gatev + (size_t)which * 12288;
#pragma unroll
            for (int j = 0; j < 8; ++j) C.gy[j] = *(const f32x4*)(gp + 4 * lane + 256 * j) * *(const f32x4*)(ngy + 4 * lane + 256 * j); }
        if (!fin) { const float* sp = shiftv + (size_t)which * 12288; const float* cp = scalev + (size_t)which * 12288;
#pragma unroll
            for (int j = 0; j < 8; ++j) { C.an[j] = *(const f32x4*)(ngn + 4 * lane + 256 * j) * (*(const f32x4*)(cp + 4 * lane + 256 * j) + 1.0f); C.sh[j] = *(const f32x4*)(sp + 4 * lane + 256 * j); } }
    }
    const float* h0 = CTXROW ? a.in[I_CTX] + ((size_t)b * CTX + t) * D : a.in[I_X] + ((size_t)b * SEQ + (t - CTX)) * D;
    Row h;
    if (mode == 0 || hprev_is_input) row_load(h, h0, lane);
    else {
#pragma unroll
        for (int j = 0; j < 8; ++j) { const u32x2 hw = *(const u32x2*)(H + (size_t)m * D + 4 * lane + 256 * j); h.v[j] = (f32x4){bflo(hw.x), bfhi(hw.x), bflo(hw.y), bfhi(hw.y)}; } }
    if (mode == 1) {
        if (!ysum) {
#pragma unroll
            for (int j = 0; j < 8; ++j) { const u32x2 yw = *(const u32x2*)(Y + (size_t)m * D + 4 * lane + 256 * j); y.v[j] = (f32x4){bflo(yw.x), bfhi(yw.x), bflo(yw.y), bfhi(yw.y)}; } }
        const float rs = row_rstd(y);
#pragma unroll
        for (int j = 0; j < 8; ++j) h.v[j] += C.gy[j] * (y.v[j] * rs);
        if (!fin) {
#pragma unroll
            for (int j = 0; j < 8; ++j) { u32x2 hw; hw.x = pk2(h.v[j][0], h.v[j][1]); hw.y = pk2(h.v[j][2], h.v[j][3]); *(u32x2*)(H + (size_t)m * D + 4 * lane + 256 * j) = hw;
                h.v[j] = (f32x4){bflo(hw.x), bfhi(hw.x), bflo(hw.y), bfhi(hw.y)}; }
        }
    }
    if (fin) {
        float* o = a.out + ((size_t)b * SEQ + (t - CTX)) * D;
#pragma unroll
        for (int j = 0; j < 8; ++j) *(f32x4*)(o + 4 * lane + 256 * j) = h.v[j];
    } else {
        const float rs = row_rstd(h);
#pragma unroll
        for (int j = 0; j < 8; ++j) { const f32x4 o = (h.v[j] * rs) * C.an[j] + C.sh[j];
            u32x2 w; w.x = pk2(o[0], o[1]); w.y = pk2(o[2], o[3]);
            *(u32x2*)(ABF + (size_t)m * D + 4 * lane + 256 * j) = w; }
    }
}
__device__ __forceinline__ void rows_phase(const Fr& F, const Args& a, int mode, int nsplit, bool hprev_is_input, const float* ngy, const float* gatev  ,
                                           bool fin, const float* ngn, const float* shiftv, const float* scalev) {
    const int gw = F.vcu * NWAVES + F.wave, NGW = F.G * NWAVES;
    RowVecs C; C.cached = -1;
    if (NGW == 2048) {
        const int grp = gw & 3, q = gw >> 2;
        int l0, ln;
        if (grp == 0) { l0 = 2 * q; ln = 2; if (!fin) rows_row<true>(F, a, (q >> 8) * TB + (q & 255), mode, nsplit, hprev_is_input, ngy, gatev, fin, ngn, shiftv, scalev, C); }
        else if (grp == 3) { l0 = 6144 + 4 * q; ln = 4; }
        else { l0 = 1024 + 5 * (2 * q + (grp - 1)); ln = 5; }
        for (int i = 0; i < ln; ++i) { const int li = l0 + i; rows_row<false>(F, a, (li >> 12) * TB + CTX + (li & 4095), mode, nsplit, hprev_is_input, ngy, gatev, fin, ngn, shiftv, scalev, C); }
    } else {
        if (!fin) { for (int m = gw; m < M; m += NGW) { if ((m % TB) < CTX) rows_row<true>(F, a, m, mode, nsplit, hprev_is_input, ngy, gatev, fin, ngn, shiftv, scalev, C); } }
        for (int m = gw; m < M; m += NGW) { if ((m % TB) >= CTX) rows_row<false>(F, a, m, mode, nsplit, hprev_is_input, ngy, gatev, fin, ngn, shiftv, scalev, C); }
    }
}

__device__ __forceinline__ void load16s(const bf16* p, bool ok, float (&o)[16]) {
    if (ok) { float t[8]; unpack8(*(const u32x4*)p, t);
#pragma unroll
        for (int i = 0; i < 8; ++i) o[i] = t[i];
        unpack8(*(const u32x4*)(p + 8), t);
#pragma unroll
        for (int i = 0; i < 8; ++i) o[8 + i] = t[i];
    } else {
#pragma unroll
        for (int i = 0; i < 16; ++i) o[i] = 0.f;
    }
}
struct Raw16 { u32x4 a, b; };
__device__ __forceinline__ Raw16 ld16raw(const bf16* p, bool ok) { Raw16 r; const u32x4 z = {0u, 0u, 0u, 0u}; r.a = ok ? *(const u32x4*)p : z; r.b = ok ? *(const u32x4*)(p + 8) : z; return r; }
__device__ __forceinline__ void unpack16(const Raw16& r, float (&o)[16]) { float t[8]; unpack8(r.a, t);
#pragma unroll
    for (int i = 0; i < 8; ++i) o[i] = t[i];
    unpack8(r.b, t);
#pragma unroll
    for (int i = 0; i < 8; ++i) o[8 + i] = t[i]; }
__device__ __forceinline__ void store16(bf16* p, const float (&v)[16]) {
    float t[8];
#pragma unroll
    for (int i = 0; i < 8; ++i) t[i] = v[i];
    *(u32x4*)p = pack8(t);
#pragma unroll
    for (int i = 0; i < 8; ++i) t[i] = v[8 + i];
    *(u32x4*)(p + 8) = pack8(t);
}
__device__ __forceinline__ void prep_phase(const Fr& F, const Args& a) {
    unsigned char* ws = a.ws;
    const bf16* Z = (const bf16*)(ws + WS_ZR);
    bf16* R = (bf16*)(ws + WS_MIX + MX_R); bf16* V = (bf16*)(ws + WS_MIX + MX_V); bf16* Kr = (bf16*)(ws + WS_MIX + MX_K); bf16* KK = (bf16*)(ws + WS_MIX + MX_KK);
    bf16* AL = (bf16*)(ws + WS_MIX + MX_ALO);
    const float* mu = a.in[I_MU]; const float* k_k = a.in[I_KK];
    const int gw = F.vcu * NWAVES + F.wave, NGW = F.G * NWAVES, lane = F.lane;
    for (int m = gw; m < M; m += NGW) {
        const int t = m % TB;
        const bool hp = (t != 0) && (t != CTX), hn = (t != CTX - 1) && (t != TB - 1);
        const bf16* z = Z + (size_t)m * ZLD0; const bf16* zp = z - ZLD0; const bf16* zn = z + ZLD0;
        Raw16 rc[3], rl[3], rr[3];
#pragma unroll
        for (int sec = 0; sec < 3; ++sec) { const int c0 = sec * MIXA + 16 * lane; rc[sec] = ld16raw(z + c0, true); rl[sec] = ld16raw(zp + c0, hp); rr[sec] = ld16raw(zn + c0, hn); }
        const u32x4 zero4 = {0u, 0u, 0u, 0u};
        const int lcol = 3072 + 8 * (lane < 56 ? lane : 0);
        const u32x4 lc = *(const u32x4*)(z + lcol), ll = hp ? *(const u32x4*)(zp + lcol) : zero4, lr = hn ? *(const u32x4*)(zn + lcol) : zero4;
#pragma unroll
        for (int sec = 0; sec < 3; ++sec) {
            const int c0 = sec * MIXA + 16 * lane;
            float zc[16], zl[16], zr[16], o[16];
            unpack16(rc[sec], zc); unpack16(rl[sec], zl); unpack16(rr[sec], zr);
#pragma unroll
            for (int q = 0; q < 4; ++q) { const f32x4 mv = *(const f32x4*)(mu + c0 + 4 * q);
#pragma unroll
                for (int i = 0; i < 4; ++i) { const int e = 4 * q + i; o[e] = zc[e] + (0.5f * (zl[e] + zr[e]) - zc[e]) * mv[i]; } }
            if (sec == 0) store16(R + (size_t)m * MIXA + 16 * lane, o);
            else if (sec == 2) store16(V + (size_t)m * MIXA + 16 * lane, o);
            else {
                store16(Kr + (size_t)m * MIXA + 16 * lane, o);
                float kq[16]; float ss = 0.f;
#pragma unroll
                for (int q = 0; q < 4; ++q) { const f32x4 kv = *(const f32x4*)(k_k + 16 * lane + 4 * q);
#pragma unroll
                    for (int i = 0; i < 4; ++i) { const int e = 4 * q + i; kq[e] = o[e] * kv[i]; ss += kq[e] * kq[e]; } }
                ss = quad_sum(ss);
                const float inv = 1.0f / fmaxf(sqrtf(ss), 1e-12f);
#pragma unroll
                for (int e = 0; e < 16; ++e) kq[e] *= inv;
                store16(KK + (size_t)m * MIXA + 16 * lane, kq);
            }
        }
        bf16* al = AL + (size_t)m * 512;
        if (lane < 56) {
            float c8[8], l8[8], r8[8], v[8]; unpack8(lc, c8); unpack8(ll, l8); unpack8(lr, r8);
            const f32x4 m0 = *(const f32x4*)(mu + lcol), m1 = *(const f32x4*)(mu + lcol + 4);
#pragma unroll
            for (int e = 0; e < 8; ++e) { const float x = c8[e] + (0.5f * (l8[e] + r8[e]) - c8[e]) * (e < 4 ? m0[e & 3] : m1[e & 3]);
                v[e] = lane < 12 ? tanhf(x) : (lane < 24 ? x : fsigmoid(x)); }
            bf16* dst = lane < 12 ? al + 8 * lane : (lane < 24 ? al + 128 + 8 * (lane - 12) : al + 256 + 8 * (lane - 24));
            *(u32x4*)dst = pack8(v);
        } else { bf16* dst = lane < 60 ? al + 96 + 8 * (lane - 56) : al + 224 + 8 * (lane - 60); *(u32x4*)dst = zero4; }
    }
}

template <int KS>
__device__ __forceinline__ void mma16(f32x4& acc, const LAS bf16* A, int lda, int arow, const LAS bf16* Bt, int ldb, int brow, int lane) {
    const LAS bf16* ap = A + (size_t)(arow + (lane & 15)) * lda + 8 * (lane >> 4);
    const LAS bf16* bp = Bt + (size_t)(brow + (lane & 15)) * ldb + 8 * (lane >> 4);
#pragma unroll
    for (int ks = 0; ks < KS; ++ks) {
        const bf16x8 av = *(const LAS bf16x8*)(ap + ks * 32), bv = *(const LAS bf16x8*)(bp + ks * 32);
        acc = __builtin_amdgcn_mfma_f32_16x16x32_bf16(av, bv, acc, 0, 0, 0);
    }
}
template <int LD>
__device__ __forceinline__ void tr_frags64(const LAS bf16* T, int col0, int lane, bf16x8& f0, bf16x8& f1) {
    const unsigned addr = (unsigned)(size_t)(T + (8 * (lane >> 4) + ((lane & 15) >> 2)) * LD + col0 + 4 * (lane & 3));
    u32x2 a0, a1, a2, a3;
    asm volatile("ds_read_b64_tr_b16 %0, %4\n\tds_read_b64_tr_b16 %1, %4 offset:%5\n\tds_read_b64_tr_b16 %2, %4 offset:%6\n\tds_read_b64_tr_b16 %3, %4 offset:%7\n\ts_waitcnt lgkmcnt(0)\n\ts_nop 1"
                 : "=&v"(a0), "=&v"(a1), "=&v"(a2), "=&v"(a3) : "v"(addr), "i"(4 * LD * 2), "i"(32 * LD * 2), "i"(36 * LD * 2) : "memory");
    const u32x4 w0 = {a0.x, a0.y, a1.x, a1.y}, w1 = {a2.x, a2.y, a3.x, a3.y};
    f0 = __builtin_bit_cast(bf16x8, w0); f1 = __builtin_bit_cast(bf16x8, w1);
}
template <int LD>
__device__ __forceinline__ void tr_frags64x2(const LAS bf16* T0, int c0, const LAS bf16* T1, int c1, int lane, bf16x8 (&f)[2][2]) {
    const int ro = (8 * (lane >> 4) + ((lane & 15) >> 2)) * LD + 4 * (lane & 3);
    const unsigned a0 = (unsigned)(size_t)(T0 + ro + c0), a1 = (unsigned)(size_t)(T1 + ro + c1);
    u32x2 r[8];
    asm volatile("ds_read_b64_tr_b16 %0, %8\n\tds_read_b64_tr_b16 %1, %8 offset:%10\n\tds_read_b64_tr_b16 %2, %8 offset:%11\n\tds_read_b64_tr_b16 %3, %8 offset:%12\n\t"
                 "ds_read_b64_tr_b16 %4, %9\n\tds_read_b64_tr_b16 %5, %9 offset:%10\n\tds_read_b64_tr_b16 %6, %9 offset:%11\n\tds_read_b64_tr_b16 %7, %9 offset:%12\n\ts_waitcnt lgkmcnt(0)\n\ts_nop 1"
                 : "=&v"(r[0]), "=&v"(r[1]), "=&v"(r[2]), "=&v"(r[3]), "=&v"(r[4]), "=&v"(r[5]), "=&v"(r[6]), "=&v"(r[7])
                 : "v"(a0), "v"(a1), "i"(4 * LD * 2), "i"(32 * LD * 2), "i"(36 * LD * 2) : "memory");
#pragma unroll
    for (int i = 0; i < 2; ++i) { const u32x4 w0 = {r[4 * i].x, r[4 * i].y, r[4 * i + 1].x, r[4 * i + 1].y}, w1 = {r[4 * i + 2].x, r[4 * i + 2].y, r[4 * i + 3].x, r[4 * i + 3].y};
        f[i][0] = __builtin_bit_cast(bf16x8, w0); f[i][1] = __builtin_bit_cast(bf16x8, w1); }
}
template <int LD>
__device__ __forceinline__ void tr_frags64x4(const LAS bf16* T0, int c0, const LAS bf16* T1, int c1, const LAS bf16* T2, int c2, const LAS bf16* T3, int c3, int lane, bf16x8 (&f)[4][2]) {
    const int ro = (8 * (lane >> 4) + ((lane & 15) >> 2)) * LD + 4 * (lane & 3);
    const unsigned a0 = (unsigned)(size_t)(T0 + ro + c0), a1 = (unsigned)(size_t)(T1 + ro + c1), a2 = (unsigned)(size_t)(T2 + ro + c2), a3 = (unsigned)(size_t)(T3 + ro + c3);
    u32x2 r[16];
    asm volatile("ds_read_b64_tr_b16 %0, %16\n\tds_read_b64_tr_b16 %1, %16 offset:%20\n\tds_read_b64_tr_b16 %2, %16 offset:%21\n\tds_read_b64_tr_b16 %3, %16 offset:%22\n\t"
                 "ds_read_b64_tr_b16 %4, %17\n\tds_read_b64_tr_b16 %5, %17 offset:%20\n\tds_read_b64_tr_b16 %6, %17 offset:%21\n\tds_read_b64_tr_b16 %7, %17 offset:%22\n\t"
                 "ds_read_b64_tr_b16 %8, %18\n\tds_read_b64_tr_b16 %9, %18 offset:%20\n\tds_read_b64_tr_b16 %10, %18 offset:%21\n\tds_read_b64_tr_b16 %11, %18 offset:%22\n\t"
                 "ds_read_b64_tr_b16 %12, %19\n\tds_read_b64_tr_b16 %13, %19 offset:%20\n\tds_read_b64_tr_b16 %14, %19 offset:%21\n\tds_read_b64_tr_b16 %15, %19 offset:%22\n\ts_waitcnt lgkmcnt(0)\n\ts_nop 1"
                 : "=&v"(r[0]), "=&v"(r[1]), "=&v"(r[2]), "=&v"(r[3]), "=&v"(r[4]), "=&v"(r[5]), "=&v"(r[6]), "=&v"(r[7]),
                   "=&v"(r[8]), "=&v"(r[9]), "=&v"(r[10]), "=&v"(r[11]), "=&v"(r[12]), "=&v"(r[13]), "=&v"(r[14]), "=&v"(r[15])
                 : "v"(a0), "v"(a1), "v"(a2), "v"(a3), "i"(4 * LD * 2), "i"(32 * LD * 2), "i"(36 * LD * 2) : "memory");
#pragma unroll
    for (int i = 0; i < 4; ++i) { const u32x4 w0 = {r[4 * i].x, r[4 * i].y, r[4 * i + 1].x, r[4 * i + 1].y}, w1 = {r[4 * i + 2].x, r[4 * i + 2].y, r[4 * i + 3].x, r[4 * i + 3].y};
        f[i][0] = __builtin_bit_cast(bf16x8, w0); f[i][1] = __builtin_bit_cast(bf16x8, w1); }
}
__device__ __forceinline__ int chunk_tok(int d, int ci, int p) { const int uc = (d == 0) ? ci : (ci < 4 ? 3 - ci : 71 - ci); return (d == 0) ? uc * 64 + p : uc * 64 + 63 - p; }
__device__ __forceinline__ float dpp_allreduce4(float x) {
    x += __int_as_float(__builtin_amdgcn_update_dpp(0, __float_as_int(x), 0xB1, 0xF, 0xF, false));
    x += __int_as_float(__builtin_amdgcn_update_dpp(0, __float_as_int(x), 0x4E, 0xF, 0xF, false));
    return x;
}
__device__ __forceinline__ float quad_bcast(float v, int src) {
    const int iv = __float_as_int(v);
    const int r = src == 0 ? __builtin_amdgcn_update_dpp(0, iv, 0x00, 0xF, 0xF, false) : src == 1 ? __builtin_amdgcn_update_dpp(0, iv, 0x55, 0xF, 0xF, false)
                : src == 2 ? __builtin_amdgcn_update_dpp(0, iv, 0xAA, 0xF, 0xF, false) : __builtin_amdgcn_update_dpp(0, iv, 0xFF, 0xF, 0xF, false);
    return __int_as_float(r);
}
__device__ __forceinline__ void rwkv_pre_phase(const Fr& F, const Args& a, int wgi, int nWG) {
    unsigned char* ws = a.ws;
    const bf16* R = (const bf16*)(ws + WS_MIX + MX_R); const bf16* V = (const bf16*)(ws + WS_MIX + MX_V); const bf16* Km = (const bf16*)(ws + WS_MIX + MX_K);
    const bf16* KK = (const bf16*)(ws + WS_MIX + MX_KK); const bf16* BV = (const bf16*)(ws + WS_MIX + MX_BV);
    constexpr int LT = 72;
    LAS bf16* AT = (LAS bf16*)F.lds; LAS bf16* BT = AT + 64 * LT; LAS bf16* KT = BT + 64 * LT; LAS bf16* RT = KT + 64 * LT; LAS bf16* VM = RT + 64 * LT;
    LAS float* ATF = (LAS float*)(VM + 64 * LT); LAS float* LAB = ATF + 4096;
    LAS bf16* LKA = (LAS bf16*)(LAB + 64 * 68); LAS bf16* LBR = LKA + 64 * LT; LAS bf16* LKR = LBR + 64 * LT;
    LAS float* RHZ = (LAS float*)(LKR + 64 * LT);
    LAS bf16* XI = (LAS bf16*)(RHZ + 4096); LAS bf16* ZI = XI + 64 * LT;
    LAS float* WC = (LAS float*)(ZI + 64 * LT);
    LAS float* LW = RHZ; LAS float* SEG = (LAS float*)XI;
    const int tid = F.tid, lane = F.lane, w = F.wave;
    u32x4 nrr = {0, 0, 0, 0}, nkr = nrr, nvr = nrr, nar = nrr, nbr = nrr; f32x4 nlw0 = {0.f, 0.f, 0.f, 0.f}, nlw1 = nlw0;
    auto issue_loads = [&](int it2) {
        const int d_ = it2 / (int)RW_ITEMS, it_ = it2 % (int)RW_ITEMS, bh_ = it_ / (TB / 64), ci_ = it_ % (TB / 64);
        const size_t off = ((size_t)(bh_ >> 4) * TB + chunk_tok(d_, ci_, tid >> 3)) * MIXA + (bh_ & 15) * 64 + (tid & 7) * 8;
        const float* lwd = (const float*)(ws + WS_MIX + MX_DEC) + (size_t)d_ * M * MIXA;
        nrr = *(const u32x4*)(R + off); nkr = *(const u32x4*)(Km + off); nvr = *(const u32x4*)(V + off); nar = *(const u32x4*)(KK + off); nbr = *(const u32x4*)(BV + off);
        nlw0 = *(const f32x4*)(lwd + off); nlw1 = *(const f32x4*)(lwd + off + 4);
    };
    if (wgi < 2 * (int)RW_ITEMS) issue_loads(wgi);
    for (int item2 = wgi; item2 < 2 * (int)RW_ITEMS; item2 += nWG) {
        const int d = item2 / (int)RW_ITEMS, item = item2 % (int)RW_ITEMS;
        unsigned char* ob = d ? (ws + WS_H) : (ws + WS_RWG);
        bf16* GO = (bf16*)ob; bf16* PO = (bf16*)(ob + RW_ITEMS * 8192); bf16* YO = (bf16*)(ob + 2 * RW_ITEMS * 8192); bf16* QO = (bf16*)(ob + 3 * RW_ITEMS * 8192);
        const int bh = item / (TB / 64), ci = item % (TB / 64), b = bh >> 4, h = bh & 15;
        const size_t rowb = (size_t)b * TB;
        const int p = tid >> 3, c8 = (tid & 7) * 8;
        const u32x4 rr = nrr, kr = nkr, vr = nvr, ar = nar, br = nbr; const f32x4 lw0 = nlw0, lw1 = nlw1;
        if (item2 + nWG < 2 * (int)RW_ITEMS) issue_loads(item2 + nWG);
        *(LAS f32x4*)(LW + p * 64 + c8) = lw0; *(LAS f32x4*)(LW + p * 64 + c8 + 4) = lw1;
        __syncthreads();
        {
            const int col = tid & 63, seg = tid >> 6; float pf[8];
#pragma unroll
            for (int q = 0; q < 8; ++q) pf[q] = LW[(8 * seg + q) * 64 + col];
#pragma unroll
            for (int q = 1; q < 8; ++q) pf[q] += pf[q - 1];
            SEG[seg * 64 + col] = pf[7];
            __syncthreads();
            float offs = 0.f;
#pragma unroll
            for (int s2 = 0; s2 < 7; ++s2) { const float sv = SEG[s2 * 64 + col]; offs += (s2 < seg) ? sv : 0.f; }
#pragma unroll
            for (int q = 0; q < 8; ++q) LW[(8 * seg + q) * 64 + col] = pf[q] + offs;
        }
        __syncthreads();
        {
            const f32x4 c0 = *(const LAS f32x4*)(LW + p * 64 + c8), c1 = *(const LAS f32x4*)(LW + p * 64 + c8 + 4);
            float r8[8], k8[8], a8[8], b8[8], at[8];
            unpack8(rr, r8); unpack8(kr, k8); unpack8(ar, a8); unpack8(br, b8);
#pragma unroll
            for (int i = 0; i < 8; ++i) { const float cum = i < 4 ? c0[i & 3] : c1[i & 3], lwr = i < 4 ? lw0[i & 3] : lw1[i & 3];
                const float Wt = fexp(cum), iWt = fexp(-cum), Wp = fexp(cum - lwr);
                at[i] = -a8[i] * Wp; b8[i] *= iWt; k8[i] *= iWt; r8[i] *= Wt;
                if (p == 63) WC[c8 + i] = Wt; }
            *(LAS u32x4*)(AT + p * LT + c8) = pack8(at); *(LAS u32x4*)(BT + p * LT + c8) = pack8(b8); *(LAS u32x4*)(KT + p * LT + c8) = pack8(k8); *(LAS u32x4*)(RT + p * LT + c8) = pack8(r8);
            *(LAS u32x4*)(VM + p * LT + c8) = vr;
        }
        __syncthreads();
        {
            const int g = w >> 1; const LAS bf16* Am = (g < 2) ? AT : RT; const LAS bf16* Bm = (g & 1) ? KT : BT;
            bf16x8 bfr[4][2];
#pragma unroll
            for (int nt = 0; nt < 4; ++nt) { const LAS bf16* bp = Bm + (size_t)(16 * nt + (lane & 15)) * LT + 8 * (lane >> 4); bfr[nt][0] = *(const LAS bf16x8*)bp; bfr[nt][1] = *(const LAS bf16x8*)(bp + 32); }
#pragma unroll
            for (int e2 = 0; e2 < 2; ++e2) { const int mt = (w & 1) * 2 + e2;
                const LAS bf16* ap = Am + (size_t)(16 * mt + (lane & 15)) * LT + 8 * (lane >> 4); const bf16x8 a0 = *(const LAS bf16x8*)ap, a1 = *(const LAS bf16x8*)(ap + 32);
#pragma unroll
                for (int nt = 0; nt < 4; ++nt) { f32x4 acc = {0.f, 0.f, 0.f, 0.f};
                    if (nt <= mt) { acc = __builtin_amdgcn_mfma_f32_16x16x32_bf16(a0, bfr[nt][0], acc, 0, 0, 0); acc = __builtin_amdgcn_mfma_f32_16x16x32_bf16(a1, bfr[nt][1], acc, 0, 0, 0); }
#pragma unroll
                    for (int r = 0; r < 4; ++r) { const int t = 16 * mt + 4 * (lane >> 4) + r, i = 16 * nt + (lane & 15);
                        const bool keep = (g < 2) ? (i < t) : (i <= t); const float val = keep ? acc[r] : 0.f;
                        if (g == 0) LAB[i * 68 + (t & 3) * 16 + (t >> 2)] = val;
                        else { LAS bf16* dst = (g == 1) ? LKA : (g == 2 ? LBR : LKR); dst[t * LT + i] = f2bf(val); } } } }
        }
        __syncthreads();
        LAS bf16* TI = (LAS bf16*)ATF;
        LAS bf16* RZ = (LAS bf16*)RHZ;
        if (w < 4) {
            const int col = w * 16 + (lane >> 2), part = lane & 3;
            f32x2 x[8];
#pragma unroll
            for (int j = 0; j < 8; ++j) { x[j][0] = (8 * j + part == col) ? 1.f : 0.f; x[j][1] = (8 * j + 4 + part == col) ? 1.f : 0.f; }
#pragma unroll
            for (int t = 0; t < 64; ++t) {
                const float xs = quad_bcast(x[t >> 3][(t >> 2) & 1], t & 3); const f32x2 xv = {xs, xs};
#pragma unroll
                for (int j4 = (t >> 4); j4 < 4; ++j4) { const f32x4 l = *(const LAS f32x4*)(LAB + t * 68 + part * 16 + 4 * j4);
                    x[2 * j4] += (f32x2){l[0], l[1]} * xv; x[2 * j4 + 1] += (f32x2){l[2], l[3]} * xv; }
            }
#pragma unroll
            for (int j = 0; j < 8; ++j) { TI[(8 * j + part) * LT + col] = f2bf(x[j][0]); TI[(8 * j + 4 + part) * LT + col] = f2bf(x[j][1]); }
        } else {
            const int w4 = w - 4;
            bf16x8 vf0, vf1; tr_frags64<LT>(VM, 16 * w4, lane, vf0, vf1);
#pragma unroll
            for (int nt = 0; nt < 4; ++nt) { f32x4 acc = {0.f, 0.f, 0.f, 0.f};
                const LAS bf16* bp = LKA + (size_t)(16 * nt + (lane & 15)) * LT + 8 * (lane >> 4);
                acc = __builtin_amdgcn_mfma_f32_16x16x32_bf16(vf0, *(const LAS bf16x8*)bp, acc, 0, 0, 0);
                acc = __builtin_amdgcn_mfma_f32_16x16x32_bf16(vf1, *(const LAS bf16x8*)(bp + 32), acc, 0, 0, 0);
                u32x2 o; o.x = pk2(acc[0], acc[1]); o.y = pk2(acc[2], acc[3]);
                *(LAS u32x2*)(RZ + (16 * nt + (lane & 15)) * LT + 16 * w4 + 4 * (lane >> 4)) = o; }
        }
        __syncthreads();
        {
            const LAS bf16* src = (w < 4) ? AT : RZ; LAS bf16* dst = (w < 4) ? XI : ZI; const int ct = w & 3;
            bf16x8 af0, af1; tr_frags64<LT>(src, 16 * ct, lane, af0, af1);
#pragma unroll
            for (int nt = 0; nt < 4; ++nt) { f32x4 acc = {0.f, 0.f, 0.f, 0.f};
                const LAS bf16* bp = TI + (size_t)(16 * nt + (lane & 15)) * LT + 8 * (lane >> 4);
                acc = __builtin_amdgcn_mfma_f32_16x16x32_bf16(af0, *(const LAS bf16x8*)bp, acc, 0, 0, 0);
                acc = __builtin_amdgcn_mfma_f32_16x16x32_bf16(af1, *(const LAS bf16x8*)(bp + 32), acc, 0, 0, 0);
                u32x2 o; o.x = pk2(acc[0], acc[1]); o.y = pk2(acc[2], acc[3]);
                *(LAS u32x2*)(dst + (16 * nt + (lane & 15)) * LT + 16 * ct + 4 * (lane >> 4)) = o; }
        }
        __syncthreads();
        {
            const int mq = w >> 1; const size_t ib = (size_t)item * 4096;
#pragma unroll
            for (int e2 = 0; e2 < 2; ++e2) { const int mt = (w & 1) * 2 + e2; const int rr0 = 16 * mt + 4 * (lane >> 4);
                if (mq == 0) {
                    bf16x8 xf0, xf1; tr_frags64<LT>(XI, 16 * mt, lane, xf0, xf1);
#pragma unroll
                    for (int nt = 0; nt < 4; ++nt) { const int cc = 16 * nt + (lane & 15); f32x4 acc = {0.f, 0.f, 0.f, 0.f};
                        const LAS bf16* bp = LBR + (size_t)cc * LT + 8 * (lane >> 4);
                        acc = __builtin_amdgcn_mfma_f32_16x16x32_bf16(xf0, *(const LAS bf16x8*)bp, acc, 0, 0, 0);
                        acc = __builtin_amdgcn_mfma_f32_16x16x32_bf16(xf1, *(const LAS bf16x8*)(bp + 32), acc, 0, 0, 0);
                        const u32x2 rw = *(const LAS u32x2*)(RT + cc * LT + rr0);
                        u32x2 o; o.x = pk2(acc[0] + bflo(rw.x), acc[1] + bfhi(rw.x)); o.y = pk2(acc[2] + bflo(rw.y), acc[3] + bfhi(rw.y));
                        *(u32x2*)(GO + ib + (size_t)cc * 64 + rr0) = o; }
                } else if (mq == 1) {
                    bf16x8 f[2][2]; tr_frags64x2<LT>(ZI, 16 * mt, VM, 16 * mt, lane, f);
#pragma unroll
                    for (int nt = 0; nt < 4; ++nt) { const int cc = 16 * nt + (lane & 15); f32x4 acc = {0.f, 0.f, 0.f, 0.f};
                        const LAS bf16* bp = LBR + (size_t)cc * LT + 8 * (lane >> 4); const LAS bf16* cp = LKR + (size_t)cc * LT + 8 * (lane >> 4);
                        acc = __builtin_amdgcn_mfma_f32_16x16x32_bf16(f[0][0], *(const LAS bf16x8*)bp, acc, 0, 0, 0);
                        acc = __builtin_amdgcn_mfma_f32_16x16x32_bf16(f[0][1], *(const LAS bf16x8*)(bp + 32), acc, 0, 0, 0);
                        acc = __builtin_amdgcn_mfma_f32_16x16x32_bf16(f[1][0], *(const LAS bf16x8*)cp, acc, 0, 0, 0);
                        acc = __builtin_amdgcn_mfma_f32_16x16x32_bf16(f[1][1], *(const LAS bf16x8*)(cp + 32), acc, 0, 0, 0);
                        u32x2 o; o.x = pk2(acc[0], acc[1]); o.y = pk2(acc[2], acc[3]);
                        *(u32x2*)(YO + ib + (size_t)cc * 64 + rr0) = o; }
                } else if (mq == 2) {
                    bf16x8 xf0, xf1; tr_frags64<LT>(XI, 16 * mt, lane, xf0, xf1);
                    bf16x8 g[4][2]; tr_frags64x4<LT>(BT, 0, BT, 16, BT, 32, BT, 48, lane, g);
#pragma unroll
                    for (int nt = 0; nt < 4; ++nt) { const int cc = 16 * nt + (lane & 15); f32x4 acc = {0.f, 0.f, 0.f, 0.f};
                        acc = __builtin_amdgcn_mfma_f32_16x16x32_bf16(xf0, g[nt][0], acc, 0, 0, 0);
                        acc = __builtin_amdgcn_mfma_f32_16x16x32_bf16(xf1, g[nt][1], acc, 0, 0, 0);
                        const float wc = WC[cc];
                        u32x2 o; o.x = pk2(wc * (acc[0] + (rr0 == cc ? 1.f : 0.f)), wc * (acc[1] + (rr0 + 1 == cc ? 1.f : 0.f)));
                        o.y = pk2(wc * (acc[2] + (rr0 + 2 == cc ? 1.f : 0.f)), wc * (acc[3] + (rr0 + 3 == cc ? 1.f : 0.f)));
                        *(u32x2*)(PO + ib + (size_t)cc * 64 + rr0) = o; }
                } else {
                    bf16x8 fa[2][2]; tr_frags64x2<LT>(BT, 16 * mt, KT, 16 * mt, lane, fa);
                    bf16x8 gz[4][2], gv[4][2]; tr_frags64x4<LT>(ZI, 0, ZI, 16, ZI, 32, ZI, 48, lane, gz); tr_frags64x4<LT>(VM, 0, VM, 16, VM, 32, VM, 48, lane, gv);
                    const f32x4 wc = *(const LAS f32x4*)(WC + rr0);
#pragma unroll
                    for (int nt = 0; nt < 4; ++nt) { const int cc = 16 * nt + (lane & 15); f32x4 acc = {0.f, 0.f, 0.f, 0.f};
                        acc = __builtin_amdgcn_mfma_f32_16x16x32_bf16(fa[0][0], gz[nt][0], acc, 0, 0, 0);
                        acc = __builtin_amdgcn_mfma_f32_16x16x32_bf16(fa[0][1], gz[nt][1], acc, 0, 0, 0);
                        acc = __builtin_amdgcn_mfma_f32_16x16x32_bf16(fa[1][0], gv[nt][0], acc, 0, 0, 0);
                        acc = __builtin_amdgcn_mfma_f32_16x16x32_bf16(fa[1][1], gv[nt][1], acc, 0, 0, 0);
                        u32x2 o; o.x = pk2(wc[0] * acc[0], wc[1] * acc[1]); o.y = pk2(wc[2] * acc[2], wc[3] * acc[3]);
                        *(u32x2*)(QO + ib + (size_t)cc * 64 + rr0) = o; }
                }
            }
        }
        __syncthreads();
    }
}
__device__ __forceinline__ void rwkv_seq_phase(const Fr& F, const Args& a, int wgi, int nWG) {
    unsigned char* ws = a.ws;
    constexpr int LT = 72, SLOT = 32768, RING0 = 2 * 64 * LT * 2;
    LAS bf16* SH = (LAS bf16*)F.lds; LAS bf16* SL = SH + 64 * LT;
    LAS unsigned char* ring = F.lds + RING0;
    const int tid = F.tid, lane = F.lane, w = F.wave, fr = lane & 15, fq = lane >> 4;
    for (int ch = wgi; ch < 2 * NB * 16; ch += nWG) {
        const int d = ch >> 5, bh = ch & 31, b = bh >> 4, h = bh & 15; const size_t rowb = (size_t)b * TB;
        const unsigned char* ob = d ? (ws + WS_H) : (ws + WS_RWG);
        bf16* YA = (bf16*)(ws + WS_MIX + MX_YA) + (size_t)d * M * MIXA;
        for (int i = tid; i < 2 * 64 * LT / 2; i += NTHR) ((LAS unsigned*)SH)[i] = 0u;
        const unsigned srcoff = (unsigned)((tid >> 3) * 128 + (((tid & 7) ^ ((tid >> 3) & 7)) * 16));
        auto issue = [&](int ci_) { const int ci = ci_ < TB / 64 ? ci_ : TB / 64 - 1;
            const unsigned char* src = ob + ((size_t)bh * (TB / 64) + ci) * 8192 + srcoff; LAS unsigned char* dst = ring + (ci_ & 3) * SLOT + w * 1024;
#pragma unroll
            for (int j = 0; j < 4; ++j)
                __builtin_amdgcn_global_load_lds((const unsigned*)(src + (size_t)j * RW_ITEMS * 8192), (LAS unsigned*)(dst + j * 8192), 16, 0, 0); };
        issue(0); issue(1); issue(2);
        asm volatile("s_waitcnt lgkmcnt(0)" ::: "memory");
        for (int ci = 0; ci < TB / 64; ++ci) {
            if (ci < 2) asm volatile("s_waitcnt vmcnt(8)" ::: "memory"); else asm volatile("s_waitcnt vmcnt(12)" ::: "memory");
            __builtin_amdgcn_s_barrier();
            asm volatile("" ::: "memory");
            issue(ci + 3);
            const LAS unsigned char* slot = ring + (ci & 3) * SLOT;
            f32x4 sn[2];
#pragma unroll
            for (int e = 0; e < 2; ++e) { const int tile = 2 * w + e, mt = tile >> 2, nt = tile & 3;
                const int rt = 16 * nt + fr, rk = 16 * mt + fr;
                const LAS unsigned char* gr = slot + rt * 128; const LAS unsigned char* pr = slot + 8192 + rk * 128;
                const bf16x8 g0 = *(const LAS bf16x8*)(gr + (((fq) ^ (rt & 7)) * 16)), g1 = *(const LAS bf16x8*)(gr + (((fq + 4) ^ (rt & 7)) * 16));
                const bf16x8 p0 = *(const LAS bf16x8*)(pr + (((fq) ^ (rk & 7)) * 16)), p1 = *(const LAS bf16x8*)(pr + (((fq + 4) ^ (rk & 7)) * 16));
                const int cpos = ((2 * mt + (fq >> 1)) ^ (rt & 7)) * 16 + (fq & 1) * 8;
                const u32x2 yl = *(const LAS u32x2*)(slot + 16384 + rt * 128 + cpos), ql = *(const LAS u32x2*)(slot + 24576 + rt * 128 + cpos);
                f32x4 acc = {bflo(yl.x), bfhi(yl.x), bflo(yl.y), bfhi(yl.y)};
                const LAS bf16* sh = SH + (size_t)(16 * mt + fr) * LT + 8 * fq; const LAS bf16* sl = SL + (size_t)(16 * mt + fr) * LT + 8 * fq;
                acc = __builtin_amdgcn_mfma_f32_16x16x32_bf16(*(const LAS bf16x8*)sh, g0, acc, 0, 0, 0);
                acc = __builtin_amdgcn_mfma_f32_16x16x32_bf16(*(const LAS bf16x8*)(sh + 32), g1, acc, 0, 0, 0);
                acc = __builtin_amdgcn_mfma_f32_16x16x32_bf16(*(const LAS bf16x8*)sl, g0, acc, 0, 0, 0);
                acc = __builtin_amdgcn_mfma_f32_16x16x32_bf16(*(const LAS bf16x8*)(sl + 32), g1, acc, 0, 0, 0);
                u32x2 o; o.x = pk2(acc[0], acc[1]); o.y = pk2(acc[2], acc[3]);
                *(u32x2*)(YA + (rowb + chunk_tok(d, ci, rt)) * MIXA + h * 64 + 16 * mt + 4 * fq) = o;
                f32x4 s2 = {bflo(ql.x), bfhi(ql.x), bflo(ql.y), bfhi(ql.y)};
                const LAS bf16* th = SH + (size_t)(16 * nt + fr) * LT + 8 * fq; const LAS bf16* tl = SL + (size_t)(16 * nt + fr) * LT + 8 * fq;
                s2 = __builtin_amdgcn_mfma_f32_16x16x32_bf16(p0, *(const LAS bf16x8*)th, s2, 0, 0, 0);
                s2 = __builtin_amdgcn_mfma_f32_16x16x32_bf16(p1, *(const LAS bf16x8*)(th + 32), s2, 0, 0, 0);
                s2 = __builtin_amdgcn_mfma_f32_16x16x32_bf16(p0, *(const LAS bf16x8*)tl, s2, 0, 0, 0);
                s2 = __builtin_amdgcn_mfma_f32_16x16x32_bf16(p1, *(const LAS bf16x8*)(tl + 32), s2, 0, 0, 0);
                sn[e] = s2; }
            asm volatile("s_waitcnt lgkmcnt(0)" ::: "memory");
            __builtin_amdgcn_s_barrier();
            asm volatile("" ::: "memory");
#pragma unroll
            for (int e = 0; e < 2; ++e) { const int tile = 2 * w + e, mt = tile >> 2, nt = tile & 3;
                u32x2 hi; hi.x = pk2(sn[e][0], sn[e][1]); hi.y = pk2(sn[e][2], sn[e][3]);
                u32x2 lo; lo.x = pk2(sn[e][0] - bflo(hi.x), sn[e][1] - bfhi(hi.x)); lo.y = pk2(sn[e][2] - bflo(hi.y), sn[e][3] - bfhi(hi.y));
                *(LAS u32x2*)(SH + (size_t)(16 * nt + fr) * LT + 16 * mt + 4 * fq) = hi; *(LAS u32x2*)(SL + (size_t)(16 * nt + fr) * LT + 16 * mt + 4 * fq) = lo; }
            asm volatile("s_waitcnt lgkmcnt(0)" ::: "memory");
        }
        asm volatile("s_waitcnt vmcnt(0)" ::: "memory");
        __builtin_amdgcn_s_barrier();
        asm volatile("" ::: "memory");
    }
}

__device__ __forceinline__ void gla_pre_phase(const Fr& F, const Args& a, int wgi, int nWG) {
    unsigned char* ws = a.ws;
    const bf16* Z = (const bf16*)(ws + WS_ZR); bf16* YB = (bf16*)(ws + WS_MIX + MX_YB);
    bf16* GQI = (bf16*)((unsigned char*)a.out + DO_GQI); bf16* GKI = (bf16*)(ws + WS_GKI); float* GDL = (float*)(ws + WS_GDL);
    const float* gk_up = a.in[I_GKUP]; const float* gk_b = a.in[I_GKB];
    constexpr int DK = 128, LQ = DK + 24, LV = 256 + 8, LT = 72;
    LAS bf16* QIN = (LAS bf16*)F.lds; LAS bf16* KIN = QIN + 64 * LQ; LAS bf16* VI = KIN + 64 * LQ; LAS bf16* ATT = VI + 64 * LV;
    LAS float* BC = (LAS float*)(ATT + 64 * LT); LAS float* QS = BC + 64 * DK; LAS float* GD = QS + 4 * DK;
    const int tid = F.tid, lane = F.lane, w = F.wave;
    const float qscale = 0.08838834764831845f;
    for (int item = wgi; item < (int)GLA_ITEMS; item += nWG) {
        const int ci = item % (TB / 64), d = (item / (TB / 64)) & 1, h = (item / (2 * (TB / 64))) & 3, b = item / (8 * (TB / 64));
        const size_t rowb = (size_t)b * TB;
        const int col = tid & (DK - 1);
        float gku[16];
#pragma unroll
        for (int j = 0; j < 16; ++j) gku[j] = gk_up[((size_t)d * 16 + j) * 512 + h * DK + col];
        const float gkb = gk_b[d * 512 + h * DK + col];
        u32x4 qreg[2], kreg[2], vreg[4], gdreg = {0, 0, 0, 0};
#pragma unroll
        for (int it = 0; it < 2; ++it) { const int idx = tid + it * NTHR; const int p = idx >> 4, kc = (idx & 15) * 8; const bf16* zr = Z + (rowb + chunk_tok(d, ci, p)) * ZLD0;
            qreg[it] = *(const u32x4*)(zr + GQ + h * DK + kc); kreg[it] = *(const u32x4*)(zr + GK + h * DK + kc); }
#pragma unroll
        for (int it = 0; it < 4; ++it) { const int idx = tid + it * NTHR; const int p = idx >> 5, vc = (idx & 31) * 8;
            vreg[it] = *(const u32x4*)(Z + (rowb + chunk_tok(d, ci, p)) * ZLD0 + GV + h * 256 + vc); }
        if (tid < 128) { const int p = tid >> 1, hf = tid & 1; gdreg = *(const u32x4*)(Z + (rowb + chunk_tok(d, ci, p)) * ZLD0 + GGD + 8 * hf); }
        if (tid < 128) { const int p = tid >> 1, hf = tid & 1; float t8[8]; unpack8(gdreg, t8);
            *(LAS f32x4*)(GD + p * 16 + 8 * hf) = (f32x4){t8[0], t8[1], t8[2], t8[3]}; *(LAS f32x4*)(GD + p * 16 + 8 * hf + 4) = (f32x4){t8[4], t8[5], t8[6], t8[7]}; }
        __syncthreads();
        {
            const int qq = tid / DK; float bc[16];
#pragma unroll
            for (int pp = 0; pp < 16; ++pp) { const int p = 16 * qq + pp; float x = gkb;
                const f32x4 g0 = *(const LAS f32x4*)(GD + p * 16), g1 = *(const LAS f32x4*)(GD + p * 16 + 4), g2 = *(const LAS f32x4*)(GD + p * 16 + 8), g3 = *(const LAS f32x4*)(GD + p * 16 + 12);
#pragma unroll
                for (int j = 0; j < 4; ++j) { x += g0[j] * gku[j]; x += g1[j] * gku[4 + j]; x += g2[j] * gku[8 + j]; x += g3[j] * gku[12 + j]; }
                bc[pp] = flogsigmoid(x) * (1.0f / 16.0f); }
#pragma unroll
            for (int pp = 1; pp < 16; ++pp) bc[pp] += bc[pp - 1];
            QS[qq * DK + col] = bc[15];
            __syncthreads();
            float offs = 0.f;
#pragma unroll
            for (int q2 = 0; q2 < 3; ++q2) { const float sv = QS[q2 * DK + col]; offs += (q2 < qq) ? sv : 0.f; }
#pragma unroll
            for (int pp = 0; pp < 16; ++pp) BC[(16 * qq + pp) * DK + col] = bc[pp] + offs;
        }
        __syncthreads();
#pragma unroll
        for (int it = 0; it < 2; ++it) { const int idx = tid + it * NTHR; const int p = idx >> 4, kc = (idx & 15) * 8;
            float q8[8], k8[8]; unpack8(qreg[it], q8); unpack8(kreg[it], k8);
            const f32x4 b0 = *(const LAS f32x4*)(BC + p * DK + kc), b1 = *(const LAS f32x4*)(BC + p * DK + kc + 4);
#pragma unroll
            for (int i = 0; i < 8; ++i) { const float bc = i < 4 ? b0[i & 3] : b1[i & 3]; q8[i] *= fexp(bc) * qscale; k8[i] *= fexp(-bc); }
            const u32x4 qw = pack8(q8), kw = pack8(k8);
            *(LAS u32x4*)(QIN + p * LQ + kc) = qw; *(LAS u32x4*)(KIN + p * LQ + kc) = kw;
            *(u32x4*)(GQI + (size_t)item * 8192 + p * DK + kc) = qw; *(u32x4*)(GKI + (size_t)item * 8192 + p * DK + kc) = kw; }
#pragma unroll
        for (int it = 0; it < 4; ++it) { const int idx = tid + it * NTHR; const int p = idx >> 5, vc = (idx & 31) * 8; *(LAS u32x4*)(VI + p * LV + vc) = vreg[it]; }
        if (tid < DK) GDL[(size_t)item * DK + tid] = fexp(BC[63 * DK + tid]);
        __syncthreads();
        { const int mt = w >> 1;
#pragma unroll
          for (int e = 0; e < 2; ++e) { const int nt = (w & 1) * 2 + e; f32x4 acc = {0.f, 0.f, 0.f, 0.f};
              if (nt <= mt) mma16<DK / 32>(acc, QIN, LQ, 16 * mt, KIN, LQ, 16 * nt, lane);
#pragma unroll
              for (int r = 0; r < 4; ++r) { const int i = 16 * mt + 4 * (lane >> 4) + r, j = 16 * nt + (lane & 15);
                  ATT[i * LT + j] = f2bf(j <= i ? acc[r] : 0.f); } } }
        __syncthreads();
        { bf16x8 af[4][2];
#pragma unroll
          for (int mt = 0; mt < 4; ++mt) { const LAS bf16* ap = ATT + (size_t)(16 * mt + (lane & 15)) * LT + 8 * (lane >> 4); af[mt][0] = *(const LAS bf16x8*)ap; af[mt][1] = *(const LAS bf16x8*)(ap + 32); }
          bf16x8 vf[2][2]; tr_frags64x2<LV>(VI, 32 * w, VI, 32 * w + 16, lane, vf);
          bf16* yb = YB + (size_t)d * M * MIXA;
#pragma unroll
          for (int e = 0; e < 2; ++e)
#pragma unroll
              for (int mt = 0; mt < 4; ++mt) { f32x4 acc = {0.f, 0.f, 0.f, 0.f};
                  acc = __builtin_amdgcn_mfma_f32_16x16x32_bf16(vf[e][0], af[mt][0], acc, 0, 0, 0);
                  acc = __builtin_amdgcn_mfma_f32_16x16x32_bf16(vf[e][1], af[mt][1], acc, 0, 0, 0);
                  u32x2 o; o.x = pk2(acc[0], acc[1]); o.y = pk2(acc[2], acc[3]);
                  *(u32x2*)(yb + (rowb + chunk_tok(d, ci, 16 * mt + (lane & 15))) * MIXA + h * 256 + 32 * w + 16 * e + 4 * (lane >> 4)) = o; } }
        __syncthreads();
    }
}
__device__ __forceinline__ void gla_seq_phase(const Fr& F, const Args& a, int wgi, int nWG) {
    unsigned char* ws = a.ws;
    const bf16* Z = (const bf16*)(ws + WS_ZR); bf16* OC2 = (bf16*)(ws + WS_MIX + MX_DEC);
    const bf16* GQI = (const bf16*)((const unsigned char*)a.out + DO_GQI); const bf16* GKI = (const bf16*)(ws + WS_GKI); const float* GDL = (const float*)(ws + WS_GDL);
    constexpr int DK = 128, LQ = DK + 24, SLOT = 37888, RING0 = 32 * LQ * 2;
    LAS bf16* ST = (LAS bf16*)F.lds; LAS unsigned char* ring = F.lds + RING0;
    static_assert(RING0 % 16 == 0 && RING0 + 4 * SLOT <= LDS_BYTES - 16, "GLA recurrence LDS map");
    const int tid = F.tid, lane = F.lane, w = F.wave, fr = lane & 15, fq = lane >> 4;
    for (int unit = wgi; unit < 128; unit += nWG) {
        const int vs = unit & 7, d = (unit >> 3) & 1, h = (unit >> 4) & 3, b = unit >> 6;
        const size_t rowb = (size_t)b * TB; const size_t it0 = (size_t)((b * 4 + h) * 2 + d) * (TB / 64);
        bf16* oc = OC2 + (size_t)d * M * MIXA;
        f32x4 S[2] = {{0.f, 0.f, 0.f, 0.f}, {0.f, 0.f, 0.f, 0.f}};
        const int vt = w >> 2, nt = w & 3;
        auto issue = [&](int ci_) { const int ci = ci_ < TB / 64 ? ci_ : TB / 64 - 1; const size_t ib = (it0 + ci) * 8192;
            LAS unsigned char* dst = ring + (ci_ & 3) * SLOT;
#pragma unroll
            for (int j = 0; j < 2; ++j) { const int lin = j * 8192 + tid * 16; const int r = lin >> 8, pp = (lin >> 4) & 15; const int sp = pp ^ (r & 7);
                __builtin_amdgcn_global_load_lds((const unsigned*)((const unsigned char*)GKI + ib * 2 + r * 256 + sp * 16), (LAS unsigned*)(dst + j * 8192 + w * 1024), 16, 0, 0);
                __builtin_amdgcn_global_load_lds((const unsigned*)((const unsigned char*)GQI + ib * 2 + r * 256 + sp * 16), (LAS unsigned*)(dst + 16384 + j * 8192 + w * 1024), 16, 0, 0); }
            { const int t2 = tid & 255; const int r = t2 >> 2, pc = t2 & 3;
              __builtin_amdgcn_global_load_lds((const unsigned*)(Z + (rowb + chunk_tok(d, ci, r)) * ZLD0 + GV + h * 256 + vs * 32 + pc * 8), (LAS unsigned*)(dst + 32768 + (w & 3) * 1024), 16, 0, 0); }
            { const int t3 = lane & 31;
              __builtin_amdgcn_global_load_lds((const unsigned*)(GDL + (it0 + ci) * DK + t3 * 4), (LAS unsigned*)(dst + 36864), 16, 0, 0); }
        };
        issue(0); issue(1); issue(2);
#pragma unroll
        for (int e = 0; e < 2; ++e) *(LAS u32x2*)(ST + (16 * e + fr) * LQ + 16 * w + 4 * fq) = (u32x2){0u, 0u};
        asm volatile("s_waitcnt lgkmcnt(0)" ::: "memory");
        for (int ci = 0; ci < TB / 64; ++ci) {
            asm volatile("s_waitcnt vmcnt(12)" ::: "memory");
            __builtin_amdgcn_s_barrier();
            asm volatile("" ::: "memory");
            issue(ci + 3);
            const LAS unsigned char* slot = ring + (ci & 3) * SLOT;
            { f32x4 acc = {0.f, 0.f, 0.f, 0.f};
              const LAS bf16* sp = ST + (size_t)(16 * vt + fr) * LQ + 8 * fq; const int rt = 16 * nt + fr; const LAS unsigned char* qr = slot + 16384 + rt * 256;
#pragma unroll
              for (int ks = 0; ks < 4; ++ks) acc = __builtin_amdgcn_mfma_f32_16x16x32_bf16(*(const LAS bf16x8*)(sp + 32 * ks), *(const LAS bf16x8*)(qr + (((fq + 4 * ks) ^ (rt & 7)) * 16)), acc, 0, 0, 0);
              u32x2 o; o.x = pk2(acc[0], acc[1]); o.y = pk2(acc[2], acc[3]);
              *(u32x2*)(oc + (rowb + chunk_tok(d, ci, rt)) * MIXA + h * 256 + vs * 32 + 16 * vt + 4 * fq) = o; }
            { const int g = lane >> 4, q = (lane & 15) >> 2, pq = lane & 3;
              const LAS unsigned char* kb = slot + (8 * g + q) * 256 + (pq & 1) * 8; const int pc = 2 * w + (pq >> 1);
              const unsigned ka0 = (unsigned)(size_t)(kb + ((pc ^ q) * 16)), ka1 = (unsigned)(size_t)(kb + 4 * 256 + ((pc ^ (q + 4)) * 16));
              u32x2 r0, r1, r2, r3;
              asm volatile("ds_read_b64_tr_b16 %0, %4\n\tds_read_b64_tr_b16 %1, %5\n\tds_read_b64_tr_b16 %2, %4 offset:8192\n\tds_read_b64_tr_b16 %3, %5 offset:8192\n\ts_waitcnt lgkmcnt(0)\n\ts_nop 1"
                           : "=&v"(r0), "=&v"(r1), "=&v"(r2), "=&v"(r3) : "v"(ka0), "v"(ka1) : "memory");
              const u32x4 k0w = {r0.x, r0.y, r1.x, r1.y}, k1w = {r2.x, r2.y, r3.x, r3.y};
              const bf16x8 kf0 = __builtin_bit_cast(bf16x8, k0w), kf1 = __builtin_bit_cast(bf16x8, k1w);
              bf16x8 f[2][2]; tr_frags64x2<32>((const LAS bf16*)(slot + 32768), 0, (const LAS bf16*)(slot + 32768), 16, lane, f);
              const f32x4 dl = *(const LAS f32x4*)(slot + 36864 + (16 * w + 4 * fq) * 4);
#pragma unroll
              for (int e = 0; e < 2; ++e) {
                  S[e] = __builtin_amdgcn_mfma_f32_16x16x32_bf16(kf0, f[e][0], S[e], 0, 0, 0);
                  S[e] = __builtin_amdgcn_mfma_f32_16x16x32_bf16(kf1, f[e][1], S[e], 0, 0, 0);
                  S[e] = S[e] * dl; } }
            asm volatile("s_waitcnt lgkmcnt(0)" ::: "memory");
            __builtin_amdgcn_s_barrier();
            asm volatile("" ::: "memory");
#pragma unroll
            for (int e = 0; e < 2; ++e) { u32x2 pw; pw.x = pk2(S[e][0], S[e][1]); pw.y = pk2(S[e][2], S[e][3]);
                *(LAS u32x2*)(ST + (16 * e + fr) * LQ + 16 * w + 4 * fq) = pw; }
            asm volatile("s_waitcnt lgkmcnt(0)" ::: "memory");
        }
        asm volatile("s_waitcnt vmcnt(0)" ::: "memory");
        __builtin_amdgcn_s_barrier();
        asm volatile("" ::: "memory");
    }
}

__device__ __forceinline__ void ret_intra_phase(const Fr& F, const bf16* Z, bf16* OI) {
    constexpr int LQ = 256 + 24, LV = 512 + 8, LT = 72;
    LAS bf16* QI = (LAS bf16*)F.lds; LAS bf16* KI = QI + 64 * LQ; LAS bf16* VI = KI + 64 * LQ; LAS bf16* ATT = VI + 64 * LV;
    const int tid = F.tid, lane = F.lane, w = F.wave;
    u32x4 pq[4], pk[4], pv[8];
    auto fetch = [&](int item) { const int uc = 4 + (item & 63), h = (item >> 6) & 7, b = item >> 9; const size_t row0 = (size_t)b * TB + uc * 64;
#pragma unroll
        for (int it = 0; it < 4; ++it) { const int idx = tid + it * NTHR; const int p = idx >> 5, kc = (idx & 31) * 8; const bf16* zr = Z + (row0 + p) * RETC + h * 256 + kc;
            pq[it] = *(const u32x4*)(zr); pk[it] = *(const u32x4*)(zr + D); }
#pragma unroll
        for (int it = 0; it < 8; ++it) { const int idx = tid + it * NTHR; const int p = idx >> 6, vc = (idx & 63) * 8;
            pv[it] = *(const u32x4*)(Z + (row0 + p) * RETC + 2 * D + h * 512 + vc); } };
    if (F.vcu < NB * 8 * 64) fetch(F.vcu);
    for (int item = F.vcu; item < NB * 8 * 64; item += F.G) {
        const int uc = 4 + (item & 63), h = (item >> 6) & 7, b = item >> 9;
        const size_t row0 = (size_t)b * TB + uc * 64;
        const float l2g = log1pf(-exp2f(-5.0f - (float)h)) * 1.4426950408889634f;
#pragma unroll
        for (int it = 0; it < 4; ++it) { const int idx = tid + it * NTHR; const int p = idx >> 5, kc = (idx & 31) * 8;
            *(LAS u32x4*)(QI + p * LQ + kc) = pq[it]; *(LAS u32x4*)(KI + p * LQ + kc) = pk[it]; }
#pragma unroll
        for (int it = 0; it < 8; ++it) { const int idx = tid + it * NTHR; const int p = idx >> 6, vc = (idx & 63) * 8;
            *(LAS u32x4*)(VI + p * LV + vc) = pv[it]; }
        __syncthreads();
        if (item + F.G < NB * 8 * 64) fetch(item + F.G);
        { const int mt = w >> 1;
#pragma unroll
          for (int e = 0; e < 2; ++e) { const int nt = (w & 1) * 2 + e; f32x4 acc = {0.f, 0.f, 0.f, 0.f};
              mma16<8>(acc, QI, LQ, 16 * mt, KI, LQ, 16 * nt, lane);
#pragma unroll
              for (int r = 0; r < 4; ++r) { const int i = 16 * mt + 4 * (lane >> 4) + r, j = 16 * nt + (lane & 15); const int dd = i > j ? i - j : j - i;
                  ATT[i * LT + j] = f2bf(acc[r] * (dd == 0 ? 2.0f : __builtin_amdgcn_exp2f((float)dd * l2g))); } } }
        __syncthreads();
        {
            bf16x8 af[4][2];
#pragma unroll
            for (int mt = 0; mt < 4; ++mt) { const LAS bf16* ap = ATT + (size_t)(16 * mt + (lane & 15)) * LT + 8 * (lane >> 4); af[mt][0] = *(const LAS bf16x8*)ap; af[mt][1] = *(const LAS bf16x8*)(ap + 32); }
#pragma unroll
            for (int vt = 0; vt < 4; ++vt) { bf16x8 vf0, vf1; tr_frags64<LV>(VI, 64 * w + 16 * vt, lane, vf0, vf1);
#pragma unroll
                for (int mt = 0; mt < 4; ++mt) { f32x4 acc = {0.f, 0.f, 0.f, 0.f};
                    acc = __builtin_amdgcn_mfma_f32_16x16x32_bf16(vf0, af[mt][0], acc, 0, 0, 0);
                    acc = __builtin_amdgcn_mfma_f32_16x16x32_bf16(vf1, af[mt][1], acc, 0, 0, 0);
                    u32x2 o; o.x = pk2(acc[0], acc[1]); o.y = pk2(acc[2], acc[3]);
                    *(u32x2*)(OI + (row0 + 16 * mt + (lane & 15)) * 4096 + h * 512 + 64 * w + 16 * vt + 4 * (lane >> 4)) = o; } }
        }
        __syncthreads();
    }
}
__device__ __forceinline__ void ret_scan_phase(const Fr& F, const bf16* Z, bf16* OUT) {
    constexpr int LQ = 256 + 24, LV = 64 + 8;
    LAS bf16* QI = (LAS bf16*)F.lds; LAS bf16* KI = QI + 64 * LQ; LAS bf16* ST = KI + 2 * 64 * LQ; LAS bf16* VI = ST + 64 * LQ;
    static_assert((4 * 64 * LQ + 2 * 64 * LV) * 2 <= LDS_BYTES - 16, "retention scan LDS map");
    const int tid = F.tid, lane = F.lane, w = F.wave;
    for (int unit = F.vcu; unit < NB * 8 * 2 * 8; unit += F.G) {
        const int vs = unit & 7, d = (unit >> 3) & 1, h = (unit >> 4) & 7, b = unit >> 7;
        const size_t rowb = (size_t)b * TB;
        bf16* out = OUT + (size_t)d * M * 4096;
        const float l2g = log1pf(-exp2f(-5.0f - (float)h)) * 1.4426950408889634f;
        const float g64 = __builtin_amdgcn_exp2f(64.0f * l2g);
        const float vsc = __builtin_amdgcn_exp2f((float)(63 - (tid >> 3)) * l2g);
        f32x4 S[2][4];
#pragma unroll
        for (int i = 0; i < 2; ++i)
#pragma unroll
            for (int j = 0; j < 4; ++j) S[i][j] = (f32x4){0.f, 0.f, 0.f, 0.f};
        struct Pre { u32x4 q[4], k[4], v; };
        Pre PA, PB;
        auto tok_of = [&](int ci, int p) { const int uc = (d == 0) ? ci : (ci < 4 ? 3 - ci : 71 - ci); return (d == 0) ? uc * 64 + p : uc * 64 + 63 - p; };
        auto prefetch = [&](int ci_, Pre& P) { const int ci = ci_ < TB / 64 ? ci_ : TB / 64 - 1;
#pragma unroll
            for (int it = 0; it < 4; ++it) { const int idx = tid + it * NTHR; const int p = idx >> 5, kc = (idx & 31) * 8; const bf16* zr = Z + (rowb + tok_of(ci, p)) * RETC + h * 256 + kc;
                P.q[it] = *(const u32x4*)(zr); P.k[it] = *(const u32x4*)(zr + D); }
            { const int p = tid >> 3, vc = (tid & 7) * 8; P.v = *(const u32x4*)(Z + (rowb + tok_of(ci, p)) * RETC + 2 * D + h * 512 + vs * 64 + vc); }
        };
        auto stage_kv = [&](int buf, const Pre& P) {
            LAS bf16* KB = KI + buf * (64 * LQ); LAS bf16* VB = VI + buf * (64 * LV);
#pragma unroll
            for (int it = 0; it < 4; ++it) { const int idx = tid + it * NTHR; const int p = idx >> 5, kc = (idx & 31) * 8; *(LAS u32x4*)(KB + p * LQ + kc) = P.k[it]; }
            { const int p = tid >> 3, vc = (tid & 7) * 8; float v8[8]; unpack8(P.v, v8);
#pragma unroll
              for (int i = 0; i < 8; ++i) v8[i] *= vsc;
              *(LAS u32x4*)(VB + p * LV + vc) = pack8(v8); } };
        auto step = [&](int ci, Pre& P, Pre& Pn) {
            const bool do_out = ci >= 4; const int buf = ci & 1;
            const LAS bf16* KB = KI + buf * (64 * LQ); const LAS bf16* VB = VI + buf * (64 * LV);
            if (do_out) {
#pragma unroll
                for (int it = 0; it < 4; ++it) { const int idx = tid + it * NTHR; const int p = idx >> 5, kc = (idx & 31) * 8; *(LAS u32x4*)(QI + p * LQ + kc) = P.q[it]; } }
#pragma unroll
            for (int ki = 0; ki < 2; ++ki)
#pragma unroll
                for (int vt = 0; vt < 4; ++vt) { u32x2 pw; pw.x = pk2(S[ki][vt][0], S[ki][vt][1]); pw.y = pk2(S[ki][vt][2], S[ki][vt][3]);
                    *(LAS u32x2*)(ST + (16 * vt + (lane & 15)) * LQ + 16 * (2 * w + ki) + 4 * (lane >> 4)) = pw; }
            __syncthreads();
            prefetch(ci + 2, P);
            __builtin_amdgcn_s_waitcnt(0xF79);
            stage_kv(buf ^ 1, Pn);
            if (do_out) {
                const int vt = w >> 1;
#pragma unroll
                for (int e = 0; e < 2; ++e) { const int nt = 2 * (w & 1) + e; f32x4 acc = {0.f, 0.f, 0.f, 0.f};
                    mma16<8>(acc, ST, LQ, 16 * vt, QI, LQ, 16 * nt, lane);
                    const int p = 16 * nt + (lane & 15); const float sc = __builtin_amdgcn_exp2f((float)(p + 1) * l2g);
                    u32x2 o; o.x = pk2(acc[0] * sc, acc[1] * sc); o.y = pk2(acc[2] * sc, acc[3] * sc);
                    *(u32x2*)(out + (rowb + tok_of(ci, p)) * 4096 + h * 512 + vs * 64 + 16 * vt + 4 * (lane >> 4)) = o; }
            }
            {
                bf16x8 vf[4][2]; tr_frags64x4<LV>(VB, 0, VB, 16, VB, 32, VB, 48, lane, vf);
                bf16x8 kf[2][2]; tr_frags64x2<LQ>(KB, 16 * (2 * w), KB, 16 * (2 * w + 1), lane, kf);
#pragma unroll
                for (int ki = 0; ki < 2; ++ki) {
#pragma unroll
                    for (int vt = 0; vt < 4; ++vt) {
#pragma unroll
                        for (int r = 0; r < 4; ++r) S[ki][vt][r] *= g64;
                        S[ki][vt] = __builtin_amdgcn_mfma_f32_16x16x32_bf16(kf[ki][0], vf[vt][0], S[ki][vt], 0, 0, 0);
                        S[ki][vt] = __builtin_amdgcn_mfma_f32_16x16x32_bf16(kf[ki][1], vf[vt][1], S[ki][vt], 0, 0, 0); } }
            }
            __syncthreads();
        };
        prefetch(0, PA); prefetch(1, PB);
        __builtin_amdgcn_s_waitcnt(0xF79);
        stage_kv(0, PA);
        static_assert((TB / 64) % 2 == 0, "the chunk loop is unrolled by two");
#pragma unroll 1
        for (int ci = 0; ci < TB / 64; ci += 2) { step(ci, PA, PB); step(ci + 1, PB, PA); }
        __builtin_amdgcn_s_waitcnt(0xF70);
    }
}

__device__ __forceinline__ void finish0_phase(const Fr& F, const Args& a) {
    unsigned char* ws = a.ws;
    const bf16* Z = (const bf16*)(ws + WS_ZR);
    const bf16* R = (const bf16*)(ws + WS_MIX + MX_R); const bf16* V = (const bf16*)(ws + WS_MIX + MX_V); const bf16* Km = (const bf16*)(ws + WS_MIX + MX_K); const bf16* Gg = (const bf16*)(ws + WS_MIX + MX_G);
    const bf16* YA = (const bf16*)(ws + WS_MIX + MX_YA); const bf16* YB = (const bf16*)(ws + WS_MIX + MX_YB); const bf16* OC2 = (const bf16*)(ws + WS_MIX + MX_DEC);
    bf16* A2 = (bf16*)a.out;
    const float* rk = a.in[I_RK]; const float* lnw = a.in[I_LNW]; const float* lnb = a.in[I_LNB]; const float* glag = a.in[I_GLAG];
    const int gw = F.vcu * NWAVES + F.wave, NGW = F.G * NWAVES, lane = F.lane;
    for (int m = gw; m < M; m += NGW) {
        const size_t ro = (size_t)m * MIXA + 16 * lane;
        const Raw16 qy0 = ld16raw(YA + ro, true), qy1 = ld16raw(YA + (size_t)M * MIXA + ro, true), qr = ld16raw(R + ro, true), qk = ld16raw(Km + ro, true), qv = ld16raw(V + ro, true), qg = ld16raw(Gg + ro, true);
        const Raw16 pb0 = ld16raw(YB + ro, true), pb1 = ld16raw(YB + (size_t)M * MIXA + ro, true), pgt = ld16raw(Z + (size_t)m * ZLD0 + GR + 16 * lane, true), pc0 = ld16raw(OC2 + ro, true), pc1 = ld16raw(OC2 + (size_t)M * MIXA + ro, true);
        {
            float y0[16], y1[16], y[16], r[16], k[16], v[16], g[16], o[16];
            unpack16(qy0, y0); unpack16(qy1, y1); unpack16(qr, r); unpack16(qk, k); unpack16(qv, v); unpack16(qg, g);
            float s = 0.f, bs = 0.f;
#pragma unroll
            for (int q = 0; q < 4; ++q) { const f32x4 rkv = *(const f32x4*)(rk + 16 * lane + 4 * q);
#pragma unroll
                for (int i = 0; i < 4; ++i) { const int e = 4 * q + i; y[e] = y0[e] + y1[e]; s += y[e]; bs += r[e] * k[e] * rkv[i]; } }
            s = quad_sum(s); bs = quad_sum(bs);
            const float mean = s * (1.0f / 64.0f); float q2 = 0.f;
#pragma unroll
            for (int e = 0; e < 16; ++e) { const float dd = y[e] - mean; q2 += dd * dd; }
            q2 = quad_sum(q2);
            const float rstd = rsqrtf(q2 * (1.0f / 64.0f) + GN_EPS);
#pragma unroll
            for (int q = 0; q < 4; ++q) { const f32x4 lw = *(const f32x4*)(lnw + 16 * lane + 4 * q), lb = *(const f32x4*)(lnb + 16 * lane + 4 * q);
#pragma unroll
                for (int i = 0; i < 4; ++i) { const int e = 4 * q + i; o[e] = ((y[e] - mean) * rstd * lw[i] + lb[i] + bs * v[e]) * g[e]; } }
            store16(A2 + (size_t)m * D + 16 * lane, o);
        }
        {
            float y0[16], y1[16], y[16], gt[16], o[16];
            unpack16(pb0, y0); unpack16(pb1, y1); unpack16(pgt, gt);
            float c0[16], c1[16]; unpack16(pc0, c0); unpack16(pc1, c1);
            float s = 0.f;
#pragma unroll
            for (int e = 0; e < 16; ++e) { y[e] = (y0[e] + y1[e]) + (c0[e] + c1[e]); s += y[e] * y[e]; }
            s = row16_sum(s);
            const float rstd = rsqrtf(s * (1.0f / 256.0f) + RMS_EPS);
#pragma unroll
            for (int q = 0; q < 4; ++q) { const f32x4 gg = *(const f32x4*)(glag + ((16 * lane) & 255) + 4 * q);
#pragma unroll
                for (int i = 0; i < 4; ++i) { const int e = 4 * q + i; o[e] = y[e] * rstd * gg[i] * fsilu(gt[e]); } }
            store16(A2 + (size_t)m * D + MIXA + 16 * lane, o);
        }
    }
}
__device__ __forceinline__ void finish1_phase(const Fr& F, const Args& a) {
    unsigned char* ws = a.ws;
    const bf16* Z = (const bf16*)(ws + WS_ZR); const bf16* OC = (const bf16*)(ws + WS_MIX + MX_OC); bf16* A3 = (bf16*)(ws + WS_MIX + MX_A3);
    const int gw = F.vcu * NWAVES + F.wave, NGW = F.G * NWAVES, lane = F.lane;
    for (int m = gw; m < M; m += NGW) {
        if ((m % TB) < CTX) continue;
#pragma unroll
        for (int hb = 0; hb < 2; ++hb) {
            u32x4 q0[4], q1[4], q2[4], qg[4];
#pragma unroll
            for (int j = 0; j < 4; ++j) { const int h = 4 * hb + j; const size_t off = (size_t)m * 4096 + h * 512 + 8 * lane;
                q0[j] = *(const u32x4*)(OC + off); q1[j] = *(const u32x4*)(OC + (size_t)M * 4096 + off); q2[j] = *(const u32x4*)(A3 + off);
                qg[j] = *(const u32x4*)(Z + (size_t)m * RETC + 8192 + h * 512 + 8 * lane); }
#pragma unroll
            for (int j = 0; j < 4; ++j) { const int h = 4 * hb + j; const size_t off = (size_t)m * 4096 + h * 512 + 8 * lane;
                float o0[8], o1[8], o2[8], g[8], o[8];
                unpack8(q0[j], o0); unpack8(q1[j], o1); unpack8(q2[j], o2); unpack8(qg[j], g);
                float s = 0.f;
#pragma unroll
                for (int e = 0; e < 8; ++e) { o[e] = (o0[e] + o1[e]) + o2[e]; s += o[e] * o[e]; }
                const float rstd = rsqrtf(wave_sum(s) * (1.0f / 512.0f) + RMS_EPS);
#pragma unroll
                for (int e = 0; e < 8; ++e) o[e] = o[e] * rstd * fsilu(g[e]);
                *(u32x4*)(A3 + off) = pack8(o); }
        }
    }
}

constexpr int N_PHASES = 23;
__global__ void __launch_bounds__(NTHR, 2) mega(Args a) {
    extern __shared__ __attribute__((aligned(16))) unsigned char lds_raw[];
    Fr F; F.lds = (LAS unsigned char*)lds_raw; F.tid = threadIdx.x; F.lane = F.tid & 63; F.wave = __builtin_amdgcn_readfirstlane(F.tid >> 6);
    F.G = gridDim.x; { const int bx = blockIdx.x; F.vcu = (F.G % 8 == 0) ? (bx % 8) * (F.G / 8) + bx / 8 : bx; }
    const int wave0 = F.wave;
#define REFRAME() do { const int _l = lane_id_opaque(); int _w = wave0; asm volatile("" : "+s"(_w)); F.lane = _l; F.wave = _w; F.tid = _w * 64 + _l; } while (0)
    unsigned char* ws = a.ws;
    const int lo = a.ph_lo, hi = a.ph_hi;
#if MK_ONE_LAUNCH
    volatile LAS unsigned* bst = (volatile LAS unsigned*)(F.lds + LDS_BYTES - 16);
    if (F.tid < 4) bst[F.tid] = 0u;
    __syncthreads();
    XcdBarrier bar = xcd_barrier_post((unsigned*)(ws + WS_CTL) + 4096, bst);
#define GRID_BAR() xcd_barrier(bar)
#else
#define GRID_BAR() do { } while (0)
#endif
#define IN(k) (lo <= (k) && (k) < hi)
#if MK_ONE_LAUNCH
#define SEAM(k) do { if (IN(k) && IN((k) + 1)) { GRID_BAR(); } } while (0)
#else
#define SEAM(k) do { } while (0)
#endif
    const float* modv = (const float*)(ws + WS_MODV);
    const float* ng = a.in[I_NG];
    bf16* ABF = (bf16*)a.out;
    const int bx = blockIdx.x;

    if (IN(0)) { REFRAME(); p0_prologue(F, a); } SEAM(0);
    if (IN(1)) { REFRAME(); rows_phase(F, a, 0, 0, true, nullptr, nullptr, false, ng + 0 * D, modv + 0 * D, modv + 1 * D); } SEAM(1);
    if (IN(2)) { REFRAME(); pg8::Gemm g{ABF, (const bf16*)(ws + WS_WAB), D, D, D}; pg8::StaticOrder S; S.init(M / 256, ZLD0 / 256, F.G, bx, 0, D / 64);
        pg8::EpiBf16 E{(bf16*)(ws + WS_ZR), ZLD0, 0}; pg8::gemm_phase(F.lds, g, S, E, F.tid);
        REFRAME(); __syncthreads(); conv_dyn(F, a, (unsigned*)(ws + WS_CTL) + 2048, 1, 3); } SEAM(2);
    if (IN(3)) { REFRAME(); prep_phase(F, a); } SEAM(3);
    if (IN(4)) { REFRAME();
        pg8::Gemm g{(const bf16*)(ws + WS_MIX + MX_ALO), (const bf16*)(ws + WS_WLO), 512, 512, 256};
        { pg8::StaticOrder S; S.init(M / 256, 8, F.G, bx, 0, 4, 0, 0); pg8::EpiDec E{(float*)(ws + WS_MIX + MX_DEC), a.in[I_W0]}; pg8::gemm_phase(F.lds, g, S, E, F.tid); }
        REFRAME();
        { pg8::StaticOrder S; S.init(M / 256, 4, F.G, (bx + 16) % F.G, 0, 4, 8, 0);
          pg8::EpiLr E{(bf16*)(ws + WS_MIX + MX_K), (const bf16*)(ws + WS_MIX + MX_KK), (bf16*)(ws + WS_MIX + MX_BV), a.in[I_A0], a.in[I_KA]}; pg8::gemm_phase(F.lds, g, S, E, F.tid); }
        REFRAME();
        { pg8::StaticOrder S; S.init(M / 256, 4, F.G, (bx + 16 + 136) % F.G, 0, 4, 12, 256); pg8::EpiBf16 E{(bf16*)(ws + WS_MIX + MX_G), MIXA, 12 * 256}; pg8::gemm_phase(F.lds, g, S, E, F.tid); }
    } SEAM(4);
    if (IN(5)) { REFRAME();
        if (F.vcu < 208) rwkv_pre_phase(F, a, F.vcu, 208);
        else gla_pre_phase(F, a, F.vcu - 208, F.G - 208);
    } SEAM(5);
    if (IN(6)) { REFRAME();
        if (F.vcu < 64) rwkv_seq_phase(F, a, F.vcu, 64);
        else if (F.vcu < 192) gla_seq_phase(F, a, F.vcu - 64, 128);
        REFRAME(); __syncthreads();
        conv_dyn(F, a, (unsigned*)(ws + WS_CTL) + 2112, 4, 5);
    } SEAM(6);
    if (IN(9)) { REFRAME(); finish0_phase(F, a); } SEAM(9);
    if (IN(10)) { REFRAME(); pg8::Gemm g{ABF, (const bf16*)(ws + WS_WO0), D, D, D}; pg8::StaticOrder S; S.init(32, D / 256, F.G, bx, 3, D / 64, 0, 0, 8);
        pg8::EpiF32 E{(bf16*)(ws + WS_MIX + MX_Y), D, (float*)(ws + WS_YC)}; pg8::gemm_phase(F.lds, g, S, E, F.tid); } SEAM(10);
    if (IN(11)) { REFRAME(); rows_phase(F, a, 1, 8, true, ng + 1 * D, modv + 2 * D, false, ng + 2 * D, modv + 3 * D, modv + 4 * D); } SEAM(11);
    if (IN(12)) { REFRAME(); pg8::Gemm g{ABF, (const bf16*)(ws + WS_WFI0), D, D, D}; pg8::StaticOrder S; S.init(M / 256, 2 * DFF / 256, F.G, bx, 0, D / 64);
        pg8::EpiSwiglu E{(bf16*)(ws + WS_ZR), DFF}; pg8::gemm_phase(F.lds, g, S, E, F.tid);
        REFRAME(); __syncthreads(); conv_dyn(F, a, (unsigned*)(ws + WS_CTL) + 2304, 3, 4); } SEAM(12);
    if (IN(13)) { REFRAME(); pg8::Gemm g{(const bf16*)(ws + WS_ZR), (const bf16*)(ws + WS_WFO0), DFF, DFF, DFF}; pg8::StaticOrder S; S.init(32, D / 256, F.G, bx, 3, DFF / 64, 0, 0, 11);
        pg8::EpiF32 E{(bf16*)(ws + WS_MIX + MX_Y), D, (float*)(ws + WS_YC)}; pg8::gemm_phase(F.lds, g, S, E, F.tid);
        REFRAME(); __syncthreads(); conv_dyn(F, a, (unsigned*)(ws + WS_CTL) + 2432, 5, 6); } SEAM(13);
    if (IN(14)) { REFRAME(); rows_phase(F, a, 1, 11, false, ng + 3 * D, modv + 5 * D, false, ng + 4 * D, modv + 3 * 12288 + 0 * D, modv + 3 * 12288 + 1 * D); } SEAM(14);
    if (IN(15)) { REFRAME(); pg8::Gemm g{ABF, (const bf16*)(ws + WS_WRI), D, D, D}; pg8::StaticOrder S; S.init(M / 256, RETC / 256, F.G, bx, 0, D / 64);
        pg8::EpiRet E{(bf16*)(ws + WS_ZR), RETC, (const float*)(ws + WS_ROT)}; pg8::gemm_phase(F.lds, g, S, E, F.tid);
        REFRAME(); __syncthreads(); conv_dyn(F, a, (unsigned*)(ws + WS_CTL) + 2176, 6, 7); } SEAM(15);
    if (IN(16)) { REFRAME();
        ret_intra_phase(F, (const bf16*)(ws + WS_ZR), (bf16*)(ws + WS_MIX + MX_A3));
        REFRAME(); __syncthreads();
        ret_scan_phase(F, (const bf16*)(ws + WS_ZR), (bf16*)(ws + WS_MIX + MX_OC)); } SEAM(16);
    if (IN(17)) { REFRAME(); finish1_phase(F, a); } SEAM(17);
    const bool fuse_rows = (F.G == 256) && MK_ONE_LAUNCH;
    unsigned* xcnt = (unsigned*)(ws + WS_CTL + 65536); float* xslot = (float*)(ws + WS_CTL + 131072); unsigned* xtmo = (unsigned*)(ws + WS_CTL) + 4096 + XB_TMO;
    if (IN(18)) { REFRAME(); pg8::Gemm g{(const bf16*)(ws + WS_MIX + MX_A3), (const bf16*)(ws + WS_WRO), 2 * D, 2 * D, 2 * D}; pg8::StaticOrder S; S.init(32, D / 256, F.G, bx, 1, 2 * D / 64);
        if (fuse_rows) {
            pg8::NormX x1{xslot, xcnt, xtmo}, x2{xslot + 34 * 256 * 8, xcnt + 34 * 64, xtmo};
            pg8::EpiNorm E{(bf16*)(ws + WS_H), ABF, nullptr, modv + 3 * 12288 + 2 * D, ng + 5 * D, ng + 6 * D, modv + 3 * 12288 + 3 * D, modv + 3 * 12288 + 4 * D, false, x1, x2};
            pg8::gemm_phase(F.lds, g, S, E, F.tid);
        } else { pg8::EpiF32 E{(bf16*)(ws + WS_MIX + MX_Y), D, (float*)(ws + WS_YC)}; pg8::gemm_phase(F.lds, g, S, E, F.tid); } } SEAM(18);
    if (!fuse_rows) { if (IN(19)) { REFRAME(); rows_phase(F, a, 1, 0, false, ng + 5 * D, modv + 3 * 12288 + 2 * D, false, ng + 6 * D, modv + 3 * 12288 + 3 * D, modv + 3 * 12288 + 4 * D); } SEAM(19); }
    if (IN(20)) { REFRAME(); pg8::Gemm g{ABF, (const bf16*)(ws + WS_WFI1), D, D, D}; pg8::StaticOrder S; S.init(32, 2 * DFF / 256, F.G, bx, 1, D / 64);
        pg8::EpiSwiglu E{(bf16*)(ws + WS_ZR), DFF}; pg8::gemm_phase(F.lds, g, S, E, F.tid);
        REFRAME(); __syncthreads(); conv_dyn(F, a, (unsigned*)(ws + WS_CTL) + 2240, 7, 8); } SEAM(20);
    if (IN(21)) { REFRAME(); pg8::Gemm g{(const bf16*)(ws + WS_ZR), (const bf16*)(ws + WS_WFO1), DFF, DFF, DFF}; pg8::StaticOrder S; S.init(32, D / 256, F.G, bx, 1, DFF / 64);
        if (fuse_rows) {
            pg8::NormX x1{xslot + 2 * 34 * 256 * 8, xcnt + 2 * 34 * 64, xtmo};
            pg8::EpiNorm E{(bf16*)(ws + WS_H), nullptr, a.out, modv + 3 * 12288 + 5 * D, ng + 7 * D, nullptr, nullptr, nullptr, true, x1, x1};
            pg8::gemm_phase(F.lds, g, S, E, F.tid);
        } else { pg8::EpiF32 E{(bf16*)(ws + WS_MIX + MX_Y), D, (float*)(ws + WS_YC)}; pg8::gemm_phase(F.lds, g, S, E, F.tid); } }
    if (!fuse_rows) { SEAM(21);
    if (IN(22)) { REFRAME(); rows_phase(F, a, 1, 0, false, ng + 7 * D, modv + 3 * 12288 + 5 * D, true, nullptr, nullptr, nullptr); } }
#undef IN
#undef SEAM
}


extern "C" void kernel_launch(void* const* d_in, const int* in_sizes, int n_in, void* d_out, int out_size, void* d_ws, size_t ws_size, hipStream_t stream) {
    static int grid = 0;
    if (grid == 0) {
        if (n_in != 27 || ws_size < WS_END) { fprintf(stderr, "kernel_launch: unexpected n_in %d or ws_size %zu (need %zu)\n", n_in, ws_size, (size_t)WS_END); grid = -1; return; }
        int dev = 0, cus = 0, per_cu = 0;
        (void)hipGetDevice(&dev); (void)hipDeviceGetAttribute(&cus, hipDeviceAttributeMultiprocessorCount, dev);
        if (hipFuncSetAttribute((const void*)mega, hipFuncAttributeMaxDynamicSharedMemorySize, LDS_BYTES) != hipSuccess) { fprintf(stderr, "kernel_launch: hipFuncSetAttribute failed\n"); grid = -1; return; }
        if (hipOccupancyMaxActiveBlocksPerMultiprocessor(&per_cu, (const void*)mega, NTHR, LDS_BYTES) != hipSuccess || per_cu < 1) { fprintf(stderr, "kernel_launch: occupancy query says %d\n", per_cu); per_cu = 1; }
        (void)hipGetLastError();
        grid = cus;
    }
    if (grid < 0) return;
    Args a{};
    for (int i = 0; i < 27; ++i) a.in[i] = (const float*)d_in[i];
    a.out = (float*)d_out; a.ws = (unsigned char*)d_ws;
#if MK_ONE_LAUNCH
    (void)hipMemsetAsync((char*)d_ws + WS_CTL, 0, 128 * 1024, stream);
    a.ph_lo = 0; a.ph_hi = N_PHASES;
    void* args[] = {&a};
    hipError_t e = hipLaunchCooperativeKernel((const void*)mega, dim3(grid), dim3(NTHR), args, LDS_BYTES, stream);
    if (e != hipSuccess) fprintf(stderr, "cooperative launch failed: %s (grid %d)\n", hipGetErrorString(e), grid);
#else
    for (int p = 0; p < N_PHASES; ++p) {
        a.ph_lo = p; a.ph_hi = p + 1;
        hipLaunchKernelGGL(mega, dim3(grid), dim3(NTHR), LDS_BYTES, stream, a);
    }
#endif
}
```

```cpp
#include <hip/hip_runtime.h>
#include <hip/hip_cooperative_groups.h>
#include <cstdio>
#include <cstdint>
namespace cg = cooperative_groups;

#ifndef MK_ONE_LAUNCH
#define MK_ONE_LAUNCH 1
#endif

#define LAS __attribute__((address_space(3)))
typedef unsigned short bf16;
typedef short bf16x8 __attribute__((ext_vector_type(8)));
typedef float f32x4 __attribute__((ext_vector_type(4)));
typedef float f32x2 __attribute__((ext_vector_type(2)));
typedef unsigned u32x4 __attribute__((ext_vector_type(4)));
typedef unsigned u32x2 __attribute__((ext_vector_type(2)));

constexpr int D = 2048, NB = 2, SEQ = 4096, CTX = 256, TB = CTX + SEQ  , M = NB * TB  ;
constexpr int DFF = 5632, MIXA = 1024, ACOLS = 3520, ABCOLS = 6608, ZLD0 = 6656, RETC = 12288;
constexpr int GQ = 3520, GK = 4032, GV = 4544, GR = 5568, GGD = 6592;
constexpr float RMS_EPS = 1e-6f, GN_EPS = 64e-5f;
constexpr int NWAVES = 8, NTHR = 512;
constexpr int LDS_BYTES = 160 * 1024;

constexpr size_t MiB = 1u << 20;
constexpr size_t SZ_WAB = (size_t)ZLD0 * D * 2, SZ_WO0 = (size_t)D * D * 2, SZ_WFI = (size_t)2 * DFF * D * 2, SZ_WFO = (size_t)D * DFF * 2,
                 SZ_WRI = (size_t)RETC * D * 2, SZ_WRO = (size_t)D * 2 * D * 2, SZ_WLO = (size_t)4096 * 512 * 2;
constexpr size_t WS_CTL = 0;
constexpr size_t WS_WAB = 1 * MiB;
constexpr size_t WS_WO0 = WS_WAB + SZ_WAB;
constexpr size_t WS_WFI0 = WS_WO0 + SZ_WO0;
constexpr size_t WS_WFI1 = WS_WFI0 + SZ_WFI;
constexpr size_t WS_WFO0 = WS_WFI1 + SZ_WFI;
constexpr size_t WS_WFO1 = WS_WFO0 + SZ_WFO;
constexpr size_t WS_WRI = WS_WFO1 + SZ_WFO;
constexpr size_t WS_WRO = WS_WRI + SZ_WRI;
constexpr size_t WS_WLO = WS_WRO + SZ_WRO;
constexpr size_t WS_MODV = WS_WLO + SZ_WLO;
constexpr size_t WS_ROT = WS_MODV + 512 * 1024;
constexpr size_t WS_H = WS_ROT + 512 * 1024;
constexpr size_t SZ_H = (size_t)M * D * 4;
constexpr size_t WS_ZR = WS_H + SZ_H;
constexpr size_t SZ_ZR = (size_t)M * RETC * 2;
constexpr size_t RW_ITEMS = (size_t)NB * 16 * (TB / 64);
constexpr size_t WS_RWG = WS_ZR + (size_t)M * ZLD0 * 2;
constexpr size_t WS_RWP = WS_RWG + RW_ITEMS * 8192;
constexpr size_t WS_RWY = WS_RWP + RW_ITEMS * 8192;
constexpr size_t WS_RWQ = WS_RWY + RW_ITEMS * 8192;
constexpr size_t GLA_ITEMS = (size_t)NB * 4 * 2 * (TB / 64);
constexpr size_t WS_GKI = WS_RWQ + RW_ITEMS * 8192;
constexpr size_t WS_GDL = WS_GKI + GLA_ITEMS * 16384;
constexpr size_t DO_GQI = (size_t)M * D * 2;
static_assert(WS_GDL + GLA_ITEMS * 512 <= WS_ZR + SZ_ZR, "RWKV chunk operators (direction 0) + GLA k_in must fit in the tail of the Z region");
static_assert(DO_GQI + GLA_ITEMS * 16384 <= (size_t)NB * SEQ * D * 4, "GLA q_in must fit in d_out behind ABF");
static_assert(RW_ITEMS * 8192 * 4 <= SZ_H, "RWKV chunk operators (direction 1) live in the residual-stream buffer H, which is first written after the mixer");
constexpr size_t WS_MIX = WS_ZR + SZ_ZR;
constexpr size_t SZ_T = (size_t)M * MIXA * 2;
constexpr size_t MX_Y = 0;
constexpr size_t MX_R = 0, MX_V = SZ_T, MX_K = 2 * SZ_T, MX_KK = 3 * SZ_T, MX_BV = 4 * SZ_T, MX_G = 5 * SZ_T;
constexpr size_t MX_DEC = 6 * SZ_T;
constexpr size_t MX_ALO = MX_DEC + 4 * SZ_T;
constexpr size_t MX_YA = MX_ALO + SZ_T / 2;
constexpr size_t MX_YB = MX_YA + 2 * SZ_T;
constexpr size_t SZ_MIX0 = MX_YB + 2 * SZ_T;
constexpr size_t MX_YC = 80 * MiB;
constexpr size_t WS_YC = WS_MIX + MX_YC;
static_assert(MX_YC >= (size_t)M * D * 4 && MX_YC + (size_t)11 * NB * CTX * D * 4 <= SZ_MIX0, "split-K slabs inside the mixer scratch, above Y");
constexpr size_t MX_OC = 0;
constexpr size_t MX_A3 = (size_t)2 * M * 4096 * 2;
constexpr size_t SZ_MIX1 = MX_A3 + (size_t)M * 4096 * 2;
constexpr size_t SZ_MIX = SZ_MIX0 > SZ_MIX1 ? SZ_MIX0 : SZ_MIX1;
constexpr size_t WS_END = WS_MIX + SZ_MIX;
static_assert(WS_END <= (size_t)768 * MiB, "workspace map exceeds 768 MiB");
static_assert((size_t)M * D * 2 <= (size_t)NB * SEQ * D * 4, "ABF must fit in d_out");

__device__ __forceinline__ float bf2f(unsigned v) { return __uint_as_float(v << 16); }
__device__ __forceinline__ float bflo(unsigned w) { return __uint_as_float(w << 16); }
__device__ __forceinline__ float bfhi(unsigned w) { return __uint_as_float(w & 0xffff0000u); }
typedef __bf16 bf16x2_t __attribute__((ext_vector_type(2)));
__device__ __forceinline__ unsigned pk2(float lo, float hi) { const f32x2 v = {lo, hi}; const bf16x2_t r = __builtin_convertvector(v, bf16x2_t); return __builtin_bit_cast(unsigned, r); }
__device__ __forceinline__ bf16 f2bf(float f) { return (bf16)(pk2(f, 0.f) & 0xffffu); }
__device__ __forceinline__ int lane_id_opaque() { int l; asm volatile("v_mbcnt_lo_u32_b32 %0, -1, 0\n\tv_mbcnt_hi_u32_b32 %0, -1, %0" : "=v"(l)); return l; }
__device__ __forceinline__ float wave_sum(float v) {
    v += __int_as_float(__builtin_amdgcn_update_dpp(0, __float_as_int(v), 0xB1, 0xF, 0xF, false));
    v += __int_as_float(__builtin_amdgcn_update_dpp(0, __float_as_int(v), 0x4E, 0xF, 0xF, false));
    v += __int_as_float(__builtin_amdgcn_update_dpp(0, __float_as_int(v), 0x141, 0xF, 0xF, false));
    v += __int_as_float(__builtin_amdgcn_update_dpp(0, __float_as_int(v), 0x140, 0xF, 0xF, false));
    const int iv = __float_as_int(v);
    return (__int_as_float(__builtin_amdgcn_readlane(iv, 0)) + __int_as_float(__builtin_amdgcn_readlane(iv, 16))) + (__int_as_float(__builtin_amdgcn_readlane(iv, 32)) + __int_as_float(__builtin_amdgcn_readlane(iv, 48)));
}
__device__ __forceinline__ float quad_sum(float v) {
    v += __int_as_float(__builtin_amdgcn_update_dpp(0, __float_as_int(v), 0xB1, 0xF, 0xF, false));
    v += __int_as_float(__builtin_amdgcn_update_dpp(0, __float_as_int(v), 0x4E, 0xF, 0xF, false));
    return v;
}
__device__ __forceinline__ float row16_sum(float v) {
    v = quad_sum(v);
    v += __int_as_float(__builtin_amdgcn_update_dpp(0, __float_as_int(v), 0x141, 0xF, 0xF, false));
    v += __int_as_float(__builtin_amdgcn_update_dpp(0, __float_as_int(v), 0x140, 0xF, 0xF, false));
    return v;
}
__device__ __forceinline__ float fexp(float x) { return __builtin_amdgcn_exp2f(x * 1.4426950408889634f); }
__device__ __forceinline__ float flog(float x) { return __builtin_amdgcn_logf(x) * 0.6931471805599453f; }
__device__ __forceinline__ float fsigmoid(float x) { return __builtin_amdgcn_rcpf(1.0f + fexp(-x)); }
__device__ __forceinline__ float fsilu(float x) { return x * __builtin_amdgcn_rcpf(1.0f + fexp(-x)); }
__device__ __forceinline__ float flogsigmoid(float x) { return -(fmaxf(-x, 0.f) + flog(1.0f + fexp(-fabsf(x)))); }
__device__ __forceinline__ void unpack8(const u32x4 w, float (&o)[8]) {
    o[0] = bflo(w.x); o[1] = bfhi(w.x); o[2] = bflo(w.y); o[3] = bfhi(w.y); o[4] = bflo(w.z); o[5] = bfhi(w.z); o[6] = bflo(w.w); o[7] = bfhi(w.w);
}
__device__ __forceinline__ u32x4 pack8(const float (&v)[8]) { u32x4 w; w.x = pk2(v[0], v[1]); w.y = pk2(v[2], v[3]); w.z = pk2(v[4], v[5]); w.w = pk2(v[6], v[7]); return w; }

namespace pg8 {
#define PG8_LAS __attribute__((address_space(3)))
typedef unsigned short bf16_t;
constexpr int BM = 256, BK = 64, HALF = 128, HTB = HALF * BK * 2, STAGE_BYTES = 8 * HTB, NXCD = 8, WGM = 4;
__host__ __device__ __forceinline__ int lds_byte(int r, int c) { const int st = (r >> 4) * 2 + (c >> 5), rr = r & 15, cc = c & 31, ob = rr * 64 + cc * 2; return st * 1024 + (ob ^ (((ob >> 9) & 1) << 5)); }
__host__ __device__ __forceinline__ void stage_rc(int b, int& R, int& C) { const int st = b / 1024, sb = b % 1024, swz = sb ^ (((sb >> 9) & 1) << 5); R = (st >> 1) * 16 + swz / 64; C = (st & 1) * 32 + (swz % 64) / 2; }
__host__ __device__ __forceinline__ int perm32(int rho) { const int n = rho >> 4, i = rho & 15; return 8 * (i >> 2) + 4 * n + (i & 3); }

struct Unit { int pm, pn, ko, nk, part; };
struct Gemm { const bf16_t* A; const bf16_t* Bt; int lda, ldb, K; };

struct StaticOrder {
    int nM, nN, nwg, G, c, mode, pn0, ko, nk, S;
    __device__ void init(int nM_, int nN_, int G_, int c_, int mode_, int nk_, int pn0_ = 0, int ko_ = 0, int S_ = 1) { nM = nM_; nN = nN_; nwg = nM * nN; G = G_; c = c_; mode = mode_; pn0 = pn0_; ko = ko_; nk = nk_; S = S_; }
    __device__ bool next(int i, Unit& u) const {
        const long L = (long)i * G + c;
        if (mode == 3 && L >= nwg) {
            const int j = (int)(L - nwg); if (j >= 16 * S) return false;
            const int tile = j / S, part = j % S;
            u.pm = (tile >> 3) ? 17 : 0; u.pn = tile & 7; u.nk = nk / S; u.ko = part * (nk / S) * 64; u.part = part + 1; return true;
        }
        if (L >= nwg) return false;
        int wgid = (int)L; { const int q = nwg / NXCD, r = nwg % NXCD, xcd = wgid % NXCD, off = wgid / NXCD; wgid = (xcd < r ? xcd * (q + 1) : r * (q + 1) + (xcd - r) * q) + off; }
        const int nig = WGM * nN, gid = wgid / nig, fm = gid * WGM, gsz = (nM - fm) < WGM ? (nM - fm) : WGM;
        u.pm = fm + ((wgid % nig) % gsz); u.pn = (wgid % nig) / gsz + pn0; u.ko = ko; u.nk = nk; u.part = 0;
        if (mode == 1 || mode == 3) u.pm = u.pm + 1 + (u.pm >= 16 ? 1 : 0);
        return true;
    }
};

template <class Epi, class Sched, bool ALIGN_EPI = true>
__device__ __forceinline__ void gemm_phase(PG8_LAS unsigned char* lds, const Gemm g, const Sched& S, const Epi& E, const int tid) {
    const int wid = __builtin_amdgcn_readfirstlane(tid >> 6), lane = tid & 63, wr = wid >> 2, wc = wid & 3, fr = lane & 15, fq = lane >> 4;
    unsigned voffA[2], voffB[2];
#pragma unroll
    for (int i = 0; i < 2; ++i) { int R, C; stage_rc(tid * 16 + i * 8192, R, C); const int Rb = Epi::PERM ? ((R & ~31) + perm32(R & 31)) : R;
        voffA[i] = (unsigned)(R * g.lda + C) * 2u; voffB[i] = (unsigned)(Rb * g.ldb + C) * 2u; }
    const size_t kstep = (size_t)(BK * 2);
    const size_t hstepA = (size_t)HALF * g.lda * 2, hstepB = (size_t)HALF * g.ldb * 2;
    const size_t tstepA = 2 * hstepA, tstepB = 2 * hstepB;
    const unsigned ldsw = (unsigned)wid * 1024u;
    const int aoff = lds_byte(wr * 64 + fr, fq * 8), boff = lds_byte(wc * 32 + fr, fq * 8);
#define PG8_SA(b, h) (((b) * 2 + (h)) * HTB)
#define PG8_SB(b, h) ((4 + (b) * 2 + (h)) * HTB)
#define PG8_STAGE(bufoff, gbase, voff) do { _Pragma("unroll") for (int _i = 0; _i < 2; ++_i) \
        __builtin_amdgcn_global_load_lds((const unsigned*)((const char*)(gbase) + (voff)[_i]), (PG8_LAS unsigned*)(lds + (bufoff) + ldsw + _i * 8192), 16, 0, 0); } while (0)
#define PG8_LDA(dst, b, h) do { _Pragma("unroll") for (int m = 0; m < 4; ++m) _Pragma("unroll") for (int k = 0; k < 2; ++k) dst[m][k] = *(const PG8_LAS bf16x8*)(lds + PG8_SA(b, h) + aoff + m * 2048 + k * 1024); } while (0)
#define PG8_LDB(dst, b, h) do { _Pragma("unroll") for (int n = 0; n < 2; ++n) _Pragma("unroll") for (int k = 0; k < 2; ++k) dst[n][k] = *(const PG8_LAS bf16x8*)(lds + PG8_SB(b, h) + boff + n * 2048 + k * 1024); } while (0)
#define PG8_MMA(ai, bj, At, Bt) do { __builtin_amdgcn_s_setprio(1); _Pragma("unroll") for (int m = 0; m < 4; ++m) _Pragma("unroll") for (int n = 0; n < 2; ++n) _Pragma("unroll") for (int k = 0; k < 2; ++k) \
        acc[ai][bj][m][n] = __builtin_amdgcn_mfma_f32_16x16x32_bf16(Bt[n][k], At[m][k], acc[ai][bj][m][n], 0, 0, 0); __builtin_amdgcn_s_setprio(0); } while (0)
#define PG8_WAIT_V(n) asm volatile("s_waitcnt vmcnt(" #n ")" ::: "memory")
#define PG8_WAIT_L(n) asm volatile("s_waitcnt lgkmcnt(" #n ")" ::: "memory")
#define PG8_BAR __builtin_amdgcn_s_barrier()
#define PG8_SCHED __builtin_amdgcn_sched_barrier(0)
    Unit cur, nxt; int ui = 0;
    if (!S.next(0, cur)) return;
    f32x4 acc[2][2][4][2];
#pragma unroll
    for (int a = 0; a < 2; ++a)
#pragma unroll
        for (int b = 0; b < 2; ++b)
#pragma unroll
            for (int m = 0; m < 4; ++m)
#pragma unroll
                for (int n = 0; n < 2; ++n) acc[a][b][m][n] = (f32x4){0.f, 0.f, 0.f, 0.f};
    bf16x8 At[4][2], B0[2][2], B1[2][2];
    const char* cA = (const char*)g.A + (size_t)cur.pm * tstepA + (size_t)cur.ko * 2; const char* cB = (const char*)g.Bt + (size_t)cur.pn * tstepB + (size_t)cur.ko * 2;
    PG8_STAGE(PG8_SB(0, 0), cB, voffB); PG8_STAGE(PG8_SB(0, 1), cB + hstepB, voffB); PG8_STAGE(PG8_SA(0, 0), cA, voffA); PG8_STAGE(PG8_SA(0, 1), cA + hstepA, voffA);
    if (wr == 1) PG8_BAR;
    PG8_WAIT_V(2); PG8_BAR;
    PG8_STAGE(PG8_SB(1, 0), cB + kstep, voffB); PG8_STAGE(PG8_SA(1, 0), cA + kstep, voffA); PG8_STAGE(PG8_SB(1, 1), cB + hstepB + kstep, voffB);
    PG8_WAIT_V(6); PG8_BAR;
    for (;;) {
        const bool has_next = S.next(ui + 1, nxt);
        const char* nA = has_next ? (const char*)g.A + (size_t)nxt.pm * tstepA + (size_t)nxt.ko * 2 : cA; const char* nB = has_next ? (const char*)g.Bt + (size_t)nxt.pn * tstepB + (size_t)nxt.ko * 2 : cB;
        const int nt = cur.nk;
        for (int t = 0; t < nt; t += 2) {
            const bool last = (t == nt - 2);
            const char* a1 = cA + (size_t)(t + 1) * kstep;
            const char* a2 = last ? nA : cA + (size_t)(t + 2) * kstep; const char* b2 = last ? nB : cB + (size_t)(t + 2) * kstep;
            const char* a3 = a2 + kstep; const char* b3 = b2 + kstep;
            PG8_LDB(B0, 0, 0); PG8_LDB(B1, 0, 1); PG8_SCHED; PG8_LDA(At, 0, 0); PG8_STAGE(PG8_SA(1, 1), a1 + hstepA, voffA);
            PG8_WAIT_V(8); PG8_WAIT_L(0); PG8_BAR; PG8_MMA(0, 0, At, B0); PG8_MMA(0, 1, At, B1); PG8_BAR; PG8_SCHED;
            PG8_LDA(At, 0, 1); PG8_STAGE(PG8_SB(0, 0), b2, voffB); PG8_STAGE(PG8_SB(0, 1), b2 + hstepB, voffB); PG8_STAGE(PG8_SA(0, 0), a2, voffA);
            PG8_WAIT_V(8); PG8_WAIT_L(0); PG8_BAR; PG8_MMA(1, 0, At, B0); PG8_MMA(1, 1, At, B1); PG8_BAR; PG8_SCHED;
            PG8_LDB(B0, 1, 0); PG8_LDB(B1, 1, 1); PG8_SCHED; PG8_LDA(At, 1, 0); PG8_STAGE(PG8_SA(0, 1), a2 + hstepA, voffA);
            PG8_WAIT_V(8); PG8_WAIT_L(0); PG8_BAR; PG8_MMA(0, 0, At, B0); PG8_MMA(0, 1, At, B1); PG8_BAR; PG8_SCHED;
            PG8_LDA(At, 1, 1); PG8_STAGE(PG8_SB(1, 0), b3, voffB); PG8_STAGE(PG8_SB(1, 1), b3 + hstepB, voffB); PG8_STAGE(PG8_SA(1, 0), a3, voffA);
            PG8_WAIT_V(8); PG8_WAIT_L(0); PG8_BAR; PG8_MMA(1, 0, At, B0); PG8_MMA(1, 1, At, B1); PG8_BAR; PG8_SCHED;
        }
        if constexpr (ALIGN_EPI) { if (wr == 0) PG8_BAR; }
        if constexpr (!Epi::AFTER_DRAIN) { const int l2 = lane_id_opaque(); E(acc, cur, wr, wc, l2 & 15, l2 >> 4); }
        if (!has_next) break;
#pragma unroll
        for (int a = 0; a < 2; ++a)
#pragma unroll
            for (int b = 0; b < 2; ++b)
#pragma unroll
                for (int m = 0; m < 4; ++m)
#pragma unroll
                    for (int n = 0; n < 2; ++n) acc[a][b][m][n] = (f32x4){0.f, 0.f, 0.f, 0.f};
        cur = nxt; cA = nA; cB = nB; ++ui;
        if constexpr (ALIGN_EPI) { if (wr == 1) PG8_BAR; }
    }
    PG8_WAIT_V(0);
    if constexpr (!ALIGN_EPI) { if (wr == 0) PG8_BAR; }
    PG8_BAR;
    if constexpr (Epi::AFTER_DRAIN) { const int l2 = lane_id_opaque(); E.fused(acc, cur, wr, wc, l2 & 15, l2 >> 4, lds, wid, l2); }
#undef PG8_SA
#undef PG8_SB
#undef PG8_STAGE
#undef PG8_LDA
#undef PG8_LDB
#undef PG8_MMA
#undef PG8_WAIT_V
#undef PG8_WAIT_L
#undef PG8_BAR
#undef PG8_SCHED
}

struct EpiF32 {
    static constexpr bool PERM = true, AFTER_DRAIN = false;
    bf16_t* C; int ldc; float* YC;
    __device__ __forceinline__ void operator()(const f32x4 (&acc)[2][2][4][2], const Unit& u, int wr, int wc, int fr, int fq) const {
        const int col0 = u.pn * BM + wc * 32 + 8 * fq;
        if (u.part) {
            const int row0 = (u.pm ? CTX : 0) + wr * 64 + fr; float* slab = YC + (size_t)(u.part - 1) * NB * CTX * ldc;
#pragma unroll
            for (int ai = 0; ai < 2; ++ai)
#pragma unroll
                for (int m = 0; m < 4; ++m) { float* rowp = slab + (size_t)(row0 + ai * HALF + m * 16) * ldc + col0;
#pragma unroll
                    for (int bj = 0; bj < 2; ++bj)
#pragma unroll
                        for (int n = 0; n < 2; ++n) *(f32x4*)(rowp + bj * HALF + 4 * n) = acc[ai][bj][m][n]; }
        } else {
            const int row0 = u.pm * BM + wr * 64 + fr;
#pragma unroll
            for (int ai = 0; ai < 2; ++ai)
#pragma unroll
                for (int m = 0; m < 4; ++m) { bf16_t* rowp = C + (size_t)(row0 + ai * HALF + m * 16) * ldc + col0;
#pragma unroll
                    for (int bj = 0; bj < 2; ++bj) { const f32x4 v0 = acc[ai][bj][m][0], v1 = acc[ai][bj][m][1];
                        u32x4 w; w.x = pk2(v0[0], v0[1]); w.y = pk2(v0[2], v0[3]); w.z = pk2(v1[0], v1[1]); w.w = pk2(v1[2], v1[3]);
                        *(u32x4*)(rowp + bj * HALF) = w; } }
        }
    }
};
struct EpiBf16 {
    static constexpr bool PERM = true, AFTER_DRAIN = false;
    bf16_t* O; int ldc; int coff;
    __device__ __forceinline__ void operator()(const f32x4 (&acc)[2][2][4][2], const Unit& u, int wr, int wc, int fr, int fq) const {
        const int row0 = u.pm * BM + wr * 64 + fr, col0 = u.pn * BM - coff + wc * 32 + 8 * fq;
#pragma unroll
        for (int ai = 0; ai < 2; ++ai)
#pragma unroll
            for (int m = 0; m < 4; ++m) { bf16_t* rowp = O + (size_t)(row0 + ai * HALF + m * 16) * ldc + col0;
#pragma unroll
                for (int bj = 0; bj < 2; ++bj) { const f32x4 v0 = acc[ai][bj][m][0], v1 = acc[ai][bj][m][1];
                    u32x4 w; w.x = pk2(v0[0], v0[1]); w.y = pk2(v0[2], v0[3]); w.z = pk2(v1[0], v1[1]); w.w = pk2(v1[2], v1[3]);
                    *(u32x4*)(rowp + bj * HALF) = w; } }
    }
};
struct EpiSwiglu {
    static constexpr bool PERM = true, AFTER_DRAIN = false;
    bf16_t* O; int ldc;
    __device__ __forceinline__ void operator()(const f32x4 (&acc)[2][2][4][2], const Unit& u, int wr, int wc, int fr, int fq) const {
        const int row0 = u.pm * BM + wr * 64 + fr, col0 = u.pn * HALF + wc * 32 + 8 * fq;
#pragma unroll
        for (int ai = 0; ai < 2; ++ai)
#pragma unroll
            for (int m = 0; m < 4; ++m) { bf16_t* rowp = O + (size_t)(row0 + ai * HALF + m * 16) * ldc + col0;
                float o[8];
#pragma unroll
                for (int n = 0; n < 2; ++n)
#pragma unroll
                    for (int j = 0; j < 4; ++j) { const float gt = acc[ai][0][m][n][j], up = acc[ai][1][m][n][j]; o[4 * n + j] = fsilu(gt) * up; }
                *(u32x4*)rowp = pack8(o); }
    }
};
struct EpiDec {
    static constexpr bool PERM = true, AFTER_DRAIN = false;
    float* DEC; const float* w0;
    __device__ __forceinline__ void operator()(const f32x4 (&acc)[2][2][4][2], const Unit& u, int wr, int wc, int fr, int fq) const {
        const int row0 = u.pm * BM + wr * 64 + fr; const int seg = u.pn >> 2; const int cs0 = (u.pn & 3) * BM + wc * 32 + 8 * fq;
        float* dbase = DEC + (size_t)seg * M * MIXA;
#pragma unroll
        for (int bj = 0; bj < 2; ++bj) { const int cs = cs0 + bj * HALF;
            const f32x4 wa = *(const f32x4*)(w0 + seg * MIXA + cs), wb = *(const f32x4*)(w0 + seg * MIXA + cs + 4);
#pragma unroll
            for (int ai = 0; ai < 2; ++ai)
#pragma unroll
                for (int m = 0; m < 4; ++m) { float* dp = dbase + (size_t)(row0 + ai * HALF + m * 16) * MIXA + cs;
                    f32x4 o0, o1;
#pragma unroll
                    for (int j = 0; j < 4; ++j) {
                        const float x0 = acc[ai][bj][m][0][j] + wa[j], x1 = acc[ai][bj][m][1][j] + wb[j];
                        o0[j] = -0.6065306597126334f * fsigmoid(x0); o1[j] = -0.6065306597126334f * fsigmoid(x1); }
                    *(f32x4*)dp = o0; *(f32x4*)(dp + 4) = o1; } }
    }
};
struct EpiLr {
    static constexpr bool PERM = true, AFTER_DRAIN = false;
    bf16_t* KM; const bf16_t* KKp; bf16_t* BV; const float* a0; const float* ka;
    __device__ __forceinline__ void operator()(const f32x4 (&acc)[2][2][4][2], const Unit& u, int wr, int wc, int fr, int fq) const {
        const int row0 = u.pm * BM + wr * 64 + fr; const int cs0 = (u.pn & 3) * BM + wc * 32 + 8 * fq;
#pragma unroll
        for (int bj = 0; bj < 2; ++bj)
#pragma unroll
            for (int n = 0; n < 2; ++n) { const int cs = cs0 + bj * HALF + 4 * n;
                const f32x4 aa = *(const f32x4*)(a0 + cs), kav = *(const f32x4*)(ka + cs);
                u32x2 kws[2][4], qws[2][4];
#pragma unroll
                for (int ai = 0; ai < 2; ++ai)
#pragma unroll
                    for (int m = 0; m < 4; ++m) { const size_t off = (size_t)(row0 + ai * HALF + m * 16) * MIXA + cs; kws[ai][m] = *(const u32x2*)(KM + off); qws[ai][m] = *(const u32x2*)(KKp + off); }
#pragma unroll
                for (int ai = 0; ai < 2; ++ai)
#pragma unroll
                    for (int m = 0; m < 4; ++m) { const size_t off = (size_t)(row0 + ai * HALF + m * 16) * MIXA + cs;
                        const u32x2 kw = kws[ai][m], qw = qws[ai][m];
                        const float kv[4] = {bflo(kw.x), bfhi(kw.x), bflo(kw.y), bfhi(kw.y)}, kk[4] = {bflo(qw.x), bfhi(qw.x), bflo(qw.y), bfhi(qw.y)};
                        float km[4], bv[4];
#pragma unroll
                        for (int j = 0; j < 4; ++j) { const float lr = fsigmoid(acc[ai][bj][m][n][j] + aa[j]);
                            km[j] = kv[j] * (1.0f + (lr - 1.0f) * kav[j]); bv[j] = kk[j] * lr; }
                        u32x2 o1, o2; o1.x = pk2(km[0], km[1]); o1.y = pk2(km[2], km[3]); o2.x = pk2(bv[0], bv[1]); o2.y = pk2(bv[2], bv[3]);
                        *(u32x2*)(KM + off) = o1; *(u32x2*)(BV + off) = o2; } }
    }
};
struct EpiRet {
    static constexpr bool PERM = true, AFTER_DRAIN = false;
    bf16_t* O; int ldc; const float* rot;
    __device__ __forceinline__ void operator()(const f32x4 (&acc)[2][2][4][2], const Unit& u, int wr, int wc, int fr, int fq) const {
        const int row0 = u.pm * BM + wr * 64 + fr, col0 = u.pn * BM + wc * 32 + 8 * fq;
        const bool qk = u.pn < 16; const float sc = (u.pn >= 8 && u.pn < 16) ? 0.0625f : 1.0f;
        const int f0 = (wc * 32 + 8 * fq) & 63; const bool use_row = wc < 2;
#pragma unroll
        for (int ai = 0; ai < 2; ++ai)
#pragma unroll
            for (int m = 0; m < 4; ++m) { const int row = row0 + ai * HALF + m * 16; bf16_t* rowp = O + (size_t)row * ldc + col0;
                float o0[8], o1[8];
#pragma unroll
                for (int n = 0; n < 2; ++n)
#pragma unroll
                    for (int j = 0; j < 4; ++j) { o0[4 * n + j] = acc[ai][0][m][n][j]; o1[4 * n + j] = acc[ai][1][m][n][j]; }
                const int t = row % TB;
                if (qk) {
                    if (t >= CTX) { const int s = t - CTX; const int pos = use_row ? (s >> 6) : (s & 63); const f32x4* rp = (const f32x4*)(rot + ((size_t)pos * 64 + f0) * 2);
#pragma unroll
                        for (int i = 0; i < 4; ++i) { const f32x4 cs = rp[i];
                            const float a0 = o0[2 * i], b0 = o1[2 * i], a1 = o0[2 * i + 1], b1 = o1[2 * i + 1];
                            o0[2 * i] = a0 * cs[0] - b0 * cs[1]; o1[2 * i] = a0 * cs[1] + b0 * cs[0];
                            o0[2 * i + 1] = a1 * cs[2] - b1 * cs[3]; o1[2 * i + 1] = a1 * cs[3] + b1 * cs[2]; } }
#pragma unroll
                    for (int i = 0; i < 8; ++i) { o0[i] *= sc; o1[i] *= sc; }
                }
                *(u32x4*)rowp = pack8(o0); *(u32x4*)(rowp + HALF) = pack8(o1); }
    }
};
struct NormX {
    float* xbuf;
    unsigned* cnt;
    unsigned* tmo;
    __device__ __forceinline__ void publish(const float (&ss)[2][4], const Unit& u, int wr, int wc, int fr, int fq, PG8_LAS unsigned char* lds, int wid, int lane) const {
        PG8_LAS float* P = (PG8_LAS float*)lds;
#pragma unroll
        for (int ai = 0; ai < 2; ++ai)
#pragma unroll
            for (int m = 0; m < 4; ++m) { float q = ss[ai][m]; q += __shfl_xor(q, 16); q += __shfl_xor(q, 32);
                if (fq == 0) P[(ai * HALF + wr * 64 + m * 16 + fr) * 4 + wc] = q; }
        asm volatile("s_waitcnt lgkmcnt(0)" ::: "memory"); __builtin_amdgcn_s_barrier(); asm volatile("" ::: "memory");
        const int row = wid * 32 + (lane & 31);
        if (lane < 32) { const f32x4 pq = *(const PG8_LAS f32x4*)(P + row * 4); const float tot = (pq[0] + pq[1]) + (pq[2] + pq[3]);
            __hip_atomic_store((unsigned*)xbuf + ((size_t)(u.pm * BM + row) * 8 + u.pn), __float_as_uint(tot), __ATOMIC_RELAXED, __HIP_MEMORY_SCOPE_AGENT); }
        asm volatile("s_waitcnt vmcnt(0)" ::: "memory");
        if (lane == 0) __hip_atomic_fetch_add(cnt + 64 * u.pm, 1u, __ATOMIC_RELAXED, __HIP_MEMORY_SCOPE_AGENT);
    }
    __device__ __forceinline__ void finish(const Unit& u, PG8_LAS unsigned char* lds, int wid, int lane) const {
        PG8_LAS float* S = (PG8_LAS float*)(lds + 4096);
        const int row = wid * 32 + (lane & 31);
        if (wid == 0) {
            unsigned sp = 0u;
            while ((unsigned)__builtin_amdgcn_readfirstlane((int)__hip_atomic_load(cnt + 64 * u.pm, __ATOMIC_RELAXED, __HIP_MEMORY_SCOPE_AGENT)) < 64u) {
                __builtin_amdgcn_s_sleep(1);
                if ((++sp & 255u) == 0u) { if (__hip_atomic_load(tmo, __ATOMIC_RELAXED, __HIP_MEMORY_SCOPE_AGENT)) break; if (sp > (1u << 20)) { if (lane == 0) atomicAdd(tmo, 1u); break; } } }
        }
        asm volatile("s_waitcnt vmcnt(0) lgkmcnt(0)" ::: "memory"); __builtin_amdgcn_s_barrier(); asm volatile("" ::: "memory");
        if (lane < 32) { const unsigned* slot = (const unsigned*)xbuf + (size_t)(u.pm * BM + row) * 8; float q = 0.f;
#pragma unroll
            for (int t = 0; t < 8; ++t) q += __uint_as_float(__hip_atomic_load(slot + t, __ATOMIC_RELAXED, __HIP_MEMORY_SCOPE_AGENT));
            S[row] = rsqrtf(q * (1.0f / 2048.0f) + 1e-6f); }
        asm volatile("s_waitcnt lgkmcnt(0)" ::: "memory"); __builtin_amdgcn_s_barrier(); asm volatile("" ::: "memory");
    }
};
struct EpiNorm {
    static constexpr bool PERM = true, AFTER_DRAIN = true;
    bf16_t* H; bf16_t* ABF; float* OUT; const float* gatev; const float* ngy; const float* ngn; const float* shiftv; const float* scalev; bool fin; NormX x1, x2;
    __device__ __forceinline__ void operator()(const f32x4 (&)[2][2][4][2], const Unit&, int, int, int, int) const {}
    __device__ __forceinline__ void fused(f32x4 (&acc)[2][2][4][2], const Unit& u, int wr, int wc, int fr, int fq, PG8_LAS unsigned char* lds, int wid, int lane) const {
        const PG8_LAS float* S = (const PG8_LAS float*)(lds + 4096);
        const int b = u.pm / 17, col0 = u.pn * BM + wc * 32 + 8 * fq;
        float ss[2][4];
#pragma unroll
        for (int ai = 0; ai < 2; ++ai)
#pragma unroll
            for (int m = 0; m < 4; ++m) { float q = 0.f;
#pragma unroll
                for (int bj = 0; bj < 2; ++bj)
#pragma unroll
                    for (int n = 0; n < 2; ++n) { const f32x4 x = acc[ai][bj][m][n]; q += (x[0] * x[0] + x[1] * x[1]) + (x[2] * x[2] + x[3] * x[3]); }
                ss[ai][m] = q; }
        x1.publish(ss, u, wr, wc, fr, fq, lds, wid, lane);
        u32x4 hw[2][4][2];
#pragma unroll
        for (int ai = 0; ai < 2; ++ai)
#pragma unroll
            for (int m = 0; m < 4; ++m)
#pragma unroll
                for (int bj = 0; bj < 2; ++bj) hw[ai][m][bj] = *(const u32x4*)(H + ((size_t)u.pm * BM + ai * HALF + wr * 64 + m * 16 + fr) * D + col0 + bj * HALF);
        f32x4 gy[2][2];
#pragma unroll
        for (int bj = 0; bj < 2; ++bj)
#pragma unroll
            for (int n = 0; n < 2; ++n) { const int c = col0 + bj * HALF + 4 * n; gy[bj][n] = *(const f32x4*)(gatev + (size_t)b * 12288 + c) * *(const f32x4*)(ngy + c); }
        x1.finish(u, lds, wid, lane);
        {
#pragma unroll
            for (int ai = 0; ai < 2; ++ai)
#pragma unroll
                for (int m = 0; m < 4; ++m) { const int r = ai * HALF + wr * 64 + m * 16 + fr; const float rs = S[r]; const size_t grow = (size_t)u.pm * BM + r;
#pragma unroll
                    for (int bj = 0; bj < 2; ++bj) { const u32x4 hq = hw[ai][m][bj];
                        f32x4 h0 = {bflo(hq.x), bfhi(hq.x), bflo(hq.y), bfhi(hq.y)}, h1 = {bflo(hq.z), bfhi(hq.z), bflo(hq.w), bfhi(hq.w)};
                        h0 += gy[bj][0] * (acc[ai][bj][m][0] * rs); h1 += gy[bj][1] * (acc[ai][bj][m][1] * rs);
                        if (fin) { float* o = OUT + ((size_t)b * SEQ + ((u.pm % 17) * BM + r - CTX)) * D + col0 + bj * HALF; *(f32x4*)o = h0; *(f32x4*)(o + 4) = h1; }
                        else { u32x4 w; w.x = pk2(h0[0], h0[1]); w.y = pk2(h0[2], h0[3]); w.z = pk2(h1[0], h1[1]); w.w = pk2(h1[2], h1[3]);
                            *(u32x4*)(H + grow * D + col0 + bj * HALF) = w;
                            acc[ai][bj][m][0] = (f32x4){bflo(w.x), bfhi(w.x), bflo(w.y), bfhi(w.y)}; acc[ai][bj][m][1] = (f32x4){bflo(w.z), bfhi(w.z), bflo(w.w), bfhi(w.w)}; } } }
        }
        if (fin) return;
#pragma unroll
        for (int ai = 0; ai < 2; ++ai)
#pragma unroll
            for (int m = 0; m < 4; ++m) { float q = 0.f;
#pragma unroll
                for (int bj = 0; bj < 2; ++bj)
#pragma unroll
                    for (int n = 0; n < 2; ++n) { const f32x4 x = acc[ai][bj][m][n]; q += (x[0] * x[0] + x[1] * x[1]) + (x[2] * x[2] + x[3] * x[3]); }
                ss[ai][m] = q; }
        x2.publish(ss, u, wr, wc, fr, fq, lds, wid, lane);
        f32x4 an[2][2], sh[2][2];
#pragma unroll
        for (int bj = 0; bj < 2; ++bj)
#pragma unroll
            for (int n = 0; n < 2; ++n) { const int c = col0 + bj * HALF + 4 * n;
                an[bj][n] = *(const f32x4*)(ngn + c) * (*(const f32x4*)(scalev + (size_t)b * 12288 + c) + 1.0f); sh[bj][n] = *(const f32x4*)(shiftv + (size_t)b * 12288 + c); }
        x2.finish(u, lds, wid, lane);
        {
#pragma unroll
            for (int ai = 0; ai < 2; ++ai)
#pragma unroll
                for (int m = 0; m < 4; ++m) { const int r = ai * HALF + wr * 64 + m * 16 + fr; const float rs = S[r]; const size_t grow = (size_t)u.pm * BM + r;
#pragma unroll
                    for (int bj = 0; bj < 2; ++bj) { const f32x4 o0 = (acc[ai][bj][m][0] * rs) * an[bj][0] + sh[bj][0], o1 = (acc[ai][bj][m][1] * rs) * an[bj][1] + sh[bj][1];
                        u32x4 w; w.x = pk2(o0[0], o0[1]); w.y = pk2(o0[2], o0[3]); w.z = pk2(o1[0], o1[1]); w.w = pk2(o1[2], o1[3]);
                        *(u32x4*)(ABF + grow * D + col0 + bj * HALF) = w; } }
        }
    }
};
}

#define XB_TMO      128
#define XB_XCNT(j)  (256  + 64 * (j))
#define XB_XSUB(j)  (1280 + 64 * (j))
#define XB_XGEN(j)  (2304 + 64 * (j))
#define XB_TOP      3328
#define XB_TOPGEN   3392
#define XCD_BAR_WORDS 3456
#define XB_SPIN_CAP (1u << 20)
__device__ __forceinline__ unsigned xb_ld(unsigned* p)              { return __hip_atomic_load(p, __ATOMIC_RELAXED, __HIP_MEMORY_SCOPE_AGENT); }
__device__ __forceinline__ unsigned xb_add(unsigned* p, unsigned v) { return __hip_atomic_fetch_add(p, v, __ATOMIC_RELAXED, __HIP_MEMORY_SCOPE_AGENT); }
__device__ __forceinline__ unsigned xb_xcc_id() { return (unsigned)__builtin_amdgcn_s_getreg((3 << 11) | 20) & 0xFu; }
#define XB_SPIN(cond, bar) do { unsigned _sp = 0; while (cond) { __builtin_amdgcn_s_sleep(1); \
    if ((++_sp & 255u) == 0u) { if (xb_ld(&(bar)[XB_TMO])) break; if (_sp > XB_SPIN_CAP) { atomicAdd(&(bar)[XB_TMO], 1u); break; } } } } while (0)
struct XcdBarrier { unsigned* bar; unsigned x; volatile LAS unsigned* st; };
__device__ __forceinline__ XcdBarrier xcd_barrier_post(unsigned* bar, volatile LAS unsigned* st) {
    XcdBarrier b; b.bar = bar; b.x = xb_xcc_id(); b.st = st;
    if (threadIdx.x == 0) (void)xb_add(&bar[XB_XCNT(b.x)], 1u);
    return b;
}
__device__ __forceinline__ void xcd_barrier_complete(unsigned* bar, unsigned x, unsigned& nloc, unsigned& nx) {
    const unsigned G = gridDim.x * gridDim.y * gridDim.z;
    unsigned sum, cnt, mine, sp = 0u;
    for (;;) {
        sum = 0u; cnt = 0u; mine = 0u;
#pragma unroll
        for (unsigned j = 0; j < 16; ++j) { const unsigned c = xb_ld(&bar[XB_XCNT(j)]); sum += c; cnt += (c > 0u) ? 1u : 0u; mine = (j == x) ? c : mine; }
        if (sum == G) break;
        __builtin_amdgcn_s_sleep(1);
        if ((++sp & 255u) == 0u) { if (xb_ld(&bar[XB_TMO])) break; if (sp > XB_SPIN_CAP) { atomicAdd(&bar[XB_TMO], 1u); break; } }
    }
    nloc = mine > 0u ? mine : 1u; nx = cnt > 0u ? cnt : 1u;
}
__device__ __forceinline__ void xcd_barrier(const XcdBarrier& b) {
    asm volatile("s_waitcnt vmcnt(0)" ::: "memory");
    __syncthreads();
    if (threadIdx.x == 0) {
        unsigned* bar = b.bar;
        __builtin_amdgcn_s_waitcnt(0);
        unsigned nloc = b.st[0], nx = b.st[1];
        if (nloc == 0u) { xcd_barrier_complete(bar, b.x, nloc, nx); b.st[0] = nloc; b.st[1] = nx; }
        const unsigned old = xb_add(&bar[XB_XSUB(b.x)], 1u);
        const unsigned gen = old / nloc;
        if (old + 1u == (gen + 1u) * nloc) {
            __builtin_amdgcn_fence(__ATOMIC_RELEASE, "agent");
            asm volatile("s_waitcnt vmcnt(0)" ::: "memory");
            __builtin_amdgcn_fence(__ATOMIC_ACQUIRE, "agent");
            const unsigned og = xb_add(&bar[XB_TOP], 1u);
            const unsigned tg = og / nx;
            if (og + 1u == (tg + 1u) * nx) xb_add(&bar[XB_TOPGEN], 1u);
            else XB_SPIN(xb_ld(&bar[XB_TOPGEN]) == tg, bar);
            xb_add(&bar[XB_XGEN(b.x)], 1u);
            asm volatile("s_waitcnt vmcnt(0)" ::: "memory");
        } else {
            __builtin_amdgcn_fence(__ATOMIC_ACQUIRE, "agent");
            XB_SPIN(xb_ld(&bar[XB_XGEN(b.x)]) == gen, bar);
            asm volatile("s_waitcnt vmcnt(0)" ::: "memory");
        }
    }
    __syncthreads();
}

struct Args {
    const float* in[27];
    float* out; unsigned char* ws;
    int ph_lo, ph_hi;
};
enum { I_X = 0, I_C, I_CTX, I_CCTX, I_MODW, I_MODB, I_NG, I_FWI, I_FWO, I_ABWI, I_ABWO, I_MU, I_W0, I_W2, I_A0, I_A2, I_G2, I_KK, I_KA, I_RK, I_LNW, I_LNB, I_GKUP, I_GKB, I_GLAG, I_RWI, I_RWO };

struct Fr {
    LAS unsigned char* lds; int tid, lane, wave, vcu, G;
};

__device__ __forceinline__ int dst_row(int n, int mode) {
    if (mode == 0) return n;
    return n < DFF ? 256 * (n / 128) + (n % 128) : 256 * ((n - DFF) / 128) + 128 + ((n - DFF) % 128);
}
__device__ __forceinline__ void conv_job(const Fr& F, const float* W, int K, int N, int Npad, bf16* WT, int mode, int wgi, int nWG) {
    LAS float* scr = (LAS float*)F.lds;
    const int tid = F.tid, ntn = Npad / 128, nitems = (K / 128) * ntn;
    const int lr = tid >> 5, lc = 4 * (tid & 31);
    f32x4 reg[8];
    int it = wgi;
    if (it < nitems) { const int k0 = (it / ntn) * 128, n0 = (it % ntn) * 128;
#pragma unroll
        for (int i = 0; i < 8; ++i) reg[i] = (n0 + lc < N) ? __builtin_nontemporal_load((const f32x4*)(W + (size_t)(k0 + lr + 16 * i) * N + n0 + lc)) : (f32x4){0.f, 0.f, 0.f, 0.f}; }
    while (it < nitems) {
        const int k0 = (it / ntn) * 128, n0 = (it % ntn) * 128;
#pragma unroll
        for (int i = 0; i < 8; ++i) *(LAS f32x4*)(scr + (lr + 16 * i) * 132 + lc) = reg[i];
        __syncthreads();
        const int nxt = it + nWG;
        if (nxt < nitems) { const int k1 = (nxt / ntn) * 128, n1 = (nxt % ntn) * 128;
#pragma unroll
            for (int i = 0; i < 8; ++i) reg[i] = (n1 + lc < N) ? __builtin_nontemporal_load((const f32x4*)(W + (size_t)(k1 + lr + 16 * i) * N + n1 + lc)) : (f32x4){0.f, 0.f, 0.f, 0.f}; }
        { const int c = tid & 15;
#pragma unroll
          for (int j = 0; j < 4; ++j) { const int n = (tid >> 4) + 32 * j; const LAS float* sp = scr + (8 * c) * 132 + n;
              u32x4 o; o.x = pk2(sp[0], sp[132]); o.y = pk2(sp[2 * 132], sp[3 * 132]); o.z = pk2(sp[4 * 132], sp[5 * 132]); o.w = pk2(sp[6 * 132], sp[7 * 132]);
              __builtin_nontemporal_store(o, (u32x4*)(WT + (size_t)dst_row(n0 + n, mode) * K + k0 + 8 * c)); } }
        __syncthreads();
        it = nxt;
    }
}
struct ConvJob { const float* W; bf16* WT; int K, N, Npad, mode; };
__device__ __forceinline__ void conv_jobs(const Fr& F, const Args& a, int jlo, int jhi, int wgi, int nWG) {
    unsigned char* ws = a.ws;
    ConvJob jobs[8];
    jobs[0] = {a.in[I_ABWI], (bf16*)(ws + WS_WAB), D, ABCOLS, ZLD0, 0};
    jobs[1] = {a.in[I_ABWO], (bf16*)(ws + WS_WO0), D, D, D, 0};
    jobs[2] = {a.in[I_FWI], (bf16*)(ws + WS_WFI0), D, 2 * DFF, 2 * DFF, 1};
    jobs[3] = {a.in[I_FWO], (bf16*)(ws + WS_WFO0), DFF, D, D, 0};
    jobs[4] = {a.in[I_RWI], (bf16*)(ws + WS_WRI), D, RETC, RETC, 0};
    jobs[5] = {a.in[I_RWO], (bf16*)(ws + WS_WRO), 2 * D, D, D, 0};
    jobs[6] = {a.in[I_FWI] + (size_t)D * 2 * DFF, (bf16*)(ws + WS_WFI1), D, 2 * DFF, 2 * DFF, 1};
    jobs[7] = {a.in[I_FWO] + (size_t)DFF * D, (bf16*)(ws + WS_WFO1), DFF, D, D, 0};
#pragma unroll
    for (int j = 0; j < 8; ++j) {
        if (j < jlo || j >= jhi) continue;
        conv_job(F, jobs[j].W, jobs[j].K, jobs[j].N, jobs[j].Npad, jobs[j].WT, jobs[j].mode, wgi, nWG);
    }
}
__device__ __forceinline__ void conv_dyn(const Fr& F, const Args& a, unsigned* qhead, int jlo, int jhi) {
    unsigned char* ws = a.ws;
    LAS float* scr = (LAS float*)F.lds; volatile LAS int* slot = (volatile LAS int*)(F.lds + 128 * 132 * 4);
    const int tid = F.tid, lr = tid >> 5, lc = 4 * (tid & 31);
    constexpr int NT[8] = {(D / 128) * (ZLD0 / 128), (D / 128) * (D / 128), (D / 128) * (2 * DFF / 128), (DFF / 128) * (D / 128), (D / 128) * (RETC / 128), (2 * D / 128) * (D / 128), (D / 128) * (2 * DFF / 128), (DFF / 128) * (D / 128)};
    int total = 0;
#pragma unroll
    for (int j = 0; j < 8; ++j) if (j >= jlo && j < jhi) total += NT[j];
    const float* W = nullptr; bf16* WT = nullptr; int K = 0, N = 0, Np = 0, mode = 0, k0 = 0, n0 = 0;
    auto decode = [&](int it) {
        int li = it, job = jlo;
#pragma unroll
        for (int j = 0; j < 8; ++j) if (j >= jlo && j < jhi - 1 && job == j && li >= NT[j]) { li -= NT[j]; job = j + 1; }
        switch (job) {
            case 0: W = a.in[I_ABWI]; WT = (bf16*)(ws + WS_WAB); K = D; N = ABCOLS; Np = ZLD0; mode = 0; break;
            case 1: W = a.in[I_ABWO]; WT = (bf16*)(ws + WS_WO0); K = D; N = D; Np = D; mode = 0; break;
            case 2: W = a.in[I_FWI]; WT = (bf16*)(ws + WS_WFI0); K = D; N = 2 * DFF; Np = 2 * DFF; mode = 1; break;
            case 3: W = a.in[I_FWO]; WT = (bf16*)(ws + WS_WFO0); K = DFF; N = D; Np = D; mode = 0; break;
            case 4: W = a.in[I_RWI]; WT = (bf16*)(ws + WS_WRI); K = D; N = RETC; Np = RETC; mode = 0; break;
            case 5: W = a.in[I_RWO]; WT = (bf16*)(ws + WS_WRO); K = 2 * D; N = D; Np = D; mode = 0; break;
            case 6: W = a.in[I_FWI] + (size_t)D * 2 * DFF; WT = (bf16*)(ws + WS_WFI1); K = D; N = 2 * DFF; Np = 2 * DFF; mode = 1; break;
            default: W = a.in[I_FWO] + (size_t)DFF * D; WT = (bf16*)(ws + WS_WFO1); K = DFF; N = D; Np = D; mode = 0; break;
        }
        const int ntn = Np / 128; k0 = (li / ntn) * 128; n0 = (li % ntn) * 128; };
    f32x4 reg[8];
    if (tid == 0) slot[0] = (int)atomicAdd(qhead, 1u);
    __syncthreads();
    int cur = slot[0];
    __syncthreads();
    if (cur < total) { decode(cur);
#pragma unroll
        for (int i = 0; i < 8; ++i) reg[i] = (n0 + lc < N) ? __builtin_nontemporal_load((const f32x4*)(W + (size_t)(k0 + lr + 16 * i) * N + n0 + lc)) : (f32x4){0.f, 0.f, 0.f, 0.f}; }
    while (cur < total) {
        const int ck0 = k0, cn0 = n0, cK = K, cmode = mode; bf16* cWT = WT;
#pragma unroll
        for (int i = 0; i < 8; ++i) *(LAS f32x4*)(scr + (lr + 16 * i) * 132 + lc) = reg[i];
        if (tid == 0) slot[0] = (int)atomicAdd(qhead, 1u);
        __syncthreads();
        const int nxt = slot[0];
        if (nxt < total) { decode(nxt);
#pragma unroll
            for (int i = 0; i < 8; ++i) reg[i] = (n0 + lc < N) ? __builtin_nontemporal_load((const f32x4*)(W + (size_t)(k0 + lr + 16 * i) * N + n0 + lc)) : (f32x4){0.f, 0.f, 0.f, 0.f}; }
        { const int c = tid & 15;
#pragma unroll
          for (int j = 0; j < 4; ++j) { const int n = (tid >> 4) + 32 * j; const LAS float* sp = scr + (8 * c) * 132 + n;
              u32x4 o; o.x = pk2(sp[0], sp[132]); o.y = pk2(sp[2 * 132], sp[3 * 132]); o.z = pk2(sp[4 * 132], sp[5 * 132]); o.w = pk2(sp[6 * 132], sp[7 * 132]);
              __builtin_nontemporal_store(o, (u32x4*)(cWT + (size_t)dst_row(cn0 + n, cmode) * cK + ck0 + 8 * c)); } }
        __syncthreads();
        cur = nxt;
    }
}
__device__ __forceinline__ void p0_prologue(const Fr& F, const Args& a) {
    unsigned char* ws = a.ws;
    conv_jobs(F, a, 0, 1, F.vcu, F.G);
    {
        bf16* WL = (bf16*)(ws + WS_WLO); const float* w2 = a.in[I_W2]; const float* a2 = a.in[I_A2]; const float* g2 = a.in[I_G2];
        for (int idx = F.vcu * NTHR + F.tid; idx < 4096 * 64; idx += F.G * NTHR) {
            const int n = idx & 4095, k0 = (idx >> 12) * 8;
            const int seg = n >> 10, c = n & 1023; float v[8];
#pragma unroll
            for (int j = 0; j < 8; ++j) { const int k = k0 + j; float x = 0.f;
                if (seg < 2) { if (k < 96) x = w2[((size_t)seg * 96 + k) * MIXA + c]; }
                else if (seg == 2) { if (k >= 128 && k < 224) x = a2[(size_t)(k - 128) * MIXA + c]; }
                else { if (k >= 256) x = g2[(size_t)(k - 256) * MIXA + c]; }
                v[j] = x; }
            *(u32x4*)(WL + (size_t)n * 512 + k0) = pack8(v);
        }
    }
    {
        float* rot = (float*)(ws + WS_ROT);
        for (int idx = F.vcu * NTHR + F.tid; idx < 4096; idx += F.G * NTHR) {
            const int pos = idx >> 6, f = idx & 63;
            const float inv = exp2f(-(float)f * (13.287712379549449f / 64.0f));
            const float rev = (float)pos * inv * 0.15915494309189535f;
            rot[2 * idx] = __builtin_amdgcn_cosf(rev); rot[2 * idx + 1] = __builtin_amdgcn_sinf(rev);
        }
    }
    {
        LAS float* sv = (LAS float*)F.lds;
        LAS float* red = sv + 3 * 2048;
        { float xs[12];
#pragma unroll
          for (int it = 0; it < 12; ++it) { const int i = F.tid + it * NTHR; const int w = it >> 2, k = i & 2047; xs[it] = (w < 2) ? a.in[I_C][w * D + k] : a.in[I_CCTX][k]; }
#pragma unroll
          for (int it = 0; it < 12; ++it) sv[F.tid + it * NTHR] = fsilu(xs[it]); }
        __syncthreads();
        float* modv = (float*)(ws + WS_MODV);
        for (int slab = F.vcu; slab < 256; slab += F.G) {
            const int l = slab >> 7, col0 = (slab & 127) * 96;
            const float* Wm = a.in[I_MODW] + (size_t)l * D * 12288;
            const int cq = F.tid % 24, kg = F.tid / 24;
            f32x4 a0 = {0, 0, 0, 0}, a1 = {0, 0, 0, 0}, a2v = {0, 0, 0, 0};
            if (kg < 21) {
#pragma unroll 1
                for (int i0 = 0; i0 < 98; i0 += 7) { f32x4 wv[7];
#pragma unroll
                    for (int j = 0; j < 7; ++j) { const int k = kg + 21 * (i0 + j), kc = k < D ? k : D - 1;
                        wv[j] = __builtin_nontemporal_load((const f32x4*)(Wm + (size_t)kc * 12288 + col0 + 4 * cq)); }
#pragma unroll
                    for (int j = 0; j < 7; ++j) { const int k = kg + 21 * (i0 + j), kc = k < D ? k : D - 1; const float z = k < D ? 1.0f : 0.0f;
                        a0 += wv[j] * (sv[kc] * z); a1 += wv[j] * (sv[2048 + kc] * z); a2v += wv[j] * (sv[4096 + kc] * z); } }
#pragma unroll
                for (int j = 0; j < 4; ++j) { red[(kg * 3 + 0) * 96 + 4 * cq + j] = a0[j]; red[(kg * 3 + 1) * 96 + 4 * cq + j] = a1[j]; red[(kg * 3 + 2) * 96 + 4 * cq + j] = a2v[j]; }
            }
            __syncthreads();
            if (F.tid < 288) { const int w = F.tid / 96, cc = F.tid % 96; float s = 0.f;
                for (int g = 0; g < 21; ++g) s += red[(g * 3 + w) * 96 + cc];
                modv[((size_t)l * 3 + w) * 12288 + col0 + cc] = s + a.in[I_MODB][l * 12288 + col0 + cc]; }
            __syncthreads();
        }
    }
}

struct Row { f32x4 v[8]; };
__device__ __forceinline__ void row_load(Row& r, const float* p, int lane) {
#pragma unroll
    for (int j = 0; j < 8; ++j) r.v[j] = *(const f32x4*)(p + 4 * lane + 256 * j);
}
__device__ __forceinline__ float row_rstd(const Row& r) {
    float s = 0.f;
#pragma unroll
    for (int j = 0; j < 8; ++j) s += (r.v[j][0] * r.v[j][0] + r.v[j][1] * r.v[j][1]) + (r.v[j][2] * r.v[j][2] + r.v[j][3] * r.v[j][3]);
    return rsqrtf(wave_sum(s) * (1.0f / D) + RMS_EPS);
}
struct RowVecs { f32x4 gy[8], an[8], sh[8]; int cached; };
template <bool CTXROW>
__device__ __forceinline__ void rows_row(const Fr& F, const Args& a, int m, int mode, int nsplit, bool hprev_is_input, const float* ngy, const float* gatev, bool fin, const float* ngn,
                                         const float* shiftv, const float* scalev, RowVecs& C) {
    unsigned char* ws = a.ws;
    bf16* H = (bf16*)(ws + WS_H); const bf16* Y = (const bf16*)(ws + WS_MIX + MX_Y); float* YC = (float*)(ws + WS_YC); bf16* ABF = (bf16*)a.out;
    const int lane = F.lane;
    const int b = m / TB, t = m % TB, which = CTXROW ? 2 : b;
    Row y; bool ysum = false;
    if (CTXROW && mode == 1 && nsplit > 0) { ysum = true;
        const float* yc = YC + ((size_t)b * CTX + t) * D;
#pragma unroll
        for (int j = 0; j < 8; ++j) y.v[j] = (f32x4){0.f, 0.f, 0.f, 0.f};
#pragma unroll 1
        for (int sp = 0; sp < nsplit; sp += 4) { Row q0, q1, q2, q3;
            row_load(q0, yc + (size_t)sp * NB * CTX * D, lane);
            if (sp + 1 < nsplit) row_load(q1, yc + (size_t)(sp + 1) * NB * CTX * D, lane);
            if (sp + 2 < nsplit) row_load(q2, yc + (size_t)(sp + 2) * NB * CTX * D, lane);
            if (sp + 3 < nsplit) row_load(q3, yc + (size_t)(sp + 3) * NB * CTX * D, lane);
#pragma unroll
            for (int j = 0; j < 8; ++j) { f32x4 acc4 = q0.v[j];
                if (sp + 1 < nsplit) acc4 += q1.v[j];
                if (sp + 2 < nsplit) acc4 += q2.v[j];
                if (sp + 3 < nsplit) acc4 += q3.v[j];
                y.v[j] += acc4; } }
    }
    if (CTXROW || which != C.cached) { C.cached = which;
        if (mode == 1) { const float* gp = gatev + (size_t)which * 12288;
#pragma unroll
            for (int j = 0; j < 8; ++j) C.gy[j] = *(const f32x4*)(gp + 4 * lane + 256 * j) * *(const f32x4*)(ngy + 4 * lane + 256 * j); }
        if (!fin) { const float* sp = shiftv + (size_t)which * 12288; const float* cp = scalev + (size_t)which * 12288;
#pragma unroll
            for (int j = 0; j < 8; ++j) { C.an[j] = *(const f32x4*)(ngn + 4 * lane + 256 * j) * (*(const f32x4*)(cp + 4 * lane + 256 * j) + 1.0f); C.sh[j] = *(const f32x4*)(sp + 4 * lane + 256 * j); } }
    }
    const float* h0 = CTXROW ? a.in[I_CTX] + ((size_t)b * CTX + t) * D : a.in[I_X] + ((size_t)b * SEQ + (t - CTX)) * D;
    Row h;
    if (mode == 0 || hprev_is_input) row_load(h, h0, lane);
    else {
#pragma unroll
        for (int j = 0; j < 8; ++j) { const u32x2 hw = *(const u32x2*)(H + (size_t)m * D + 4 * lane + 256 * j); h.v[j] = (f32x4){bflo(hw.x), bfhi(hw.x), bflo(hw.y), bfhi(hw.y)}; } }
    if (mode == 1) {
        if (!ysum) {
#pragma unroll
            for (int j = 0; j < 8; ++j) { const u32x2 yw = *(const u32x2*)(Y + (size_t)m * D + 4 * lane + 256 * j); y.v[j] = (f32x4){bflo(yw.x), bfhi(yw.x), bflo(yw.y), bfhi(yw.y)}; } }
        const float rs = row_rstd(y);
#pragma unroll
        for (int j = 0; j < 8; ++j) h.v[j] += C.gy[j] * (y.v[j] * rs);
        if (!fin) {
#pragma unroll
            for (int j = 0; j < 8; ++j) { u32x2 hw; hw.x = pk2(h.v[j][0], h.v[j][1]); hw.y = pk2(h.v[j][2], h.v[j][3]); *(u32x2*)(H + (size_t)m * D + 4 * lane + 256 * j) = hw;
                h.v[j] = (f32x4){bflo(hw.x), bfhi(hw.x), bflo(hw.y), bfhi(hw.y)}; }
        }
    }
    if (fin) {
        float* o = a.out + ((size_t)b * SEQ + (t - CTX)) * D;
#pragma unroll
        for (int j = 0; j < 8; ++j) *(f32x4*)(o + 4 * lane + 256 * j) = h.v[j];
    } else {
        const float rs = row_rstd(h);
#pragma unroll
        for (int j = 0; j < 8; ++j) { const f32x4 o = (h.v[j] * rs) * C.an[j] + C.sh[j];
            u32x2 w; w.x = pk2(o[0], o[1]); w.y = pk2(o[2], o[3]);
            *(u32x2*)(ABF + (size_t)m * D + 4 * lane + 256 * j) = w; }
    }
}
__device__ __forceinline__ void rows_phase(const Fr& F, const Args& a, int mode, int nsplit, bool hprev_is_input, const float* ngy, const float* gatev  ,
                                           bool fin, const float* ngn, const float* shiftv, const float* scalev) {
    const int gw = F.vcu * NWAVES + F.wave, NGW = F.G * NWAVES;
    RowVecs C; C.cached = -1;
    if (NGW == 2048) {
        const int grp = gw & 3, q = gw >> 2;
        int l0, ln;
        if (grp == 0) { l0 = 2 * q; ln = 2; if (!fin) rows_row<true>(F, a, (q >> 8) * TB + (q & 255), mode, nsplit, hprev_is_input, ngy, gatev, fin, ngn, shiftv, scalev, C); }
        else if (grp == 3) { l0 = 6144 + 4 * q; ln = 4; }
        else { l0 = 1024 + 5 * (2 * q + (grp - 1)); ln = 5; }
        for (int i = 0; i < ln; ++i) { const int li = l0 + i; rows_row<false>(F, a, (li >> 12) * TB + CTX + (li & 4095), mode, nsplit, hprev_is_input, ngy, gatev, fin, ngn, shiftv, scalev, C); }
    } else {
        if (!fin) { for (int m = gw; m < M; m += NGW) { if ((m % TB) < CTX) rows_row<true>(F, a, m, mode, nsplit, hprev_is_input, ngy, gatev, fin, ngn, shiftv, scalev, C); } }
        for (int m = gw; m < M; m += NGW) { if ((m % TB) >= CTX) rows_row<false>(F, a, m, mode, nsplit, hprev_is_input, ngy, gatev, fin, ngn, shiftv, scalev, C); }
    }
}

__device__ __forceinline__ void load16s(const bf16* p, bool ok, float (&o)[16]) {
    if (ok) { float t[8]; unpack8(*(const u32x4*)p, t);
#pragma unroll
        for (int i = 0; i < 8; ++i) o[i] = t[i];
        unpack8(*(const u32x4*)(p + 8), t);
#pragma unroll
        for (int i = 0; i < 8; ++i) o[8 + i] = t[i];
    } else {
#pragma unroll
        for (int i = 0; i < 16; ++i) o[i] = 0.f;
    }
}
struct Raw16 { u32x4 a, b; };
__device__ __forceinline__ Raw16 ld16raw(const bf16* p, bool ok) { Raw16 r; const u32x4 z = {0u, 0u, 0u, 0u}; r.a = ok ? *(const u32x4*)p : z; r.b = ok ? *(const u32x4*)(p + 8) : z; return r; }
__device__ __forceinline__ void unpack16(const Raw16& r, float (&o)[16]) { float t[8]; unpack8(r.a, t);
#pragma unroll
    for (int i = 0; i < 8; ++i) o[i] = t[i];
    unpack8(r.b, t);
#pragma unroll
    for (int i = 0; i < 8; ++i) o[8 + i] = t[i]; }
__device__ __forceinline__ void store16(bf16* p, const float (&v)[16]) {
    float t[8];
#pragma unroll
    for (int i = 0; i < 8; ++i) t[i] = v[i];
    *(u32x4*)p = pack8(t);
#pragma unroll
    for (int i = 0; i < 8; ++i) t[i] = v[8 + i];
    *(u32x4*)(p + 8) = pack8(t);
}
__device__ __forceinline__ void prep_phase(const Fr& F, const Args& a) {
    unsigned char* ws = a.ws;
    const bf16* Z = (const bf16*)(ws + WS_ZR);
    bf16* R = (bf16*)(ws + WS_MIX + MX_R); bf16* V = (bf16*)(ws + WS_MIX + MX_V); bf16* Kr = (bf16*)(ws + WS_MIX + MX_K); bf16* KK = (bf16*)(ws + WS_MIX + MX_KK);
    bf16* AL = (bf16*)(ws + WS_MIX + MX_ALO);
    const float* mu = a.in[I_MU]; const float* k_k = a.in[I_KK];
    const int gw = F.wave * F.G + F.vcu, NGW = F.G * NWAVES, lane = F.lane;
    for (int m = gw; m < M; m += NGW) {
        const int t = m % TB;
        const bool hp = (t != 0) && (t != CTX), hn = (t != CTX - 1) && (t != TB - 1);
        const bf16* z = Z + (size_t)m * ZLD0; const bf16* zp = z - ZLD0; const bf16* zn = z + ZLD0;
        Raw16 rc[3], rl[3], rr[3];
#pragma unroll
        for (int sec = 0; sec < 3; ++sec) { const int c0 = sec * MIXA + 16 * lane; rc[sec] = ld16raw(z + c0, true); rl[sec] = ld16raw(zp + c0, hp); rr[sec] = ld16raw(zn + c0, hn); }
        const u32x4 zero4 = {0u, 0u, 0u, 0u};
        const int lcol = 3072 + 8 * (lane < 56 ? lane : 0);
        const u32x4 lc = *(const u32x4*)(z + lcol), ll = hp ? *(const u32x4*)(zp + lcol) : zero4, lr = hn ? *(const u32x4*)(zn + lcol) : zero4;
#pragma unroll
        for (int sec = 0; sec < 3; ++sec) {
            const int c0 = sec * MIXA + 16 * lane;
            float zc[16], zl[16], zr[16], o[16];
            unpack16(rc[sec], zc); unpack16(rl[sec], zl); unpack16(rr[sec], zr);
#pragma unroll
            for (int q = 0; q < 4; ++q) { const f32x4 mv = *(const f32x4*)(mu + c0 + 4 * q);
#pragma unroll
                for (int i = 0; i < 4; ++i) { const int e = 4 * q + i; o[e] = zc[e] + (0.5f * (zl[e] + zr[e]) - zc[e]) * mv[i]; } }
            if (sec == 0) store16(R + (size_t)m * MIXA + 16 * lane, o);
            else if (sec == 2) store16(V + (size_t)m * MIXA + 16 * lane, o);
            else {
                store16(Kr + (size_t)m * MIXA + 16 * lane, o);
                float kq[16]; float ss = 0.f;
#pragma unroll
                for (int q = 0; q < 4; ++q) { const f32x4 kv = *(const f32x4*)(k_k + 16 * lane + 4 * q);
#pragma unroll
                    for (int i = 0; i < 4; ++i) { const int e = 4 * q + i; kq[e] = o[e] * kv[i]; ss += kq[e] * kq[e]; } }
                ss = quad_sum(ss);
                const float inv = 1.0f / fmaxf(sqrtf(ss), 1e-12f);
#pragma unroll
                for (int e = 0; e < 16; ++e) kq[e] *= inv;
                store16(KK + (size_t)m * MIXA + 16 * lane, kq);
            }
        }
        bf16* al = AL + (size_t)m * 512;
        if (lane < 56) {
            float c8[8], l8[8], r8[8], v[8]; unpack8(lc, c8); unpack8(ll, l8); unpack8(lr, r8);
            const f32x4 m0 = *(const f32x4*)(mu + lcol), m1 = *(const f32x4*)(mu + lcol + 4);
#pragma unroll
            for (int e = 0; e < 8; ++e) { const float x = c8[e] + (0.5f * (l8[e] + r8[e]) - c8[e]) * (e < 4 ? m0[e & 3] : m1[e & 3]);
                v[e] = lane < 12 ? tanhf(x) : (lane < 24 ? x : fsigmoid(x)); }
            bf16* dst = lane < 12 ? al + 8 * lane : (lane < 24 ? al + 128 + 8 * (lane - 12) : al + 256 + 8 * (lane - 24));
            *(u32x4*)dst = pack8(v);
        } else { bf16* dst = lane < 60 ? al + 96 + 8 * (lane - 56) : al + 224 + 8 * (lane - 60); *(u32x4*)dst = zero4; }
    }
}

template <int KS>
__device__ __forceinline__ void mma16(f32x4& acc, const LAS bf16* A, int lda, int arow, const LAS bf16* Bt, int ldb, int brow, int lane) {
    const LAS bf16* ap = A + (size_t)(arow + (lane & 15)) * lda + 8 * (lane >> 4);
    const LAS bf16* bp = Bt + (size_t)(brow + (lane & 15)) * ldb + 8 * (lane >> 4);
#pragma unroll
    for (int ks = 0; ks < KS; ++ks) {
        const bf16x8 av = *(const LAS bf16x8*)(ap + ks * 32), bv = *(const LAS bf16x8*)(bp + ks * 32);
        acc = __builtin_amdgcn_mfma_f32_16x16x32_bf16(av, bv, acc, 0, 0, 0);
    }
}
template <int LD>
__device__ __forceinline__ void tr_frags64(const LAS bf16* T, int col0, int lane, bf16x8& f0, bf16x8& f1) {
    const unsigned addr = (unsigned)(size_t)(T + (8 * (lane >> 4) + ((lane & 15) >> 2)) * LD + col0 + 4 * (lane & 3));
    u32x2 a0, a1, a2, a3;
    asm volatile("ds_read_b64_tr_b16 %0, %4\n\tds_read_b64_tr_b16 %1, %4 offset:%5\n\tds_read_b64_tr_b16 %2, %4 offset:%6\n\tds_read_b64_tr_b16 %3, %4 offset:%7\n\ts_waitcnt lgkmcnt(0)\n\ts_nop 1"
                 : "=&v"(a0), "=&v"(a1), "=&v"(a2), "=&v"(a3) : "v"(addr), "i"(4 * LD * 2), "i"(32 * LD * 2), "i"(36 * LD * 2) : "memory");
    const u32x4 w0 = {a0.x, a0.y, a1.x, a1.y}, w1 = {a2.x, a2.y, a3.x, a3.y};
    f0 = __builtin_bit_cast(bf16x8, w0); f1 = __builtin_bit_cast(bf16x8, w1);
}
template <int LD>
__device__ __forceinline__ void tr_frags64x2(const LAS bf16* T0, int c0, const LAS bf16* T1, int c1, int lane, bf16x8 (&f)[2][2]) {
    const int ro = (8 * (lane >> 4) + ((lane & 15) >> 2)) * LD + 4 * (lane & 3);
    const unsigned a0 = (unsigned)(size_t)(T0 + ro + c0), a1 = (unsigned)(size_t)(T1 + ro + c1);
    u32x2 r[8];
    asm volatile("ds_read_b64_tr_b16 %0, %8\n\tds_read_b64_tr_b16 %1, %8 offset:%10\n\tds_read_b64_tr_b16 %2, %8 offset:%11\n\tds_read_b64_tr_b16 %3, %8 offset:%12\n\t"
                 "ds_read_b64_tr_b16 %4, %9\n\tds_read_b64_tr_b16 %5, %9 offset:%10\n\tds_read_b64_tr_b16 %6, %9 offset:%11\n\tds_read_b64_tr_b16 %7, %9 offset:%12\n\ts_waitcnt lgkmcnt(0)\n\ts_nop 1"
                 : "=&v"(r[0]), "=&v"(r[1]), "=&v"(r[2]), "=&v"(r[3]), "=&v"(r[4]), "=&v"(r[5]), "=&v"(r[6]), "=&v"(r[7])
                 : "v"(a0), "v"(a1), "i"(4 * LD * 2), "i"(32 * LD * 2), "i"(36 * LD * 2) : "memory");
#pragma unroll
    for (int i = 0; i < 2; ++i) { const u32x4 w0 = {r[4 * i].x, r[4 * i].y, r[4 * i + 1].x, r[4 * i + 1].y}, w1 = {r[4 * i + 2].x, r[4 * i + 2].y, r[4 * i + 3].x, r[4 * i + 3].y};
        f[i][0] = __builtin_bit_cast(bf16x8, w0); f[i][1] = __builtin_bit_cast(bf16x8, w1); }
}
template <int LD>
__device__ __forceinline__ void tr_frags64x4(const LAS bf16* T0, int c0, const LAS bf16* T1, int c1, const LAS bf16* T2, int c2, const LAS bf16* T3, int c3, int lane, bf16x8 (&f)[4][2]) {
    const int ro = (8 * (lane >> 4) + ((lane & 15) >> 2)) * LD + 4 * (lane & 3);
    const unsigned a0 = (unsigned)(size_t)(T0 + ro + c0), a1 = (unsigned)(size_t)(T1 + ro + c1), a2 = (unsigned)(size_t)(T2 + ro + c2), a3 = (unsigned)(size_t)(T3 + ro + c3);
    u32x2 r[16];
    asm volatile("ds_read_b64_tr_b16 %0, %16\n\tds_read_b64_tr_b16 %1, %16 offset:%20\n\tds_read_b64_tr_b16 %2, %16 offset:%21\n\tds_read_b64_tr_b16 %3, %16 offset:%22\n\t"
                 "ds_read_b64_tr_b16 %4, %17\n\tds_read_b64_tr_b16 %5, %17 offset:%20\n\tds_read_b64_tr_b16 %6, %17 offset:%21\n\tds_read_b64_tr_b16 %7, %17 offset:%22\n\t"
                 "ds_read_b64_tr_b16 %8, %18\n\tds_read_b64_tr_b16 %9, %18 offset:%20\n\tds_read_b64_tr_b16 %10, %18 offset:%21\n\tds_read_b64_tr_b16 %11, %18 offset:%22\n\t"
                 "ds_read_b64_tr_b16 %12, %19\n\tds_read_b64_tr_b16 %13, %19 offset:%20\n\tds_read_b64_tr_b16 %14, %19 offset:%21\n\tds_read_b64_tr_b16 %15, %19 offset:%22\n\ts_waitcnt lgkmcnt(0)\n\ts_nop 1"
                 : "=&v"(r[0]), "=&v"(r[1]), "=&v"(r[2]), "=&v"(r[3]), "=&v"(r[4]), "=&v"(r[5]), "=&v"(r[6]), "=&v"(r[7]),
                   "=&v"(r[8]), "=&v"(r[9]), "=&v"(r[10]), "=&v"(r[11]), "=&v"(r[12]), "=&v"(r[13]), "=&v"(r[14]), "=&v"(r[15])
                 : "v"(a0), "v"(a1), "v"(a2), "v"(a3), "i"(4 * LD * 2), "i"(32 * LD * 2), "i"(36 * LD * 2) : "memory");
#pragma unroll
    for (int i = 0; i < 4; ++i) { const u32x4 w0 = {r[4 * i].x, r[4 * i].y, r[4 * i + 1].x, r[4 * i + 1].y}, w1 = {r[4 * i + 2].x, r[4 * i + 2].y, r[4 * i + 3].x, r[4 * i + 3].y};
        f[i][0] = __builtin_bit_cast(bf16x8, w0); f[i][1] = __builtin_bit_cast(bf16x8, w1); }
}
__device__ __forceinline__ int chunk_tok(int d, int ci, int p) { const int uc = (d == 0) ? ci : (ci < 4 ? 3 - ci : 71 - ci); return (d == 0) ? uc * 64 + p : uc * 64 + 63 - p; }
__device__ __forceinline__ float dpp_allreduce4(float x) {
    x += __int_as_float(__builtin_amdgcn_update_dpp(0, __float_as_int(x), 0xB1, 0xF, 0xF, false));
    x += __int_as_float(__builtin_amdgcn_update_dpp(0, __float_as_int(x), 0x4E, 0xF, 0xF, false));
    return x;
}
__device__ __forceinline__ float quad_bcast(float v, int src) {
    const int iv = __float_as_int(v);
    const int r = src == 0 ? __builtin_amdgcn_update_dpp(0, iv, 0x00, 0xF, 0xF, false) : src == 1 ? __builtin_amdgcn_update_dpp(0, iv, 0x55, 0xF, 0xF, false)
                : src == 2 ? __builtin_amdgcn_update_dpp(0, iv, 0xAA, 0xF, 0xF, false) : __builtin_amdgcn_update_dpp(0, iv, 0xFF, 0xF, 0xF, false);
    return __int_as_float(r);
}
__device__ __forceinline__ void rwkv_pre_phase(const Fr& F, const Args& a, int wgi, int nWG) {
    unsigned char* ws = a.ws;
    const bf16* R = (const bf16*)(ws + WS_MIX + MX_R); const bf16* V = (const bf16*)(ws + WS_MIX + MX_V); const bf16* Km = (const bf16*)(ws + WS_MIX + MX_K);
    const bf16* KK = (const bf16*)(ws + WS_MIX + MX_KK); const bf16* BV = (const bf16*)(ws + WS_MIX + MX_BV);
    constexpr int LT = 72;
    LAS bf16* AT = (LAS bf16*)F.lds; LAS bf16* BT = AT + 64 * LT; LAS bf16* KT = BT + 64 * LT; LAS bf16* RT = KT + 64 * LT; LAS bf16* VM = RT + 64 * LT;
    LAS float* ATF = (LAS float*)(VM + 64 * LT); LAS float* LAB = ATF + 4096;
    LAS bf16* LKA = (LAS bf16*)(LAB + 64 * 68); LAS bf16* LBR = LKA + 64 * LT; LAS bf16* LKR = LBR + 64 * LT;
    LAS float* RHZ = (LAS float*)(LKR + 64 * LT);
    LAS bf16* XI = (LAS bf16*)(RHZ + 4096); LAS bf16* ZI = XI + 64 * LT;
    LAS float* WC = (LAS float*)(ZI + 64 * LT);
    LAS float* LW = RHZ; LAS float* SEG = (LAS float*)XI;
    const int tid = F.tid, lane = F.lane, w = F.wave;
    u32x4 nrr = {0, 0, 0, 0}, nkr = nrr, nvr = nrr, nar = nrr, nbr = nrr; f32x4 nlw0 = {0.f, 0.f, 0.f, 0.f}, nlw1 = nlw0;
    auto issue_loads = [&](int it2) {
        const int d_ = it2 / (int)RW_ITEMS, it_ = it2 % (int)RW_ITEMS, bh_ = it_ / (TB / 64), ci_ = it_ % (TB / 64);
        const size_t off = ((size_t)(bh_ >> 4) * TB + chunk_tok(d_, ci_, tid >> 3)) * MIXA + (bh_ & 15) * 64 + (tid & 7) * 8;
        const float* lwd = (const float*)(ws + WS_MIX + MX_DEC) + (size_t)d_ * M * MIXA;
        nrr = *(const u32x4*)(R + off); nkr = *(const u32x4*)(Km + off); nvr = *(const u32x4*)(V + off); nar = *(const u32x4*)(KK + off); nbr = *(const u32x4*)(BV + off);
        nlw0 = *(const f32x4*)(lwd + off); nlw1 = *(const f32x4*)(lwd + off + 4);
    };
    if (wgi < 2 * (int)RW_ITEMS) issue_loads(wgi);
    for (int item2 = wgi; item2 < 2 * (int)RW_ITEMS; item2 += nWG) {
        const int d = item2 / (int)RW_ITEMS, item = item2 % (int)RW_ITEMS;
        unsigned char* ob = d ? (ws + WS_H) : (ws + WS_RWG);
        bf16* GO = (bf16*)ob; bf16* PO = (bf16*)(ob + RW_ITEMS * 8192); bf16* YO = (bf16*)(ob + 2 * RW_ITEMS * 8192); bf16* QO = (bf16*)(ob + 3 * RW_ITEMS * 8192);
        const int bh = item / (TB / 64), ci = item % (TB / 64), b = bh >> 4, h = bh & 15;
        const size_t rowb = (size_t)b * TB;
        const int p = tid >> 3, c8 = (tid & 7) * 8;
        const u32x4 rr = nrr, kr = nkr, vr = nvr, ar = nar, br = nbr; const f32x4 lw0 = nlw0, lw1 = nlw1;
        if (item2 + nWG < 2 * (int)RW_ITEMS) issue_loads(item2 + nWG);
        *(LAS f32x4*)(LW + p * 64 + c8) = lw0; *(LAS f32x4*)(LW + p * 64 + c8 + 4) = lw1;
        __syncthreads();
        {
            const int col = tid & 63, seg = tid >> 6; float pf[8];
#pragma unroll
            for (int q = 0; q < 8; ++q) pf[q] = LW[(8 * seg + q) * 64 + col];
#pragma unroll
            for (int q = 1; q < 8; ++q) pf[q] += pf[q - 1];
            SEG[seg * 64 + col] = pf[7];
            __syncthreads();
            float offs = 0.f;
#pragma unroll
            for (int s2 = 0; s2 < 7; ++s2) { const float sv = SEG[s2 * 64 + col]; offs += (s2 < seg) ? sv : 0.f; }
#pragma unroll
            for (int q = 0; q < 8; ++q) LW[(8 * seg + q) * 64 + col] = pf[q] + offs;
        }
        __syncthreads();
        {
            const f32x4 c0 = *(const LAS f32x4*)(LW + p * 64 + c8), c1 = *(const LAS f32x4*)(LW + p * 64 + c8 + 4);
            float r8[8], k8[8], a8[8], b8[8], at[8];
            unpack8(rr, r8); unpack8(kr, k8); unpack8(ar, a8); unpack8(br, b8);
#pragma unroll
            for (int i = 0; i < 8; ++i) { const float cum = i < 4 ? c0[i & 3] : c1[i & 3], lwr = i < 4 ? lw0[i & 3] : lw1[i & 3];
                const float Wt = fexp(cum), iWt = fexp(-cum), Wp = fexp(cum - lwr);
                at[i] = -a8[i] * Wp; b8[i] *= iWt; k8[i] *= iWt; r8[i] *= Wt;
                if (p == 63) WC[c8 + i] = Wt; }
            *(LAS u32x4*)(AT + p * LT + c8) = pack8(at); *(LAS u32x4*)(BT + p * LT + c8) = pack8(b8); *(LAS u32x4*)(KT + p * LT + c8) = pack8(k8); *(LAS u32x4*)(RT + p * LT + c8) = pack8(r8);
            *(LAS u32x4*)(VM + p * LT + c8) = vr;
        }
        __syncthreads();
        {
            const int g = w >> 1; const LAS bf16* Am = (g < 2) ? AT : RT; const LAS bf16* Bm = (g & 1) ? KT : BT;
            bf16x8 bfr[4][2];
#pragma unroll
            for (int nt = 0; nt < 4; ++nt) { const LAS bf16* bp = Bm + (size_t)(16 * nt + (lane & 15)) * LT + 8 * (lane >> 4); bfr[nt][0] = *(const LAS bf16x8*)bp; bfr[nt][1] = *(const LAS bf16x8*)(bp + 32); }
#pragma unroll
            for (int e2 = 0; e2 < 2; ++e2) { const int mt = (w & 1) * 2 + e2;
                const LAS bf16* ap = Am + (size_t)(16 * mt + (lane & 15)) * LT + 8 * (lane >> 4); const bf16x8 a0 = *(const LAS bf16x8*)ap, a1 = *(const LAS bf16x8*)(ap + 32);
#pragma unroll
                for (int nt = 0; nt < 4; ++nt) { f32x4 acc = {0.f, 0.f, 0.f, 0.f};
                    if (nt <= mt) { acc = __builtin_amdgcn_mfma_f32_16x16x32_bf16(a0, bfr[nt][0], acc, 0, 0, 0); acc = __builtin_amdgcn_mfma_f32_16x16x32_bf16(a1, bfr[nt][1], acc, 0, 0, 0); }
#pragma unroll
                    for (int r = 0; r < 4; ++r) { const int t = 16 * mt + 4 * (lane >> 4) + r, i = 16 * nt + (lane & 15);
                        const bool keep = (g < 2) ? (i < t) : (i <= t); const float val = keep ? acc[r] : 0.f;
                        if (g == 0) LAB[i * 68 + (t & 3) * 16 + (t >> 2)] = val;
                        else { LAS bf16* dst = (g == 1) ? LKA : (g == 2 ? LBR : LKR); dst[t * LT + i] = f2bf(val); } } } }
        }
        __syncthreads();
        LAS bf16* TI = (LAS bf16*)ATF;
        LAS bf16* RZ = (LAS bf16*)RHZ;
        if (w < 4) {
            const int col = w * 16 + (lane >> 2), part = lane & 3;
            f32x2 x[8];
#pragma unroll
            for (int j = 0; j < 8; ++j) { x[j][0] = (8 * j + part == col) ? 1.f : 0.f; x[j][1] = (8 * j + 4 + part == col) ? 1.f : 0.f; }
#pragma unroll
            for (int t = 0; t < 64; ++t) {
                const float xs = quad_bcast(x[t >> 3][(t >> 2) & 1], t & 3); const f32x2 xv = {xs, xs};
#pragma unroll
                for (int j4 = (t >> 4); j4 < 4; ++j4) { const f32x4 l = *(const LAS f32x4*)(LAB + t * 68 + part * 16 + 4 * j4);
                    x[2 * j4] += (f32x2){l[0], l[1]} * xv; x[2 * j4 + 1] += (f32x2){l[2], l[3]} * xv; }
            }
#pragma unroll
            for (int j = 0; j < 8; ++j) { TI[(8 * j + part) * LT + col] = f2bf(x[j][0]); TI[(8 * j + 4 + part) * LT + col] = f2bf(x[j][1]); }
        } else {
            const int w4 = w - 4;
            bf16x8 vf0, vf1; tr_frags64<LT>(VM, 16 * w4, lane, vf0, vf1);
#pragma unroll
            for (int nt = 0; nt < 4; ++nt) { f32x4 acc = {0.f, 0.f, 0.f, 0.f};
                const LAS bf16* bp = LKA + (size_t)(16 * nt + (lane & 15)) * LT + 8 * (lane >> 4);
                acc = __builtin_amdgcn_mfma_f32_16x16x32_bf16(vf0, *(const LAS bf16x8*)bp, acc, 0, 0, 0);
                acc = __builtin_amdgcn_mfma_f32_16x16x32_bf16(vf1, *(const LAS bf16x8*)(bp + 32), acc, 0, 0, 0);
                u32x2 o; o.x = pk2(acc[0], acc[1]); o.y = pk2(acc[2], acc[3]);
                *(LAS u32x2*)(RZ + (16 * nt + (lane & 15)) * LT + 16 * w4 + 4 * (lane >> 4)) = o; }
        }
        __syncthreads();
        {
            const LAS bf16* src = (w < 4) ? AT : RZ; LAS bf16* dst = (w < 4) ? XI : ZI; const int ct = w & 3;
            bf16x8 af0, af1; tr_frags64<LT>(src, 16 * ct, lane, af0, af1);
#pragma unroll
            for (int nt = 0; nt < 4; ++nt) { f32x4 acc = {0.f, 0.f, 0.f, 0.f};
                const LAS bf16* bp = TI + (size_t)(16 * nt + (lane & 15)) * LT + 8 * (lane >> 4);
                acc = __builtin_amdgcn_mfma_f32_16x16x32_bf16(af0, *(const LAS bf16x8*)bp, acc, 0, 0, 0);
                acc = __builtin_amdgcn_mfma_f32_16x16x32_bf16(af1, *(const LAS bf16x8*)(bp + 32), acc, 0, 0, 0);
                u32x2 o; o.x = pk2(acc[0], acc[1]); o.y = pk2(acc[2], acc[3]);
                *(LAS u32x2*)(dst + (16 * nt + (lane & 15)) * LT + 16 * ct + 4 * (lane >> 4)) = o; }
        }
        __syncthreads();
        {
            const int mq = w >> 1; const size_t ib = (size_t)item * 4096;
#pragma unroll
            for (int e2 = 0; e2 < 2; ++e2) { const int mt = (w & 1) * 2 + e2; const int rr0 = 16 * mt + 4 * (lane >> 4);
                if (mq == 0) {
                    bf16x8 xf0, xf1; tr_frags64<LT>(XI, 16 * mt, lane, xf0, xf1);
#pragma unroll
                    for (int nt = 0; nt < 4; ++nt) { const int cc = 16 * nt + (lane & 15); f32x4 acc = {0.f, 0.f, 0.f, 0.f};
                        const LAS bf16* bp = LBR + (size_t)cc * LT + 8 * (lane >> 4);
                        acc = __builtin_amdgcn_mfma_f32_16x16x32_bf16(xf0, *(const LAS bf16x8*)bp, acc, 0, 0, 0);
                        acc = __builtin_amdgcn_mfma_f32_16x16x32_bf16(xf1, *(const LAS bf16x8*)(bp + 32), acc, 0, 0, 0);
                        const u32x2 rw = *(const LAS u32x2*)(RT + cc * LT + rr0);
                        u32x2 o; o.x = pk2(acc[0] + bflo(rw.x), acc[1] + bfhi(rw.x)); o.y = pk2(acc[2] + bflo(rw.y), acc[3] + bfhi(rw.y));
                        *(u32x2*)(GO + ib + (size_t)cc * 64 + rr0) = o; }
                } else if (mq == 1) {
                    bf16x8 f[2][2]; tr_frags64x2<LT>(ZI, 16 * mt, VM, 16 * mt, lane, f);
#pragma unroll
                    for (int nt = 0; nt < 4; ++nt) { const int cc = 16 * nt + (lane & 15); f32x4 acc = {0.f, 0.f, 0.f, 0.f};
                        const LAS bf16* bp = LBR + (size_t)cc * LT + 8 * (lane >> 4); const LAS bf16* cp = LKR + (size_t)cc * LT + 8 * (lane >> 4);
                        acc = __builtin_amdgcn_mfma_f32_16x16x32_bf16(f[0][0], *(const LAS bf16x8*)bp, acc, 0, 0, 0);
                        acc = __builtin_amdgcn_mfma_f32_16x16x32_bf16(f[0][1], *(const LAS bf16x8*)(bp + 32), acc, 0, 0, 0);
                        acc = __builtin_amdgcn_mfma_f32_16x16x32_bf16(f[1][0], *(const LAS bf16x8*)cp, acc, 0, 0, 0);
                        acc = __builtin_amdgcn_mfma_f32_16x16x32_bf16(f[1][1], *(const LAS bf16x8*)(cp + 32), acc, 0, 0, 0);
                        u32x2 o; o.x = pk2(acc[0], acc[1]); o.y = pk2(acc[2], acc[3]);
                        *(u32x2*)(YO + ib + (size_t)cc * 64 + rr0) = o; }
                } else if (mq == 2) {
                    bf16x8 xf0, xf1; tr_frags64<LT>(XI, 16 * mt, lane, xf0, xf1);
                    bf16x8 g[4][2]; tr_frags64x4<LT>(BT, 0, BT, 16, BT, 32, BT, 48, lane, g);
#pragma unroll
                    for (int nt = 0; nt < 4; ++nt) { const int cc = 16 * nt + (lane & 15); f32x4 acc = {0.f, 0.f, 0.f, 0.f};
                        acc = __builtin_amdgcn_mfma_f32_16x16x32_bf16(xf0, g[nt][0], acc, 0, 0, 0);
                        acc = __builtin_amdgcn_mfma_f32_16x16x32_bf16(xf1, g[nt][1], acc, 0, 0, 0);
                        const float wc = WC[cc];
                        u32x2 o; o.x = pk2(wc * (acc[0] + (rr0 == cc ? 1.f : 0.f)), wc * (acc[1] + (rr0 + 1 == cc ? 1.f : 0.f)));
                        o.y = pk2(wc * (acc[2] + (rr0 + 2 == cc ? 1.f : 0.f)), wc * (acc[3] + (rr0 + 3 == cc ? 1.f : 0.f)));
                        *(u32x2*)(PO + ib + (size_t)cc * 64 + rr0) = o; }
                } else {
                    bf16x8 fa[2][2]; tr_frags64x2<LT>(BT, 16 * mt, KT, 16 * mt, lane, fa);
                    bf16x8 gz[4][2], gv[4][2]; tr_frags64x4<LT>(ZI, 0, ZI, 16, ZI, 32, ZI, 48, lane, gz); tr_frags64x4<LT>(VM, 0, VM, 16, VM, 32, VM, 48, lane, gv);
                    const f32x4 wc = *(const LAS f32x4*)(WC + rr0);
#pragma unroll
                    for (int nt = 0; nt < 4; ++nt) { const int cc = 16 * nt + (lane & 15); f32x4 acc = {0.f, 0.f, 0.f, 0.f};
                        acc = __builtin_amdgcn_mfma_f32_16x16x32_bf16(fa[0][0], gz[nt][0], acc, 0, 0, 0);
                        acc = __builtin_amdgcn_mfma_f32_16x16x32_bf16(fa[0][1], gz[nt][1], acc, 0, 0, 0);
                        acc = __builtin_amdgcn_mfma_f32_16x16x32_bf16(fa[1][0], gv[nt][0], acc, 0, 0, 0);
                        acc = __builtin_amdgcn_mfma_f32_16x16x32_bf16(fa[1][1], gv[nt][1], acc, 0, 0, 0);
                        u32x2 o; o.x = pk2(wc[0] * acc[0], wc[1] * acc[1]); o.y = pk2(wc[2] * acc[2], wc[3] * acc[3]);
                        *(u32x2*)(QO + ib + (size_t)cc * 64 + rr0) = o; }
                }
            }
        }
        __syncthreads();
    }
}
__device__ __forceinline__ void rwkv_seq_phase(const Fr& F, const Args& a, int wgi, int nWG) {
    unsigned char* ws = a.ws;
    constexpr int LT = 72, SLOT = 32768, RING0 = 2 * 64 * LT * 2;
    LAS bf16* SH = (LAS bf16*)F.lds; LAS bf16* SL = SH + 64 * LT;
    LAS unsigned char* ring = F.lds + RING0;
    const int tid = F.tid, lane = F.lane, w = F.wave, fr = lane & 15, fq = lane >> 4;
    for (int ch = wgi; ch < 2 * NB * 16; ch += nWG) {
        const int d = ch >> 5, bh = ch & 31, b = bh >> 4, h = bh & 15; const size_t rowb = (size_t)b * TB;
        const unsigned char* ob = d ? (ws + WS_H) : (ws + WS_RWG);
        bf16* YA = (bf16*)(ws + WS_MIX + MX_YA) + (size_t)d * M * MIXA;
        for (int i = tid; i < 2 * 64 * LT / 2; i += NTHR) ((LAS unsigned*)SH)[i] = 0u;
        const unsigned srcoff = (unsigned)((tid >> 3) * 128 + (((tid & 7) ^ ((tid >> 3) & 7)) * 16));
        auto issue = [&](int ci_) { const int ci = ci_ < TB / 64 ? ci_ : TB / 64 - 1;
            const unsigned char* src = ob + ((size_t)bh * (TB / 64) + ci) * 8192 + srcoff; LAS unsigned char* dst = ring + (ci_ & 3) * SLOT + w * 1024;
#pragma unroll
            for (int j = 0; j < 4; ++j)
                __builtin_amdgcn_global_load_lds((const unsigned*)(src + (size_t)j * RW_ITEMS * 8192), (LAS unsigned*)(dst + j * 8192), 16, 0, 0); };
        issue(0); issue(1); issue(2);
        asm volatile("s_waitcnt lgkmcnt(0)" ::: "memory");
        for (int ci = 0; ci < TB / 64; ++ci) {
            if (ci < 2) asm volatile("s_waitcnt vmcnt(8)" ::: "memory"); else asm volatile("s_waitcnt vmcnt(12)" ::: "memory");
            __builtin_amdgcn_s_barrier();
            asm volatile("" ::: "memory");
            issue(ci + 3);
            const LAS unsigned char* slot = ring + (ci & 3) * SLOT;
            f32x4 sn[2];
#pragma unroll
            for (int e = 0; e < 2; ++e) { const int tile = 2 * w + e, mt = tile >> 2, nt = tile & 3;
                const int rt = 16 * nt + fr, rk = 16 * mt + fr;
                const LAS unsigned char* gr = slot + rt * 128; const LAS unsigned char* pr = slot + 8192 + rk * 128;
                const bf16x8 g0 = *(const LAS bf16x8*)(gr + (((fq) ^ (rt & 7)) * 16)), g1 = *(const LAS bf16x8*)(gr + (((fq + 4) ^ (rt & 7)) * 16));
                const bf16x8 p0 = *(const LAS bf16x8*)(pr + (((fq) ^ (rk & 7)) * 16)), p1 = *(const LAS bf16x8*)(pr + (((fq + 4) ^ (rk & 7)) * 16));
                const int cpos = ((2 * mt + (fq >> 1)) ^ (rt & 7)) * 16 + (fq & 1) * 8;
                const u32x2 yl = *(const LAS u32x2*)(slot + 16384 + rt * 128 + cpos), ql = *(const LAS u32x2*)(slot + 24576 + rt * 128 + cpos);
                f32x4 acc = {bflo(yl.x), bfhi(yl.x), bflo(yl.y), bfhi(yl.y)};
                const LAS bf16* sh = SH + (size_t)(16 * mt + fr) * LT + 8 * fq; const LAS bf16* sl = SL + (size_t)(16 * mt + fr) * LT + 8 * fq;
                acc = __builtin_amdgcn_mfma_f32_16x16x32_bf16(*(const LAS bf16x8*)sh, g0, acc, 0, 0, 0);
                acc = __builtin_amdgcn_mfma_f32_16x16x32_bf16(*(const LAS bf16x8*)(sh + 32), g1, acc, 0, 0, 0);
                acc = __builtin_amdgcn_mfma_f32_16x16x32_bf16(*(const LAS bf16x8*)sl, g0, acc, 0, 0, 0);
                acc = __builtin_amdgcn_mfma_f32_16x16x32_bf16(*(const LAS bf16x8*)(sl + 32), g1, acc, 0, 0, 0);
                u32x2 o; o.x = pk2(acc[0], acc[1]); o.y = pk2(acc[2], acc[3]);
                *(u32x2*)(YA + (rowb + chunk_tok(d, ci, rt)) * MIXA + h * 64 + 16 * mt + 4 * fq) = o;
                f32x4 s2 = {bflo(ql.x), bfhi(ql.x), bflo(ql.y), bfhi(ql.y)};
                const LAS bf16* th = SH + (size_t)(16 * nt + fr) * LT + 8 * fq; const LAS bf16* tl = SL + (size_t)(16 * nt + fr) * LT + 8 * fq;
                s2 = __builtin_amdgcn_mfma_f32_16x16x32_bf16(p0, *(const LAS bf16x8*)th, s2, 0, 0, 0);
                s2 = __builtin_amdgcn_mfma_f32_16x16x32_bf16(p1, *(const LAS bf16x8*)(th + 32), s2, 0, 0, 0);
                s2 = __builtin_amdgcn_mfma_f32_16x16x32_bf16(p0, *(const LAS bf16x8*)tl, s2, 0, 0, 0);
                s2 = __builtin_amdgcn_mfma_f32_16x16x32_bf16(p1, *(const LAS bf16x8*)(tl + 32), s2, 0, 0, 0);
                sn[e] = s2; }
            asm volatile("s_waitcnt lgkmcnt(0)" ::: "memory");
            __builtin_amdgcn_s_barrier();
            asm volatile("" ::: "memory");
#pragma unroll
            for (int e = 0; e < 2; ++e) { const int tile = 2 * w + e, mt = tile >> 2, nt = tile & 3;
                u32x2 hi; hi.x = pk2(sn[e][0], sn[e][1]); hi.y = pk2(sn[e][2], sn[e][3]);
                u32x2 lo; lo.x = pk2(sn[e][0] - bflo(hi.x), sn[e][1] - bfhi(hi.x)); lo.y = pk2(sn[e][2] - bflo(hi.y), sn[e][3] - bfhi(hi.y));
                *(LAS u32x2*)(SH + (size_t)(16 * nt + fr) * LT + 16 * mt + 4 * fq) = hi; *(LAS u32x2*)(SL + (size_t)(16 * nt + fr) * LT + 16 * mt + 4 * fq) = lo; }
            asm volatile("s_waitcnt lgkmcnt(0)" ::: "memory");
        }
        asm volatile("s_waitcnt vmcnt(0)" ::: "memory");
        __builtin_amdgcn_s_barrier();
        asm volatile("" ::: "memory");
    }
}

__device__ __forceinline__ void gla_pre_phase(const Fr& F, const Args& a, int wgi, int nWG) {
    unsigned char* ws = a.ws;
    const bf16* Z = (const bf16*)(ws + WS_ZR); bf16* YB = (bf16*)(ws + WS_MIX + MX_YB);
    bf16* GQI = (bf16*)((unsigned char*)a.out + DO_GQI); bf16* GKI = (bf16*)(ws + WS_GKI); float* GDL = (float*)(ws + WS_GDL);
    const float* gk_up = a.in[I_GKUP]; const float* gk_b = a.in[I_GKB];
    constexpr int DK = 128, LQ = DK + 24, LV = 256 + 8, LT = 72;
    LAS bf16* QIN = (LAS bf16*)F.lds; LAS bf16* KIN = QIN + 64 * LQ; LAS bf16* VI = KIN + 64 * LQ; LAS bf16* ATT = VI + 64 * LV;
    LAS float* BC = (LAS float*)(ATT + 64 * LT); LAS float* QS = BC + 64 * DK; LAS float* GD = QS + 4 * DK;
    const int tid = F.tid, lane = F.lane, w = F.wave;
    const float qscale = 0.08838834764831845f;
    for (int item = wgi; item < (int)GLA_ITEMS; item += nWG) {
        const int ci = item % (TB / 64), d = (item / (TB / 64)) & 1, h = (item / (2 * (TB / 64))) & 3, b = item / (8 * (TB / 64));
        const size_t rowb = (size_t)b * TB;
        const int col = tid & (DK - 1);
        float gku[16];
#pragma unroll
        for (int j = 0; j < 16; ++j) gku[j] = gk_up[((size_t)d * 16 + j) * 512 + h * DK + col];
        const float gkb = gk_b[d * 512 + h * DK + col];
        u32x4 qreg[2], kreg[2], vreg[4], gdreg = {0, 0, 0, 0};
#pragma unroll
        for (int it = 0; it < 2; ++it) { const int idx = tid + it * NTHR; const int p = idx >> 4, kc = (idx & 15) * 8; const bf16* zr = Z + (rowb + chunk_tok(d, ci, p)) * ZLD0;
            qreg[it] = *(const u32x4*)(zr + GQ + h * DK + kc); kreg[it] = *(const u32x4*)(zr + GK + h * DK + kc); }
#pragma unroll
        for (int it = 0; it < 4; ++it) { const int idx = tid + it * NTHR; const int p = idx >> 5, vc = (idx & 31) * 8;
            vreg[it] = *(const u32x4*)(Z + (rowb + chunk_tok(d, ci, p)) * ZLD0 + GV + h * 256 + vc); }
        if (tid < 128) { const int p = tid >> 1, hf = tid & 1; gdreg = *(const u32x4*)(Z + (rowb + chunk_tok(d, ci, p)) * ZLD0 + GGD + 8 * hf); }
        if (tid < 128) { const int p = tid >> 1, hf = tid & 1; float t8[8]; unpack8(gdreg, t8);
            *(LAS f32x4*)(GD + p * 16 + 8 * hf) = (f32x4){t8[0], t8[1], t8[2], t8[3]}; *(LAS f32x4*)(GD + p * 16 + 8 * hf + 4) = (f32x4){t8[4], t8[5], t8[6], t8[7]}; }
        __syncthreads();
        {
            const int qq = tid / DK; float bc[16];
#pragma unroll
            for (int pp = 0; pp < 16; ++pp) { const int p = 16 * qq + pp; float x = gkb;
                const f32x4 g0 = *(const LAS f32x4*)(GD + p * 16), g1 = *(const LAS f32x4*)(GD + p * 16 + 4), g2 = *(const LAS f32x4*)(GD + p * 16 + 8), g3 = *(const LAS f32x4*)(GD + p * 16 + 12);
#pragma unroll
                for (int j = 0; j < 4; ++j) { x += g0[j] * gku[j]; x += g1[j] * gku[4 + j]; x += g2[j] * gku[8 + j]; x += g3[j] * gku[12 + j]; }
                bc[pp] = flogsigmoid(x) * (1.0f / 16.0f); }
#pragma unroll
            for (int pp = 1; pp < 16; ++pp) bc[pp] += bc[pp - 1];
            QS[qq * DK + col] = bc[15];
            __syncthreads();
            float offs = 0.f;
#pragma unroll
            for (int q2 = 0; q2 < 3; ++q2) { const float sv = QS[q2 * DK + col]; offs += (q2 < qq) ? sv : 0.f; }
#pragma unroll
            for (int pp = 0; pp < 16; ++pp) BC[(16 * qq + pp) * DK + col] = bc[pp] + offs;
        }
        __syncthreads();
#pragma unroll
        for (int it = 0; it < 2; ++it) { const int idx = tid + it * NTHR; const int p = idx >> 4, kc = (idx & 15) * 8;
            float q8[8], k8[8]; unpack8(qreg[it], q8); unpack8(kreg[it], k8);
            const f32x4 b0 = *(const LAS f32x4*)(BC + p * DK + kc), b1 = *(const LAS f32x4*)(BC + p * DK + kc + 4);
#pragma unroll
            for (int i = 0; i < 8; ++i) { const float bc = i < 4 ? b0[i & 3] : b1[i & 3]; q8[i] *= fexp(bc) * qscale; k8[i] *= fexp(-bc); }
            const u32x4 qw = pack8(q8), kw = pack8(k8);
            *(LAS u32x4*)(QIN + p * LQ + kc) = qw; *(LAS u32x4*)(KIN + p * LQ + kc) = kw;
            *(u32x4*)(GQI + (size_t)item * 8192 + p * DK + kc) = qw; *(u32x4*)(GKI + (size_t)item * 8192 + p * DK + kc) = kw; }
#pragma unroll
        for (int it = 0; it < 4; ++it) { const int idx = tid + it * NTHR; const int p = idx >> 5, vc = (idx & 31) * 8; *(LAS u32x4*)(VI + p * LV + vc) = vreg[it]; }
        if (tid < DK) GDL[(size_t)item * DK + tid] = fexp(BC[63 * DK + tid]);
        __syncthreads();
        { const int mt = w >> 1;
#pragma unroll
          for (int e = 0; e < 2; ++e) { const int nt = (w & 1) * 2 + e; f32x4 acc = {0.f, 0.f, 0.f, 0.f};
              if (nt <= mt) mma16<DK / 32>(acc, QIN, LQ, 16 * mt, KIN, LQ, 16 * nt, lane);
#pragma unroll
              for (int r = 0; r < 4; ++r) { const int i = 16 * mt + 4 * (lane >> 4) + r, j = 16 * nt + (lane & 15);
                  ATT[i * LT + j] = f2bf(j <= i ? acc[r] : 0.f); } } }
        __syncthreads();
        { bf16x8 af[4][2];
#pragma unroll
          for (int mt = 0; mt < 4; ++mt) { const LAS bf16* ap = ATT + (size_t)(16 * mt + (lane & 15)) * LT + 8 * (lane >> 4); af[mt][0] = *(const LAS bf16x8*)ap; af[mt][1] = *(const LAS bf16x8*)(ap + 32); }
          bf16x8 vf[2][2]; tr_frags64x2<LV>(VI, 32 * w, VI, 32 * w + 16, lane, vf);
          bf16* yb = YB + (size_t)d * M * MIXA;
#pragma unroll
          for (int e = 0; e < 2; ++e)
#pragma unroll
              for (int mt = 0; mt < 4; ++mt) { f32x4 acc = {0.f, 0.f, 0.f, 0.f};
                  acc = __builtin_amdgcn_mfma_f32_16x16x32_bf16(vf[e][0], af[mt][0], acc, 0, 0, 0);
                  acc = __builtin_amdgcn_mfma_f32_16x16x32_bf16(vf[e][1], af[mt][1], acc, 0, 0, 0);
                  u32x2 o; o.x = pk2(acc[0], acc[1]); o.y = pk2(acc[2], acc[3]);
                  *(u32x2*)(yb + (rowb + chunk_tok(d, ci, 16 * mt + (lane & 15))) * MIXA + h * 256 + 32 * w + 16 * e + 4 * (lane >> 4)) = o; } }
        __syncthreads();
    }
}
__device__ __forceinline__ void gla_seq_phase(const Fr& F, const Args& a, int wgi, int nWG) {
    unsigned char* ws = a.ws;
    const bf16* Z = (const bf16*)(ws + WS_ZR); bf16* OC2 = (bf16*)(ws + WS_MIX + MX_DEC);
    const bf16* GQI = (const bf16*)((const unsigned char*)a.out + DO_GQI); const bf16* GKI = (const bf16*)(ws + WS_GKI); const float* GDL = (const float*)(ws + WS_GDL);
    constexpr int DK = 128, LQ = DK + 24, SLOT = 37888, RING0 = 32 * LQ * 2;
    LAS bf16* ST = (LAS bf16*)F.lds; LAS unsigned char* ring = F.lds + RING0;
    static_assert(RING0 % 16 == 0 && RING0 + 4 * SLOT <= LDS_BYTES - 16, "GLA recurrence LDS map");
    const int tid = F.tid, lane = F.lane, w = F.wave, fr = lane & 15, fq = lane >> 4;
    for (int unit = wgi; unit < 128; unit += nWG) {
        const int vs = unit & 7, d = (unit >> 3) & 1, h = (unit >> 4) & 3, b = unit >> 6;
        const size_t rowb = (size_t)b * TB; const size_t it0 = (size_t)((b * 4 + h) * 2 + d) * (TB / 64);
        bf16* oc = OC2 + (size_t)d * M * MIXA;
        f32x4 S[2] = {{0.f, 0.f, 0.f, 0.f}, {0.f, 0.f, 0.f, 0.f}};
        const int vt = w >> 2, nt = w & 3;
        auto issue = [&](int ci_) { const int ci = ci_ < TB / 64 ? ci_ : TB / 64 - 1; const size_t ib = (it0 + ci) * 8192;
            LAS unsigned char* dst = ring + (ci_ & 3) * SLOT;
#pragma unroll
            for (int j = 0; j < 2; ++j) { const int lin = j * 8192 + tid * 16; const int r = lin >> 8, pp = (lin >> 4) & 15; const int sp = pp ^ (r & 7);
                __builtin_amdgcn_global_load_lds((const unsigned*)((const unsigned char*)GKI + ib * 2 + r * 256 + sp * 16), (LAS unsigned*)(dst + j * 8192 + w * 1024), 16, 0, 0);
                __builtin_amdgcn_global_load_lds((const unsigned*)((const unsigned char*)GQI + ib * 2 + r * 256 + sp * 16), (LAS unsigned*)(dst + 16384 + j * 8192 + w * 1024), 16, 0, 0); }
            { const int t2 = tid & 255; const int r = t2 >> 2, pc = t2 & 3;
              __builtin_amdgcn_global_load_lds((const unsigned*)(Z + (rowb + chunk_tok(d, ci, r)) * ZLD0 + GV + h * 256 + vs * 32 + pc * 8), (LAS unsigned*)(dst + 32768 + (w & 3) * 1024), 16, 0, 0); }
            { const int t3 = lane & 31;
              __builtin_amdgcn_global_load_lds((const unsigned*)(GDL + (it0 + ci) * DK + t3 * 4), (LAS unsigned*)(dst + 36864), 16, 0, 0); }
        };
        issue(0); issue(1); issue(2);
#pragma unroll
        for (int e = 0; e < 2; ++e) *(LAS u32x2*)(ST + (16 * e + fr) * LQ + 16 * w + 4 * fq) = (u32x2){0u, 0u};
        asm volatile("s_waitcnt lgkmcnt(0)" ::: "memory");
        for (int ci = 0; ci < TB / 64; ++ci) {
            asm volatile("s_waitcnt vmcnt(12)" ::: "memory");
            __builtin_amdgcn_s_barrier();
            asm volatile("" ::: "memory");
            issue(ci + 3);
            const LAS unsigned char* slot = ring + (ci & 3) * SLOT;
            { f32x4 acc = {0.f, 0.f, 0.f, 0.f};
              const LAS bf16* sp = ST + (size_t)(16 * vt + fr) * LQ + 8 * fq; const int rt = 16 * nt + fr; const LAS unsigned char* qr = slot + 16384 + rt * 256;
#pragma unroll
              for (int ks = 0; ks < 4; ++ks) acc = __builtin_amdgcn_mfma_f32_16x16x32_bf16(*(const LAS bf16x8*)(sp + 32 * ks), *(const LAS bf16x8*)(qr + (((fq + 4 * ks) ^ (rt & 7)) * 16)), acc, 0, 0, 0);
              u32x2 o; o.x = pk2(acc[0], acc[1]); o.y = pk2(acc[2], acc[3]);
              *(u32x2*)(oc + (rowb + chunk_tok(d, ci, rt)) * MIXA + h * 256 + vs * 32 + 16 * vt + 4 * fq) = o; }
            { const int g = lane >> 4, q = (lane & 15) >> 2, pq = lane & 3;
              const LAS unsigned char* kb = slot + (8 * g + q) * 256 + (pq & 1) * 8; const int pc = 2 * w + (pq >> 1);
              const unsigned ka0 = (unsigned)(size_t)(kb + ((pc ^ q) * 16)), ka1 = (unsigned)(size_t)(kb + 4 * 256 + ((pc ^ (q + 4)) * 16));
              u32x2 r0, r1, r2, r3;
              asm volatile("ds_read_b64_tr_b16 %0, %4\n\tds_read_b64_tr_b16 %1, %5\n\tds_read_b64_tr_b16 %2, %4 offset:8192\n\tds_read_b64_tr_b16 %3, %5 offset:8192\n\ts_waitcnt lgkmcnt(0)\n\ts_nop 1"
                           : "=&v"(r0), "=&v"(r1), "=&v"(r2), "=&v"(r3) : "v"(ka0), "v"(ka1) : "memory");
              const u32x4 k0w = {r0.x, r0.y, r1.x, r1.y}, k1w = {r2.x, r2.y, r3.x, r3.y};
              const bf16x8 kf0 = __builtin_bit_cast(bf16x8, k0w), kf1 = __builtin_bit_cast(bf16x8, k1w);
              bf16x8 f[2][2]; tr_frags64x2<32>((const LAS bf16*)(slot + 32768), 0, (const LAS bf16*)(slot + 32768), 16, lane, f);
              const f32x4 dl = *(const LAS f32x4*)(slot + 36864 + (16 * w + 4 * fq) * 4);
#pragma unroll
              for (int e = 0; e < 2; ++e) {
                  S[e] = __builtin_amdgcn_mfma_f32_16x16x32_bf16(kf0, f[e][0], S[e], 0, 0, 0);
                  S[e] = __builtin_amdgcn_mfma_f32_16x16x32_bf16(kf1, f[e][1], S[e], 0, 0, 0);
                  S[e] = S[e] * dl; } }
            asm volatile("s_waitcnt lgkmcnt(0)" ::: "memory");
            __builtin_amdgcn_s_barrier();
            asm volatile("" ::: "memory");
#pragma unroll
            for (int e = 0; e < 2; ++e) { u32x2 pw; pw.x = pk2(S[e][0], S[e][1]); pw.y = pk2(S[e][2], S[e][3]);
                *(LAS u32x2*)(ST + (16 * e + fr) * LQ + 16 * w + 4 * fq) = pw; }
            asm volatile("s_waitcnt lgkmcnt(0)" ::: "memory");
        }
        asm volatile("s_waitcnt vmcnt(0)" ::: "memory");
        __builtin_amdgcn_s_barrier();
        asm volatile("" ::: "memory");
    }
}

__device__ __forceinline__ void ret_intra_phase(const Fr& F, const bf16* Z, bf16* OI) {
    constexpr int LQ = 256 + 24, LV = 512 + 8, LT = 72;
    LAS bf16* QI = (LAS bf16*)F.lds; LAS bf16* KI = QI + 64 * LQ; LAS bf16* VI = KI + 64 * LQ; LAS bf16* ATT = VI + 64 * LV;
    const int tid = F.tid, lane = F.lane, w = F.wave;
    u32x4 pq[4], pk[4], pv[8];
    auto fetch = [&](int item) { const int uc = 4 + (item & 63), h = (item >> 6) & 7, b = item >> 9; const size_t row0 = (size_t)b * TB + uc * 64;
#pragma unroll
        for (int it = 0; it < 4; ++it) { const int idx = tid + it * NTHR; const int p = idx >> 5, kc = (idx & 31) * 8; const bf16* zr = Z + (row0 + p) * RETC + h * 256 + kc;
            pq[it] = *(const u32x4*)(zr); pk[it] = *(const u32x4*)(zr + D); }
#pragma unroll
        for (int it = 0; it < 8; ++it) { const int idx = tid + it * NTHR; const int p = idx >> 6, vc = (idx & 63) * 8;
            pv[it] = *(const u32x4*)(Z + (row0 + p) * RETC + 2 * D + h * 512 + vc); } };
    if (F.vcu < NB * 8 * 64) fetch(F.vcu);
    for (int item = F.vcu; item < NB * 8 * 64; item += F.G) {
        const int uc = 4 + (item & 63), h = (item >> 6) & 7, b = item >> 9;
        const size_t row0 = (size_t)b * TB + uc * 64;
        const float l2g = log1pf(-exp2f(-5.0f - (float)h)) * 1.4426950408889634f;
#pragma unroll
        for (int it = 0; it < 4; ++it) { const int idx = tid + it * NTHR; const int p = idx >> 5, kc = (idx & 31) * 8;
            *(LAS u32x4*)(QI + p * LQ + kc) = pq[it]; *(LAS u32x4*)(KI + p * LQ + kc) = pk[it]; }
#pragma unroll
        for (int it = 0; it < 8; ++it) { const int idx = tid + it * NTHR; const int p = idx >> 6, vc = (idx & 63) * 8;
            *(LAS u32x4*)(VI + p * LV + vc) = pv[it]; }
        __syncthreads();
        if (item + F.G < NB * 8 * 64) fetch(item + F.G);
        { const int mt = w >> 1;
#pragma unroll
          for (int e = 0; e < 2; ++e) { const int nt = (w & 1) * 2 + e; f32x4 acc = {0.f, 0.f, 0.f, 0.f};
              mma16<8>(acc, QI, LQ, 16 * mt, KI, LQ, 16 * nt, lane);
#pragma unroll
              for (int r = 0; r < 4; ++r) { const int i = 16 * mt + 4 * (lane >> 4) + r, j = 16 * nt + (lane & 15); const int dd = i > j ? i - j : j - i;
                  ATT[i * LT + j] = f2bf(acc[r] * (dd == 0 ? 2.0f : __builtin_amdgcn_exp2f((float)dd * l2g))); } } }
        __syncthreads();
        {
            bf16x8 af[4][2];
#pragma unroll
            for (int mt = 0; mt < 4; ++mt) { const LAS bf16* ap = ATT + (size_t)(16 * mt + (lane & 15)) * LT + 8 * (lane >> 4); af[mt][0] = *(const LAS bf16x8*)ap; af[mt][1] = *(const LAS bf16x8*)(ap + 32); }
#pragma unroll
            for (int vt = 0; vt < 4; ++vt) { bf16x8 vf0, vf1; tr_frags64<LV>(VI, 64 * w + 16 * vt, lane, vf0, vf1);
#pragma unroll
                for (int mt = 0; mt < 4; ++mt) { f32x4 acc = {0.f, 0.f, 0.f, 0.f};
                    acc = __builtin_amdgcn_mfma_f32_16x16x32_bf16(vf0, af[mt][0], acc, 0, 0, 0);
                    acc = __builtin_amdgcn_mfma_f32_16x16x32_bf16(vf1, af[mt][1], acc, 0, 0, 0);
                    u32x2 o; o.x = pk2(acc[0], acc[1]); o.y = pk2(acc[2], acc[3]);
                    *(u32x2*)(OI + (row0 + 16 * mt + (lane & 15)) * 4096 + h * 512 + 64 * w + 16 * vt + 4 * (lane >> 4)) = o; } }
        }
        __syncthreads();
    }
}
__device__ __forceinline__ void ret_scan_phase(const Fr& F, const bf16* Z, bf16* OUT) {
    constexpr int LQ = 256 + 24, LV = 64 + 8;
    LAS bf16* QI = (LAS bf16*)F.lds; LAS bf16* KI = QI + 64 * LQ; LAS bf16* ST = KI + 2 * 64 * LQ; LAS bf16* VI = ST + 64 * LQ;
    static_assert((4 * 64 * LQ + 2 * 64 * LV) * 2 <= LDS_BYTES - 16, "retention scan LDS map");
    const int tid = F.tid, lane = F.lane, w = F.wave;
    for (int unit = F.vcu; unit < NB * 8 * 2 * 8; unit += F.G) {
        const int vs = unit & 7, d = (unit >> 3) & 1, h = (unit >> 4) & 7, b = unit >> 7;
        const size_t rowb = (size_t)b * TB;
        bf16* out = OUT + (size_t)d * M * 4096;
        const float l2g = log1pf(-exp2f(-5.0f - (float)h)) * 1.4426950408889634f;
        const float g64 = __builtin_amdgcn_exp2f(64.0f * l2g);
        const float vsc = __builtin_amdgcn_exp2f((float)(63 - (tid >> 3)) * l2g);
        f32x4 S[2][4];
#pragma unroll
        for (int i = 0; i < 2; ++i)
#pragma unroll
            for (int j = 0; j < 4; ++j) S[i][j] = (f32x4){0.f, 0.f, 0.f, 0.f};
        struct Pre { u32x4 q[4], k[4], v; };
        Pre PA, PB;
        auto tok_of = [&](int ci, int p) { const int uc = (d == 0) ? ci : (ci < 4 ? 3 - ci : 71 - ci); return (d == 0) ? uc * 64 + p : uc * 64 + 63 - p; };
        auto prefetch = [&](int ci_, Pre& P) { const int ci = ci_ < TB / 64 ? ci_ : TB / 64 - 1;
#pragma unroll
            for (int it = 0; it < 4; ++it) { const int idx = tid + it * NTHR; const int p = idx >> 5, kc = (idx & 31) * 8; const bf16* zr = Z + (rowb + tok_of(ci, p)) * RETC + h * 256 + kc;
                P.q[it] = *(const u32x4*)(zr); P.k[it] = *(const u32x4*)(zr + D); }
            { const int p = tid >> 3, vc = (tid & 7) * 8; P.v = *(const u32x4*)(Z + (rowb + tok_of(ci, p)) * RETC + 2 * D + h * 512 + vs * 64 + vc); }
        };
        auto stage_kv = [&](int buf, const Pre& P) {
            LAS bf16* KB = KI + buf * (64 * LQ); LAS bf16* VB = VI + buf * (64 * LV);
#pragma unroll
            for (int it = 0; it < 4; ++it) { const int idx = tid + it * NTHR; const int p = idx >> 5, kc = (idx & 31) * 8; *(LAS u32x4*)(KB + p * LQ + kc) = P.k[it]; }
            { const int p = tid >> 3, vc = (tid & 7) * 8; float v8[8]; unpack8(P.v, v8);
#pragma unroll
              for (int i = 0; i < 8; ++i) v8[i] *= vsc;
              *(LAS u32x4*)(VB + p * LV + vc) = pack8(v8); } };
        auto step = [&](int ci, Pre& P, Pre& Pn) {
            const bool do_out = ci >= 4; const int buf = ci & 1;
            const LAS bf16* KB = KI + buf * (64 * LQ); const LAS bf16* VB = VI + buf * (64 * LV);
            if (do_out) {
#pragma unroll
                for (int it = 0; it < 4; ++it) { const int idx = tid + it * NTHR; const int p = idx >> 5, kc = (idx & 31) * 8; *(LAS u32x4*)(QI + p * LQ + kc) = P.q[it]; } }
#pragma unroll
            for (int ki = 0; ki < 2; ++ki)
#pragma unroll
                for (int vt = 0; vt < 4; ++vt) { u32x2 pw; pw.x = pk2(S[ki][vt][0], S[ki][vt][1]); pw.y = pk2(S[ki][vt][2], S[ki][vt][3]);
                    *(LAS u32x2*)(ST + (16 * vt + (lane & 15)) * LQ + 16 * (2 * w + ki) + 4 * (lane >> 4)) = pw; }
            __syncthreads();
            prefetch(ci + 2, P);
            __builtin_amdgcn_s_waitcnt(0xF79);
            stage_kv(buf ^ 1, Pn);
            if (do_out) {
                const int vt = w >> 1;
#pragma unroll
                for (int e = 0; e < 2; ++e) { const int nt = 2 * (w & 1) + e; f32x4 acc = {0.f, 0.f, 0.f, 0.f};
                    mma16<8>(acc, ST, LQ, 16 * vt, QI, LQ, 16 * nt, lane);
                    const int p = 16 * nt + (lane & 15); const float sc = __builtin_amdgcn_exp2f((float)(p + 1) * l2g);
                    u32x2 o; o.x = pk2(acc[0] * sc, acc[1] * sc); o.y = pk2(acc[2] * sc, acc[3] * sc);
                    *(u32x2*)(out + (rowb + tok_of(ci, p)) * 4096 + h * 512 + vs * 64 + 16 * vt + 4 * (lane >> 4)) = o; }
            }
            {
                bf16x8 vf[4][2]; tr_frags64x4<LV>(VB, 0, VB, 16, VB, 32, VB, 48, lane, vf);
                bf16x8 kf[2][2]; tr_frags64x2<LQ>(KB, 16 * (2 * w), KB, 16 * (2 * w + 1), lane, kf);
#pragma unroll
                for (int ki = 0; ki < 2; ++ki) {
#pragma unroll
                    for (int vt = 0; vt < 4; ++vt) {
#pragma unroll
                        for (int r = 0; r < 4; ++r) S[ki][vt][r] *= g64;
                        S[ki][vt] = __builtin_amdgcn_mfma_f32_16x16x32_bf16(kf[ki][0], vf[vt][0], S[ki][vt], 0, 0, 0);
                        S[ki][vt] = __builtin_amdgcn_mfma_f32_16x16x32_bf16(kf[ki][1], vf[vt][1], S[ki][vt], 0, 0, 0); } }
            }
            __syncthreads();
        };
        prefetch(0, PA); prefetch(1, PB);
        __builtin_amdgcn_s_waitcnt(0xF79);
        stage_kv(0, PA);
        static_assert((TB / 64) % 2 == 0, "the chunk loop is unrolled by two");
#pragma unroll 1
        for (int ci = 0; ci < TB / 64; ci += 2) { step(ci, PA, PB); step(ci + 1, PB, PA); }
        __builtin_amdgcn_s_waitcnt(0xF70);
    }
}

__device__ __forceinline__ void finish0_phase(const Fr& F, const Args& a) {
    unsigned char* ws = a.ws;
    const bf16* Z = (const bf16*)(ws + WS_ZR);
    const bf16* R = (const bf16*)(ws + WS_MIX + MX_R); const bf16* V = (const bf16*)(ws + WS_MIX + MX_V); const bf16* Km = (const bf16*)(ws + WS_MIX + MX_K); const bf16* Gg = (const bf16*)(ws + WS_MIX + MX_G);
    const bf16* YA = (const bf16*)(ws + WS_MIX + MX_YA); const bf16* YB = (const bf16*)(ws + WS_MIX + MX_YB); const bf16* OC2 = (const bf16*)(ws + WS_MIX + MX_DEC);
    bf16* A2 = (bf16*)a.out;
    const float* rk = a.in[I_RK]; const float* lnw = a.in[I_LNW]; const float* lnb = a.in[I_LNB]; const float* glag = a.in[I_GLAG];
    const int gw = F.wave * F.G + F.vcu, NGW = F.G * NWAVES, lane = F.lane;
    for (int m = gw; m < M; m += NGW) {
        const size_t ro = (size_t)m * MIXA + 16 * lane;
        const Raw16 qy0 = ld16raw(YA + ro, true), qy1 = ld16raw(YA + (size_t)M * MIXA + ro, true), qr = ld16raw(R + ro, true), qk = ld16raw(Km + ro, true), qv = ld16raw(V + ro, true), qg = ld16raw(Gg + ro, true);
        const Raw16 pb0 = ld16raw(YB + ro, true), pb1 = ld16raw(YB + (size_t)M * MIXA + ro, true), pgt = ld16raw(Z + (size_t)m * ZLD0 + GR + 16 * lane, true), pc0 = ld16raw(OC2 + ro, true), pc1 = ld16raw(OC2 + (size_t)M * MIXA + ro, true);
        {
            float y0[16], y1[16], y[16], r[16], k[16], v[16], g[16], o[16];
            unpack16(qy0, y0); unpack16(qy1, y1); unpack16(qr, r); unpack16(qk, k); unpack16(qv, v); unpack16(qg, g);
            float s = 0.f, bs = 0.f;
#pragma unroll
            for (int q = 0; q < 4; ++q) { const f32x4 rkv = *(const f32x4*)(rk + 16 * lane + 4 * q);
#pragma unroll
                for (int i = 0; i < 4; ++i) { const int e = 4 * q + i; y[e] = y0[e] + y1[e]; s += y[e]; bs += r[e] * k[e] * rkv[i]; } }
            s = quad_sum(s); bs = quad_sum(bs);
            const float mean = s * (1.0f / 64.0f); float q2 = 0.f;
#pragma unroll
            for (int e = 0; e < 16; ++e) { const float dd = y[e] - mean; q2 += dd * dd; }
            q2 = quad_sum(q2);
            const float rstd = rsqrtf(q2 * (1.0f / 64.0f) + GN_EPS);
#pragma unroll
            for (int q = 0; q < 4; ++q) { const f32x4 lw = *(const f32x4*)(lnw + 16 * lane + 4 * q), lb = *(const f32x4*)(lnb + 16 * lane + 4 * q);
#pragma unroll
                for (int i = 0; i < 4; ++i) { const int e = 4 * q + i; o[e] = ((y[e] - mean) * rstd * lw[i] + lb[i] + bs * v[e]) * g[e]; } }
            store16(A2 + (size_t)m * D + 16 * lane, o);
        }
        {
            float y0[16], y1[16], y[16], gt[16], o[16];
            unpack16(pb0, y0); unpack16(pb1, y1); unpack16(pgt, gt);
            float c0[16], c1[16]; unpack16(pc0, c0); unpack16(pc1, c1);
            float s = 0.f;
#pragma unroll
            for (int e = 0; e < 16; ++e) { y[e] = (y0[e] + y1[e]) + (c0[e] + c1[e]); s += y[e] * y[e]; }
            s = row16_sum(s);
            const float rstd = rsqrtf(s * (1.0f / 256.0f) + RMS_EPS);
#pragma unroll
            for (int q = 0; q < 4; ++q) { const f32x4 gg = *(const f32x4*)(glag + ((16 * lane) & 255) + 4 * q);
#pragma unroll
                for (int i = 0; i < 4; ++i) { const int e = 4 * q + i; o[e] = y[e] * rstd * gg[i] * fsilu(gt[e]); } }
            store16(A2 + (size_t)m * D + MIXA + 16 * lane, o);
        }
    }
}
__device__ __forceinline__ void finish1_phase(const Fr& F, const Args& a) {
    unsigned char* ws = a.ws;
    const bf16* Z = (const bf16*)(ws + WS_ZR); const bf16* OC = (const bf16*)(ws + WS_MIX + MX_OC); bf16* A3 = (bf16*)(ws + WS_MIX + MX_A3);
    const int gw = F.vcu * NWAVES + F.wave, NGW = F.G * NWAVES, lane = F.lane;
    for (int m = gw; m < M; m += NGW) {
        if ((m % TB) < CTX) continue;
#pragma unroll
        for (int hb = 0; hb < 2; ++hb) {
            u32x4 q0[4], q1[4], q2[4], qg[4];
#pragma unroll
            for (int j = 0; j < 4; ++j) { const int h = 4 * hb + j; const size_t off = (size_t)m * 4096 + h * 512 + 8 * lane;
                q0[j] = *(const u32x4*)(OC + off); q1[j] = *(const u32x4*)(OC + (size_t)M * 4096 + off); q2[j] = *(const u32x4*)(A3 + off);
                qg[j] = *(const u32x4*)(Z + (size_t)m * RETC + 8192 + h * 512 + 8 * lane); }
#pragma unroll
            for (int j = 0; j < 4; ++j) { const int h = 4 * hb + j; const size_t off = (size_t)m * 4096 + h * 512 + 8 * lane;
                float o0[8], o1[8], o2[8], g[8], o[8];
                unpack8(q0[j], o0); unpack8(q1[j], o1); unpack8(q2[j], o2); unpack8(qg[j], g);
                float s = 0.f;
#pragma unroll
                for (int e = 0; e < 8; ++e) { o[e] = (o0[e] + o1[e]) + o2[e]; s += o[e] * o[e]; }
                const float rstd = rsqrtf(wave_sum(s) * (1.0f / 512.0f) + RMS_EPS);
#pragma unroll
                for (int e = 0; e < 8; ++e) o[e] = o[e] * rstd * fsilu(g[e]);
                *(u32x4*)(A3 + off) = pack8(o); }
        }
    }
}

constexpr int N_PHASES = 23;
__global__ void __launch_bounds__(NTHR, 2) mega(Args a) {
    extern __shared__ __attribute__((aligned(16))) unsigned char lds_raw[];
    Fr F; F.lds = (LAS unsigned char*)lds_raw; F.tid = threadIdx.x; F.lane = F.tid & 63; F.wave = __builtin_amdgcn_readfirstlane(F.tid >> 6);
    F.G = gridDim.x; { const int bx = blockIdx.x; F.vcu = (F.G % 8 == 0) ? (bx % 8) * (F.G / 8) + bx / 8 : bx; }
    const int wave0 = F.wave;
#define REFRAME() do { const int _l = lane_id_opaque(); int _w = wave0; asm volatile("" : "+s"(_w)); F.lane = _l; F.wave = _w; F.tid = _w * 64 + _l; } while (0)
    unsigned char* ws = a.ws;
    const int lo = a.ph_lo, hi = a.ph_hi;
#if MK_ONE_LAUNCH
    volatile LAS unsigned* bst = (volatile LAS unsigned*)(F.lds + LDS_BYTES - 16);
    if (F.tid < 4) bst[F.tid] = 0u;
    __syncthreads();
    XcdBarrier bar = xcd_barrier_post((unsigned*)(ws + WS_CTL) + 4096, bst);
#define GRID_BAR() xcd_barrier(bar)
#else
#define GRID_BAR() do { } while (0)
#endif
#define IN(k) (lo <= (k) && (k) < hi)
#if MK_ONE_LAUNCH
#define SEAM(k) do { if (IN(k) && IN((k) + 1)) { GRID_BAR(); } } while (0)
#else
#define SEAM(k) do { } while (0)
#endif
    const float* modv = (const float*)(ws + WS_MODV);
    const float* ng = a.in[I_NG];
    bf16* ABF = (bf16*)a.out;
    const int bx = blockIdx.x;

    if (IN(0)) { REFRAME(); p0_prologue(F, a); } SEAM(0);
    if (IN(1)) { REFRAME(); rows_phase(F, a, 0, 0, true, nullptr, nullptr, false, ng + 0 * D, modv + 0 * D, modv + 1 * D); } SEAM(1);
    if (IN(2)) { REFRAME(); pg8::Gemm g{ABF, (const bf16*)(ws + WS_WAB), D, D, D}; pg8::StaticOrder S; S.init(M / 256, ZLD0 / 256, F.G, bx, 0, D / 64);
        pg8::EpiBf16 E{(bf16*)(ws + WS_ZR), ZLD0, 0}; pg8::gemm_phase(F.lds, g, S, E, F.tid);
        REFRAME(); __syncthreads(); conv_dyn(F, a, (unsigned*)(ws + WS_CTL) + 2048, 1, 3); } SEAM(2);
    if (IN(3)) { REFRAME(); prep_phase(F, a); } SEAM(3);
    if (IN(4)) { REFRAME();
        pg8::Gemm g{(const bf16*)(ws + WS_MIX + MX_ALO), (const bf16*)(ws + WS_WLO), 512, 512, 256};
        { pg8::StaticOrder S; S.init(M / 256, 8, F.G, bx, 0, 4, 0, 0); pg8::EpiDec E{(float*)(ws + WS_MIX + MX_DEC), a.in[I_W0]}; pg8::gemm_phase(F.lds, g, S, E, F.tid); }
        REFRAME();
        { pg8::StaticOrder S; S.init(M / 256, 4, F.G, (bx + 16) % F.G, 0, 4, 8, 0);
          pg8::EpiLr E{(bf16*)(ws + WS_MIX + MX_K), (const bf16*)(ws + WS_MIX + MX_KK), (bf16*)(ws + WS_MIX + MX_BV), a.in[I_A0], a.in[I_KA]}; pg8::gemm_phase(F.lds, g, S, E, F.tid); }
        REFRAME();
        { pg8::StaticOrder S; S.init(M / 256, 4, F.G, (bx + 16 + 136) % F.G, 0, 4, 12, 256); pg8::EpiBf16 E{(bf16*)(ws + WS_MIX + MX_G), MIXA, 12 * 256}; pg8::gemm_phase(F.lds, g, S, E, F.tid); }
    } SEAM(4);
    if (IN(5)) { REFRAME();
        if (F.vcu < 208) rwkv_pre_phase(F, a, F.vcu, 208);
        else gla_pre_phase(F, a, F.vcu - 208, F.G - 208);
    } SEAM(5);
    if (IN(6)) { REFRAME();
        if (F.vcu < 64) rwkv_seq_phase(F, a, F.vcu, 64);
        else if (F.vcu < 192) gla_seq_phase(F, a, F.vcu - 64, 128);
        REFRAME(); __syncthreads();
        conv_dyn(F, a, (unsigned*)(ws + WS_CTL) + 2112, 4, 5);
    } SEAM(6);
    if (IN(9)) { REFRAME(); finish0_phase(F, a); } SEAM(9);
    if (IN(10)) { REFRAME(); pg8::Gemm g{ABF, (const bf16*)(ws + WS_WO0), D, D, D}; pg8::StaticOrder S; S.init(32, D / 256, F.G, bx, 3, D / 64, 0, 0, 8);
        pg8::EpiF32 E{(bf16*)(ws + WS_MIX + MX_Y), D, (float*)(ws + WS_YC)}; pg8::gemm_phase(F.lds, g, S, E, F.tid); } SEAM(10);
    if (IN(11)) { REFRAME(); rows_phase(F, a, 1, 8, true, ng + 1 * D, modv + 2 * D, false, ng + 2 * D, modv + 3 * D, modv + 4 * D); } SEAM(11);
    if (IN(12)) { REFRAME(); pg8::Gemm g{ABF, (const bf16*)(ws + WS_WFI0), D, D, D}; pg8::StaticOrder S; S.init(M / 256, 2 * DFF / 256, F.G, bx, 0, D / 64);
        pg8::EpiSwiglu E{(bf16*)(ws + WS_ZR), DFF}; pg8::gemm_phase(F.lds, g, S, E, F.tid);
        REFRAME(); __syncthreads(); conv_dyn(F, a, (unsigned*)(ws + WS_CTL) + 2304, 3, 4); } SEAM(12);
    if (IN(13)) { REFRAME(); pg8::Gemm g{(const bf16*)(ws + WS_ZR), (const bf16*)(ws + WS_WFO0), DFF, DFF, DFF}; pg8::StaticOrder S; S.init(32, D / 256, F.G, bx, 3, DFF / 64, 0, 0, 11);
        pg8::EpiF32 E{(bf16*)(ws + WS_MIX + MX_Y), D, (float*)(ws + WS_YC)}; pg8::gemm_phase(F.lds, g, S, E, F.tid);
        REFRAME(); __syncthreads(); conv_dyn(F, a, (unsigned*)(ws + WS_CTL) + 2432, 5, 6); } SEAM(13);
    if (IN(14)) { REFRAME(); rows_phase(F, a, 1, 11, false, ng + 3 * D, modv + 5 * D, false, ng + 4 * D, modv + 3 * 12288 + 0 * D, modv + 3 * 12288 + 1 * D); } SEAM(14);
    if (IN(15)) { REFRAME(); pg8::Gemm g{ABF, (const bf16*)(ws + WS_WRI), D, D, D}; pg8::StaticOrder S; S.init(M / 256, RETC / 256, F.G, bx, 0, D / 64);
        pg8::EpiRet E{(bf16*)(ws + WS_ZR), RETC, (const float*)(ws + WS_ROT)}; pg8::gemm_phase(F.lds, g, S, E, F.tid);
        REFRAME(); __syncthreads(); conv_dyn(F, a, (unsigned*)(ws + WS_CTL) + 2176, 6, 7); } SEAM(15);
    if (IN(16)) { REFRAME();
        ret_intra_phase(F, (const bf16*)(ws + WS_ZR), (bf16*)(ws + WS_MIX + MX_A3));
        REFRAME(); __syncthreads();
        ret_scan_phase(F, (const bf16*)(ws + WS_ZR), (bf16*)(ws + WS_MIX + MX_OC)); } SEAM(16);
    if (IN(17)) { REFRAME(); finish1_phase(F, a); } SEAM(17);
    const bool fuse_rows = (F.G == 256) && MK_ONE_LAUNCH;
    unsigned* xcnt = (unsigned*)(ws + WS_CTL + 65536); float* xslot = (float*)(ws + WS_CTL + 131072); unsigned* xtmo = (unsigned*)(ws + WS_CTL) + 4096 + XB_TMO;
    if (IN(18)) { REFRAME(); pg8::Gemm g{(const bf16*)(ws + WS_MIX + MX_A3), (const bf16*)(ws + WS_WRO), 2 * D, 2 * D, 2 * D}; pg8::StaticOrder S; S.init(32, D / 256, F.G, bx, 1, 2 * D / 64);
        if (fuse_rows) {
            pg8::NormX x1{xslot, xcnt, xtmo}, x2{xslot + 34 * 256 * 8, xcnt + 34 * 64, xtmo};
            pg8::EpiNorm E{(bf16*)(ws + WS_H), ABF, nullptr, modv + 3 * 12288 + 2 * D, ng + 5 * D, ng + 6 * D, modv + 3 * 12288 + 3 * D, modv + 3 * 12288 + 4 * D, false, x1, x2};
            pg8::gemm_phase(F.lds, g, S, E, F.tid);
        } else { pg8::EpiF32 E{(bf16*)(ws + WS_MIX + MX_Y), D, (float*)(ws + WS_YC)}; pg8::gemm_phase(F.lds, g, S, E, F.tid); } } SEAM(18);
    if (!fuse_rows) { if (IN(19)) { REFRAME(); rows_phase(F, a, 1, 0, false, ng + 5 * D, modv + 3 * 12288 + 2 * D, false, ng + 6 * D, modv + 3 * 12288 + 3 * D, modv + 3 * 12288 + 4 * D); } SEAM(19); }
    if (IN(20)) { REFRAME(); pg8::Gemm g{ABF, (const bf16*)(ws + WS_WFI1), D, D, D}; pg8::StaticOrder S; S.init(32, 2 * DFF / 256, F.G, bx, 1, D / 64);
        pg8::EpiSwiglu E{(bf16*)(ws + WS_ZR), DFF}; pg8::gemm_phase(F.lds, g, S, E, F.tid);
        REFRAME(); __syncthreads(); conv_dyn(F, a, (unsigned*)(ws + WS_CTL) + 2240, 7, 8); } SEAM(20);
    if (IN(21)) { REFRAME(); pg8::Gemm g{(const bf16*)(ws + WS_ZR), (const bf16*)(ws + WS_WFO1), DFF, DFF, DFF}; pg8::StaticOrder S; S.init(32, D / 256, F.G, bx, 1, DFF / 64);
        if (fuse_rows) {
            pg8::NormX x1{xslot + 2 * 34 * 256 * 8, xcnt + 2 * 34 * 64, xtmo};
            pg8::EpiNorm E{(bf16*)(ws + WS_H), nullptr, a.out, modv + 3 * 12288 + 5 * D, ng + 7 * D, nullptr, nullptr, nullptr, true, x1, x1};
            pg8::gemm_phase(F.lds, g, S, E, F.tid);
        } else { pg8::EpiF32 E{(bf16*)(ws + WS_MIX + MX_Y), D, (float*)(ws + WS_YC)}; pg8::gemm_phase(F.lds, g, S, E, F.tid); } }
    if (!fuse_rows) { SEAM(21);
    if (IN(22)) { REFRAME(); rows_phase(F, a, 1, 0, false, ng + 7 * D, modv + 3 * 12288 + 5 * D, true, nullptr, nullptr, nullptr); } }
#undef IN
#undef SEAM
}


extern "C" void kernel_launch(void* const* d_in, const int* in_sizes, int n_in, void* d_out, int out_size, void* d_ws, size_t ws_size, hipStream_t stream) {
    static int grid = 0;
    if (grid == 0) {
        if (n_in != 27 || ws_size < WS_END) { fprintf(stderr, "kernel_launch: unexpected n_in %d or ws_size %zu (need %zu)\n", n_in, ws_size, (size_t)WS_END); grid = -1; return; }
        int dev = 0, cus = 0, per_cu = 0;
        (void)hipGetDevice(&dev); (void)hipDeviceGetAttribute(&cus, hipDeviceAttributeMultiprocessorCount, dev);
        if (hipFuncSetAttribute((const void*)mega, hipFuncAttributeMaxDynamicSharedMemorySize, LDS_BYTES) != hipSuccess) { fprintf(stderr, "kernel_launch: hipFuncSetAttribute failed\n"); grid = -1; return; }
        if (hipOccupancyMaxActiveBlocksPerMultiprocessor(&per_cu, (const void*)mega, NTHR, LDS_BYTES) != hipSuccess || per_cu < 1) { fprintf(stderr, "kernel_launch: occupancy query says %d\n", per_cu); per_cu = 1; }
        (void)hipGetLastError();
        grid = cus;
    }
    if (grid < 0) return;
    Args a{};
    for (int i = 0; i < 27; ++i) a.in[i] = (const float*)d_in[i];
    a.out = (float*)d_out; a.ws = (unsigned char*)d_ws;
#if MK_ONE_LAUNCH
    (void)hipMemsetAsync((char*)d_ws + WS_CTL, 0, 128 * 1024, stream);
    a.ph_lo = 0; a.ph_hi = N_PHASES;
    void* args[] = {&a};
    hipError_t e = hipLaunchCooperativeKernel((const void*)mega, dim3(grid), dim3(NTHR), args, LDS_BYTES, stream);
    if (e != hipSuccess) fprintf(stderr, "cooperative launch failed: %s (grid %d)\n", hipGetErrorString(e), grid);
#else
    for (int p = 0; p < N_PHASES; ++p) {
        a.ph_lo = p; a.ph_hi = p + 1;
        hipLaunchKernelGGL(mega, dim3(grid), dim3(NTHR), LDS_BYTES, stream, a);
    }
#endif
}
```

```cpp
#include <hip/hip_runtime.h>
#include <hip/hip_cooperative_groups.h>
#include <cstdio>
#include <cstdint>
namespace cg = cooperative_groups;

#ifndef MK_ONE_LAUNCH
#define MK_ONE_LAUNCH 1
#endif

#define LAS __attribute__((address_space(3)))
typedef unsigned short bf16;
typedef short bf16x8 __attribute__((ext_vector_type(8)));
typedef float f32x4 __attribute__((ext_vector_type(4)));
typedef float f32x2 __attribute__((ext_vector_type(2)));
typedef unsigned u32x4 __attribute__((ext_vector_type(4)));
typedef unsigned u32x2 __attribute__((ext_vector_type(2)));

constexpr int D = 2048, NB = 2, SEQ = 4096, CTX = 256, TB = CTX + SEQ  , M = NB * TB  ;
constexpr int DFF = 5632, MIXA = 1024, ACOLS = 3520, ABCOLS = 6608, ZLD0 = 6656, RETC = 12288;
constexpr int GQ = 3520, GK = 4032, GV = 4544, GR = 5568, GGD = 6592;
constexpr float RMS_EPS = 1e-6f, GN_EPS = 64e-5f;
constexpr int NWAVES = 8, NTHR = 512;
constexpr int LDS_BYTES = 160 * 1024;

constexpr size_t MiB = 1u << 20;
constexpr size_t SZ_WAB = (size_t)ZLD0 * D * 2, SZ_WO0 = (size_t)D * D * 2, SZ_WFI = (size_t)2 * DFF * D * 2, SZ_WFO = (size_t)D * DFF * 2,
                 SZ_WRI = (size_t)RETC * D * 2, SZ_WRO = (size_t)D * 2 * D * 2, SZ_WLO = (size_t)4096 * 512 * 2;
constexpr size_t WS_CTL = 0;
constexpr size_t WS_WAB = 1 * MiB;
constexpr size_t WS_WO0 = WS_WAB + SZ_WAB;
constexpr size_t WS_WFI0 = WS_WO0 + SZ_WO0;
constexpr size_t WS_WFI1 = WS_WFI0 + SZ_WFI;
constexpr size_t WS_WFO0 = WS_WFI1 + SZ_WFI;
constexpr size_t WS_WFO1 = WS_WFO0 + SZ_WFO;
constexpr size_t WS_WRI = WS_WFO1 + SZ_WFO;
constexpr size_t WS_WRO = WS_WRI + SZ_WRI;
constexpr size_t WS_WLO = WS_WRO + SZ_WRO;
constexpr size_t WS_MODV = WS_WLO + SZ_WLO;
constexpr size_t WS_ROT = WS_MODV + 512 * 1024;
constexpr size_t WS_H = WS_ROT + 512 * 1024;
constexpr size_t SZ_H = (size_t)M * D * 4;
constexpr size_t WS_ZR = WS_H + SZ_H;
constexpr size_t SZ_ZR = (size_t)M * RETC * 2;
constexpr size_t RW_ITEMS = (size_t)NB * 16 * (TB / 64);
constexpr size_t WS_RWG = WS_ZR + (size_t)M * ZLD0 * 2;
constexpr size_t WS_RWP = WS_RWG + RW_ITEMS * 8192;
constexpr size_t WS_RWY = WS_RWP + RW_ITEMS * 8192;
constexpr size_t WS_RWQ = WS_RWY + RW_ITEMS * 8192;
constexpr size_t GLA_ITEMS = (size_t)NB * 4 * 2 * (TB / 64);
constexpr size_t WS_GKI = WS_RWQ + RW_ITEMS * 8192;
constexpr size_t WS_GDL = WS_GKI + GLA_ITEMS * 16384;
constexpr size_t DO_GQI = (size_t)M * D * 2;
static_assert(WS_GDL + GLA_ITEMS * 512 <= WS_ZR + SZ_ZR, "RWKV chunk operators (direction 0) + GLA k_in must fit in the tail of the Z region");
static_assert(DO_GQI + GLA_ITEMS * 16384 <= (size_t)NB * SEQ * D * 4, "GLA q_in must fit in d_out behind ABF");
static_assert(RW_ITEMS * 8192 * 4 <= SZ_H, "RWKV chunk operators (direction 1) live in the residual-stream buffer H, which is first written after the mixer");
constexpr size_t WS_MIX = WS_ZR + SZ_ZR;
constexpr size_t SZ_T = (size_t)M * MIXA * 2;
constexpr size_t MX_Y = 0;
constexpr size_t MX_R = 0, MX_V = SZ_T, MX_K = 2 * SZ_T, MX_KK = 3 * SZ_T, MX_BV = 4 * SZ_T, MX_G = 5 * SZ_T;
constexpr size_t MX_DEC = 6 * SZ_T;
constexpr size_t MX_ALO = MX_DEC + 4 * SZ_T;
constexpr size_t MX_YA = MX_ALO + SZ_T / 2;
constexpr size_t MX_YB = MX_YA + 2 * SZ_T;
constexpr size_t SZ_MIX0 = MX_YB + 2 * SZ_T;
constexpr size_t MX_YC = 80 * MiB;
constexpr size_t WS_YC = WS_MIX + MX_YC;
static_assert(MX_YC >= (size_t)M * D * 4 && MX_YC + (size_t)11 * NB * CTX * D * 4 <= SZ_MIX0, "split-K slabs inside the mixer scratch, above Y");
constexpr size_t MX_OC = 0;
constexpr size_t MX_A3 = (size_t)2 * M * 4096 * 2;
constexpr size_t SZ_MIX1 = MX_A3 + (size_t)M * 4096 * 2;
constexpr size_t SZ_MIX = SZ_MIX0 > SZ_MIX1 ? SZ_MIX0 : SZ_MIX1;
constexpr size_t WS_END = WS_MIX + SZ_MIX;
static_assert(WS_END <= (size_t)768 * MiB, "workspace map exceeds 768 MiB");
static_assert((size_t)M * D * 2 <= (size_t)NB * SEQ * D * 4, "ABF must fit in d_out");

__device__ __forceinline__ float bf2f(unsigned v) { return __uint_as_float(v << 16); }
__device__ __forceinline__ float bflo(unsigned w) { return __uint_as_float(w << 16); }
__device__ __forceinline__ float bfhi(unsigned w) { return __uint_as_float(w & 0xffff0000u); }
typedef __bf16 bf16x2_t __attribute__((ext_vector_type(2)));
__device__ __forceinline__ unsigned pk2(float lo, float hi) { const f32x2 v = {lo, hi}; const bf16x2_t r = __builtin_convertvector(v, bf16x2_t); return __builtin_bit_cast(unsigned, r); }
__device__ __forceinline__ bf16 f2bf(float f) { return (bf16)(pk2(f, 0.f) & 0xffffu); }
__device__ __forceinline__ int lane_id_opaque() { int l; asm volatile("v_mbcnt_lo_u32_b32 %0, -1, 0\n\tv_mbcnt_hi_u32_b32 %0, -1, %0" : "=v"(l)); return l; }
__device__ __forceinline__ float wave_sum(float v) {
    v += __int_as_float(__builtin_amdgcn_update_dpp(0, __float_as_int(v), 0xB1, 0xF, 0xF, false));
    v += __int_as_float(__builtin_amdgcn_update_dpp(0, __float_as_int(v), 0x4E, 0xF, 0xF, false));
    v += __int_as_float(__builtin_amdgcn_update_dpp(0, __float_as_int(v), 0x141, 0xF, 0xF, false));
    v += __int_as_float(__builtin_amdgcn_update_dpp(0, __float_as_int(v), 0x140, 0xF, 0xF, false));
    const int iv = __float_as_int(v);
    return (__int_as_float(__builtin_amdgcn_readlane(iv, 0)) + __int_as_float(__builtin_amdgcn_readlane(iv, 16))) + (__int_as_float(__builtin_amdgcn_readlane(iv, 32)) + __int_as_float(__builtin_amdgcn_readlane(iv, 48)));
}
__device__ __forceinline__ float quad_sum(float v) {
    v += __int_as_float(__builtin_amdgcn_update_dpp(0, __float_as_int(v), 0xB1, 0xF, 0xF, false));
    v += __int_as_float(__builtin_amdgcn_update_dpp(0, __float_as_int(v), 0x4E, 0xF, 0xF, false));
    return v;
}
__device__ __forceinline__ float row16_sum(float v) {
    v = quad_sum(v);
    v += __int_as_float(__builtin_amdgcn_update_dpp(0, __float_as_int(v), 0x141, 0xF, 0xF, false));
    v += __int_as_float(__builtin_amdgcn_update_dpp(0, __float_as_int(v), 0x140, 0xF, 0xF, false));
    return v;
}
__device__ __forceinline__ float fexp(float x) { return __builtin_amdgcn_exp2f(x * 1.4426950408889634f); }
__device__ __forceinline__ float flog(float x) { return __builtin_amdgcn_logf(x) * 0.6931471805599453f; }
__device__ __forceinline__ float fsigmoid(float x) { return __builtin_amdgcn_rcpf(1.0f + fexp(-x)); }
__device__ __forceinline__ float fsilu(float x) { return x * __builtin_amdgcn_rcpf(1.0f + fexp(-x)); }
__device__ __forceinline__ float flogsigmoid(float x) { return -(fmaxf(-x, 0.f) + flog(1.0f + fexp(-fabsf(x)))); }
__device__ __forceinline__ void unpack8(const u32x4 w, float (&o)[8]) {
    o[0] = bflo(w.x); o[1] = bfhi(w.x); o[2] = bflo(w.y); o[3] = bfhi(w.y); o[4] = bflo(w.z); o[5] = bfhi(w.z); o[6] = bflo(w.w); o[7] = bfhi(w.w);
}
__device__ __forceinline__ u32x4 pack8(const float (&v)[8]) { u32x4 w; w.x = pk2(v[0], v[1]); w.y = pk2(v[2], v[3]); w.z = pk2(v[4], v[5]); w.w = pk2(v[6], v[7]); return w; }

namespace pg8 {
#define PG8_LAS __attribute__((address_space(3)))
typedef unsigned short bf16_t;
constexpr int BM = 256, BK = 64, HALF = 128, HTB = HALF * BK * 2, STAGE_BYTES = 8 * HTB, NXCD = 8, WGM = 4;
__host__ __device__ __forceinline__ int lds_byte(int r, int c) { const int st = (r >> 4) * 2 + (c >> 5), rr = r & 15, cc = c & 31, ob = rr * 64 + cc * 2; return st * 1024 + (ob ^ (((ob >> 9) & 1) << 5)); }
__host__ __device__ __forceinline__ void stage_rc(int b, int& R, int& C) { const int st = b / 1024, sb = b % 1024, swz = sb ^ (((sb >> 9) & 1) << 5); R = (st >> 1) * 16 + swz / 64; C = (st & 1) * 32 + (swz % 64) / 2; }
__host__ __device__ __forceinline__ int perm32(int rho) { const int n = rho >> 4, i = rho & 15; return 8 * (i >> 2) + 4 * n + (i & 3); }

struct Unit { int pm, pn, ko, nk, part; };
struct Gemm { const bf16_t* A; const bf16_t* Bt; int lda, ldb, K; };

struct StaticOrder {
    int nM, nN, nwg, G, c, mode, pn0, ko, nk, S;
    __device__ void init(int nM_, int nN_, int G_, int c_, int mode_, int nk_, int pn0_ = 0, int ko_ = 0, int S_ = 1) { nM = nM_; nN = nN_; nwg = nM * nN; G = G_; c = c_; mode = mode_; pn0 = pn0_; ko = ko_; nk = nk_; S = S_; }
    __device__ bool next(int i, Unit& u) const {
        const long L = (long)i * G + c;
        if (mode == 3 && L >= nwg) {
            const int j = (int)(L - nwg); if (j >= 16 * S) return false;
            const int tile = j / S, part = j % S;
            u.pm = (tile >> 3) ? 17 : 0; u.pn = tile & 7; u.nk = nk / S; u.ko = part * (nk / S) * 64; u.part = part + 1; return true;
        }
        if (L >= nwg) return false;
        int wgid = (int)L; { const int q = nwg / NXCD, r = nwg % NXCD, xcd = wgid % NXCD, off = wgid / NXCD; wgid = (xcd < r ? xcd * (q + 1) : r * (q + 1) + (xcd - r) * q) + off; }
        const int nig = WGM * nN, gid = wgid / nig, fm = gid * WGM, gsz = (nM - fm) < WGM ? (nM - fm) : WGM;
        u.pm = fm + ((wgid % nig) % gsz); u.pn = (wgid % nig) / gsz + pn0; u.ko = ko; u.nk = nk; u.part = 0;
        if (mode == 1 || mode == 3) u.pm = u.pm + 1 + (u.pm >= 16 ? 1 : 0);
        return true;
    }
};

template <class Epi, class Sched, bool ALIGN_EPI = true>
__device__ __forceinline__ void gemm_phase(PG8_LAS unsigned char* lds, const Gemm g, const Sched& S, const Epi& E, const int tid) {
    const int wid = __builtin_amdgcn_readfirstlane(tid >> 6), lane = tid & 63, wr = wid >> 2, wc = wid & 3, fr = lane & 15, fq = lane >> 4;
    unsigned voffA[2], voffB[2];
#pragma unroll
    for (int i = 0; i < 2; ++i) { int R, C; stage_rc(tid * 16 + i * 8192, R, C); const int Rb = Epi::PERM ? ((R & ~31) + perm32(R & 31)) : R;
        voffA[i] = (unsigned)(R * g.lda + C) * 2u; voffB[i] = (unsigned)(Rb * g.ldb + C) * 2u; }
    const size_t kstep = (size_t)(BK * 2);
    const size_t hstepA = (size_t)HALF * g.lda * 2, hstepB = (size_t)HALF * g.ldb * 2;
    const size_t tstepA = 2 * hstepA, tstepB = 2 * hstepB;
    const unsigned ldsw = (unsigned)wid * 1024u;
    const int aoff = lds_byte(wr * 64 + fr, fq * 8), boff = lds_byte(wc * 32 + fr, fq * 8);
#define PG8_SA(b, h) (((b) * 2 + (h)) * HTB)
#define PG8_SB(b, h) ((4 + (b) * 2 + (h)) * HTB)
#define PG8_STAGE(bufoff, gbase, voff) do { _Pragma("unroll") for (int _i = 0; _i < 2; ++_i) \
        __builtin_amdgcn_global_load_lds((const unsigned*)((const char*)(gbase) + (voff)[_i]), (PG8_LAS unsigned*)(lds + (bufoff) + ldsw + _i * 8192), 16, 0, 0); } while (0)
#define PG8_LDA(dst, b, h) do { _Pragma("unroll") for (int m = 0; m < 4; ++m) _Pragma("unroll") for (int k = 0; k < 2; ++k) dst[m][k] = *(const PG8_LAS bf16x8*)(lds + PG8_SA(b, h) + aoff + m * 2048 + k * 1024); } while (0)
#define PG8_LDB(dst, b, h) do { _Pragma("unroll") for (int n = 0; n < 2; ++n) _Pragma("unroll") for (int k = 0; k < 2; ++k) dst[n][k] = *(const PG8_LAS bf16x8*)(lds + PG8_SB(b, h) + boff + n * 2048 + k * 1024); } while (0)
#define PG8_MMA(ai, bj, At, Bt) do { __builtin_amdgcn_s_setprio(1); _Pragma("unroll") for (int m = 0; m < 4; ++m) _Pragma("unroll") for (int n = 0; n < 2; ++n) _Pragma("unroll") for (int k = 0; k < 2; ++k) \
        acc[ai][bj][m][n] = __builtin_amdgcn_mfma_f32_16x16x32_bf16(Bt[n][k], At[m][k], acc[ai][bj][m][n], 0, 0, 0); __builtin_amdgcn_s_setprio(0); } while (0)
#define PG8_WAIT_V(n) asm volatile("s_waitcnt vmcnt(" #n ")" ::: "memory")
#define PG8_WAIT_L(n) asm volatile("s_waitcnt lgkmcnt(" #n ")" ::: "memory")
#define PG8_BAR __builtin_amdgcn_s_barrier()
#define PG8_SCHED __builtin_amdgcn_sched_barrier(0)
    Unit cur, nxt; int ui = 0;
    if (!S.next(0, cur)) return;
    f32x4 acc[2][2][4][2];
#pragma unroll
    for (int a = 0; a < 2; ++a)
#pragma unroll
        for (int b = 0; b < 2; ++b)
#pragma unroll
            for (int m = 0; m < 4; ++m)
#pragma unroll
                for (int n = 0; n < 2; ++n) acc[a][b][m][n] = (f32x4){0.f, 0.f, 0.f, 0.f};
    bf16x8 At[4][2], B0[2][2], B1[2][2];
    const char* cA = (const char*)g.A + (size_t)cur.pm * tstepA + (size_t)cur.ko * 2; const char* cB = (const char*)g.Bt + (size_t)cur.pn * tstepB + (size_t)cur.ko * 2;
    PG8_STAGE(PG8_SB(0, 0), cB, voffB); PG8_STAGE(PG8_SB(0, 1), cB + hstepB, voffB); PG8_STAGE(PG8_SA(0, 0), cA, voffA); PG8_STAGE(PG8_SA(0, 1), cA + hstepA, voffA);
    if (wr == 1) PG8_BAR;
    PG8_WAIT_V(2); PG8_BAR;
    PG8_STAGE(PG8_SB(1, 0), cB + kstep, voffB); PG8_STAGE(PG8_SA(1, 0), cA + kstep, voffA); PG8_STAGE(PG8_SB(1, 1), cB + hstepB + kstep, voffB);
    PG8_WAIT_V(6); PG8_BAR;
    for (;;) {
        const bool has_next = S.next(ui + 1, nxt);
        const char* nA = has_next ? (const char*)g.A + (size_t)nxt.pm * tstepA + (size_t)nxt.ko * 2 : cA; const char* nB = has_next ? (const char*)g.Bt + (size_t)nxt.pn * tstepB + (size_t)nxt.ko * 2 : cB;
        const int nt = cur.nk;
        for (int t = 0; t < nt; t += 2) {
            const bool last = (t == nt - 2);
            const char* a1 = cA + (size_t)(t + 1) * kstep;
            const char* a2 = last ? nA : cA + (size_t)(t + 2) * kstep; const char* b2 = last ? nB : cB + (size_t)(t + 2) * kstep;
            const char* a3 = a2 + kstep; const char* b3 = b2 + kstep;
            PG8_LDB(B0, 0, 0); PG8_LDB(B1, 0, 1); PG8_SCHED; PG8_LDA(At, 0, 0); PG8_STAGE(PG8_SA(1, 1), a1 + hstepA, voffA);
            PG8_WAIT_V(8); PG8_WAIT_L(0); PG8_BAR; PG8_MMA(0, 0, At, B0); PG8_MMA(0, 1, At, B1); PG8_BAR; PG8_SCHED;
            PG8_LDA(At, 0, 1); PG8_STAGE(PG8_SB(0, 0), b2, voffB); PG8_STAGE(PG8_SB(0, 1), b2 + hstepB, voffB); PG8_STAGE(PG8_SA(0, 0), a2, voffA);
            PG8_WAIT_V(8); PG8_WAIT_L(0); PG8_BAR; PG8_MMA(1, 0, At, B0); PG8_MMA(1, 1, At, B1); PG8_BAR; PG8_SCHED;
            PG8_LDB(B0, 1, 0); PG8_LDB(B1, 1, 1); PG8_SCHED; PG8_LDA(At, 1, 0); PG8_STAGE(PG8_SA(0, 1), a2 + hstepA, voffA);
            PG8_WAIT_V(8); PG8_WAIT_L(0); PG8_BAR; PG8_MMA(0, 0, At, B0); PG8_MMA(0, 1, At, B1); PG8_BAR; PG8_SCHED;
            PG8_LDA(At, 1, 1); PG8_STAGE(PG8_SB(1, 0), b3, voffB); PG8_STAGE(PG8_SB(1, 1), b3 + hstepB, voffB); PG8_STAGE(PG8_SA(1, 0), a3, voffA);
            PG8_WAIT_V(8); PG8_WAIT_L(0); PG8_BAR; PG8_MMA(1, 0, At, B0); PG8_MMA(1, 1, At, B1); PG8_BAR; PG8_SCHED;
        }
        if constexpr (ALIGN_EPI) { if (wr == 0) PG8_BAR; }
        if constexpr (!Epi::AFTER_DRAIN) { const int l2 = lane_id_opaque(); E(acc, cur, wr, wc, l2 & 15, l2 >> 4); }
        if (!has_next) break;
#pragma unroll
        for (int a = 0; a < 2; ++a)
#pragma unroll
            for (int b = 0; b < 2; ++b)
#pragma unroll
                for (int m = 0; m < 4; ++m)
#pragma unroll
                    for (int n = 0; n < 2; ++n) acc[a][b][m][n] = (f32x4){0.f, 0.f, 0.f, 0.f};
        cur = nxt; cA = nA; cB = nB; ++ui;
        if constexpr (ALIGN_EPI) { if (wr == 1) PG8_BAR; }
    }
    PG8_WAIT_V(0);
    if constexpr (!ALIGN_EPI) { if (wr == 0) PG8_BAR; }
    PG8_BAR;
    if constexpr (Epi::AFTER_DRAIN) { const int l2 = lane_id_opaque(); E.fused(acc, cur, wr, wc, l2 & 15, l2 >> 4, lds, wid, l2); }
#undef PG8_SA
#undef PG8_SB
#undef PG8_STAGE
#undef PG8_LDA
#undef PG8_LDB
#undef PG8_MMA
#undef PG8_WAIT_V
#undef PG8_WAIT_L
#undef PG8_BAR
#undef PG8_SCHED
}

struct EpiF32 {
    static constexpr bool PERM = true, AFTER_DRAIN = false;
    bf16_t* C; int ldc; float* YC;
    __device__ __forceinline__ void operator()(const f32x4 (&acc)[2][2][4][2], const Unit& u, int wr, int wc, int fr, int fq) const {
        const int col0 = u.pn * BM + wc * 32 + 8 * fq;
        if (u.part) {
            const int row0 = (u.pm ? CTX : 0) + wr * 64 + fr; float* slab = YC + (size_t)(u.part - 1) * NB * CTX * ldc;
#pragma unroll
            for (int ai = 0; ai < 2; ++ai)
#pragma unroll
                for (int m = 0; m < 4; ++m) { float* rowp = slab + (size_t)(row0 + ai * HALF + m * 16) * ldc + col0;
#pragma unroll
                    for (int bj = 0; bj < 2; ++bj)
#pragma unroll
                        for (int n = 0; n < 2; ++n) *(f32x4*)(rowp + bj * HALF + 4 * n) = acc[ai][bj][m][n]; }
        } else {
            const int row0 = u.pm * BM + wr * 64 + fr;
#pragma unroll
            for (int ai = 0; ai < 2; ++ai)
#pragma unroll
                for (int m = 0; m < 4; ++m) { bf16_t* rowp = C + (size_t)(row0 + ai * HALF + m * 16) * ldc + col0;
#pragma unroll
                    for (int bj = 0; bj < 2; ++bj) { const f32x4 v0 = acc[ai][bj][m][0], v1 = acc[ai][bj][m][1];
                        u32x4 w; w.x = pk2(v0[0], v0[1]); w.y = pk2(v0[2], v0[3]); w.z = pk2(v1[0], v1[1]); w.w = pk2(v1[2], v1[3]);
                        *(u32x4*)(rowp + bj * HALF) = w; } }
        }
    }
};
struct EpiBf16 {
    static constexpr bool PERM = true, AFTER_DRAIN = false;
    bf16_t* O; int ldc; int coff;
    __device__ __forceinline__ void operator()(const f32x4 (&acc)[2][2][4][2], const Unit& u, int wr, int wc, int fr, int fq) const {
        const int row0 = u.pm * BM + wr * 64 + fr, col0 = u.pn * BM - coff + wc * 32 + 8 * fq;
#pragma unroll
        for (int ai = 0; ai < 2; ++ai)
#pragma unroll
            for (int m = 0; m < 4; ++m) { bf16_t* rowp = O + (size_t)(row0 + ai * HALF + m * 16) * ldc + col0;
#pragma unroll
                for (int bj = 0; bj < 2; ++bj) { const f32x4 v0 = acc[ai][bj][m][0], v1 = acc[ai][bj][m][1];
                    u32x4 w; w.x = pk2(v0[0], v0[1]); w.y = pk2(v0[2], v0[3]); w.z = pk2(v1[0], v1[1]); w.w = pk2(v1[2], v1[3]);
                    *(u32x4*)(rowp + bj * HALF) = w; } }
    }
};
struct EpiSwiglu {
    static constexpr bool PERM = true, AFTER_DRAIN = false;
    bf16_t* O; int ldc;
    __device__ __forceinline__ void operator()(const f32x4 (&acc)[2][2][4][2], const Unit& u, int wr, int wc, int fr, int fq) const {
        const int row0 = u.pm * BM + wr * 64 + fr, col0 = u.pn * HALF + wc * 32 + 8 * fq;
#pragma unroll
        for (int ai = 0; ai < 2; ++ai)
#pragma unroll
            for (int m = 0; m < 4; ++m) { bf16_t* rowp = O + (size_t)(row0 + ai * HALF + m * 16) * ldc + col0;
                float o[8];
#pragma unroll
                for (int n = 0; n < 2; ++n)
#pragma unroll
                    for (int j = 0; j < 4; ++j) { const float gt = acc[ai][0][m][n][j], up = acc[ai][1][m][n][j]; o[4 * n + j] = fsilu(gt) * up; }
                *(u32x4*)rowp = pack8(o); }
    }
};
struct EpiDec {
    static constexpr bool PERM = true, AFTER_DRAIN = false;
    float* DEC; const float* w0;
    __device__ __forceinline__ void operator()(const f32x4 (&acc)[2][2][4][2], const Unit& u, int wr, int wc, int fr, int fq) const {
        const int row0 = u.pm * BM + wr * 64 + fr; const int seg = u.pn >> 2; const int cs0 = (u.pn & 3) * BM + wc * 32 + 8 * fq;
        float* dbase = DEC + (size_t)seg * M * MIXA;
#pragma unroll
        for (int bj = 0; bj < 2; ++bj) { const int cs = cs0 + bj * HALF;
            const f32x4 wa = *(const f32x4*)(w0 + seg * MIXA + cs), wb = *(const f32x4*)(w0 + seg * MIXA + cs + 4);
#pragma unroll
            for (int ai = 0; ai < 2; ++ai)
#pragma unroll
                for (int m = 0; m < 4; ++m) { float* dp = dbase + (size_t)(row0 + ai * HALF + m * 16) * MIXA + cs;
                    f32x4 o0, o1;
#pragma unroll
                    for (int j = 0; j < 4; ++j) {
                        const float x0 = acc[ai][bj][m][0][j] + wa[j], x1 = acc[ai][bj][m][1][j] + wb[j];
                        o0[j] = -0.6065306597126334f * fsigmoid(x0); o1[j] = -0.6065306597126334f * fsigmoid(x1); }
                    *(f32x4*)dp = o0; *(f32x4*)(dp + 4) = o1; } }
    }
};
struct EpiLr {
    static constexpr bool PERM = true, AFTER_DRAIN = false;
    bf16_t* KM; const bf16_t* KKp; bf16_t* BV; const float* a0; const float* ka;
    __device__ __forceinline__ void operator()(const f32x4 (&acc)[2][2][4][2], const Unit& u, int wr, int wc, int fr, int fq) const {
        const int row0 = u.pm * BM + wr * 64 + fr; const int cs0 = (u.pn & 3) * BM + wc * 32 + 8 * fq;
#pragma unroll
        for (int bj = 0; bj < 2; ++bj)
#pragma unroll
            for (int n = 0; n < 2; ++n) { const int cs = cs0 + bj * HALF + 4 * n;
                const f32x4 aa = *(const f32x4*)(a0 + cs), kav = *(const f32x4*)(ka + cs);
                u32x2 kws[2][4], qws[2][4];
#pragma unroll
                for (int ai = 0; ai < 2; ++ai)
#pragma unroll
                    for (int m = 0; m < 4; ++m) { const size_t off = (size_t)(row0 + ai * HALF + m * 16) * MIXA + cs; kws[ai][m] = *(const u32x2*)(KM + off); qws[ai][m] = *(const u32x2*)(KKp + off); }
#pragma unroll
                for (int ai = 0; ai < 2; ++ai)
#pragma unroll
                    for (int m = 0; m < 4; ++m) { const size_t off = (size_t)(row0 + ai * HALF + m * 16) * MIXA + cs;
                        const u32x2 kw = kws[ai][m], qw = qws[ai][m];
                        const float kv[4] = {bflo(kw.x), bfhi(kw.x), bflo(kw.y), bfhi(kw.y)}, kk[4] = {bflo(qw.x), bfhi(qw.x), bflo(qw.y), bfhi(qw.y)};
                        float km[4], bv[4];
#pragma unroll
                        for (int j = 0; j < 4; ++j) { const float lr = fsigmoid(acc[ai][bj][m][n][j] + aa[j]);
                            km[j] = kv[j] * (1.0f + (lr - 1.0f) * kav[j]); bv[j] = kk[j] * lr; }
                        u32x2 o1, o2; o1.x = pk2(km[0], km[1]); o1.y = pk2(km[2], km[3]); o2.x = pk2(bv[0], bv[1]); o2.y = pk2(bv[2], bv[3]);
                        *(u32x2*)(KM + off) = o1; *(u32x2*)(BV + off) = o2; } }
    }
};
struct EpiRet {
    static constexpr bool PERM = true, AFTER_DRAIN = false;
    bf16_t* O; int ldc; const float* rot;
    __device__ __forceinline__ void operator()(const f32x4 (&acc)[2][2][4][2], const Unit& u, int wr, int wc, int fr, int fq) const {
        const int row0 = u.pm * BM + wr * 64 + fr, col0 = u.pn * BM + wc * 32 + 8 * fq;
        const bool qk = u.pn < 16; const float sc = (u.pn >= 8 && u.pn < 16) ? 0.0625f : 1.0f;
        const int f0 = (wc * 32 + 8 * fq) & 63; const bool use_row = wc < 2;
#pragma unroll
        for (int ai = 0; ai < 2; ++ai)
#pragma unroll
            for (int m = 0; m < 4; ++m) { const int row = row0 + ai * HALF + m * 16; bf16_t* rowp = O + (size_t)row * ldc + col0;
                float o0[8], o1[8];
#pragma unroll
                for (int n = 0; n < 2; ++n)
#pragma unroll
                    for (int j = 0; j < 4; ++j) { o0[4 * n + j] = acc[ai][0][m][n][j]; o1[4 * n + j] = acc[ai][1][m][n][j]; }
                const int t = row % TB;
                if (qk) {
                    if (t >= CTX) { const int s = t - CTX; const int pos = use_row ? (s >> 6) : (s & 63); const f32x4* rp = (const f32x4*)(rot + ((size_t)pos * 64 + f0) * 2);
#pragma unroll
                        for (int i = 0; i < 4; ++i) { const f32x4 cs = rp[i];
                            const float a0 = o0[2 * i], b0 = o1[2 * i], a1 = o0[2 * i + 1], b1 = o1[2 * i + 1];
                            o0[2 * i] = a0 * cs[0] - b0 * cs[1]; o1[2 * i] = a0 * cs[1] + b0 * cs[0];
                            o0[2 * i + 1] = a1 * cs[2] - b1 * cs[3]; o1[2 * i + 1] = a1 * cs[3] + b1 * cs[2]; } }
#pragma unroll
                    for (int i = 0; i < 8; ++i) { o0[i] *= sc; o1[i] *= sc; }
                }
                *(u32x4*)rowp = pack8(o0); *(u32x4*)(rowp + HALF) = pack8(o1); }
    }
};
struct NormX {
    float* xbuf;
    unsigned* cnt;
    unsigned* tmo;
    __device__ __forceinline__ void publish(const float (&ss)[2][4], const Unit& u, int wr, int wc, int fr, int fq, PG8_LAS unsigned char* lds, int wid, int lane) const {
        PG8_LAS float* P = (PG8_LAS float*)lds;
#pragma unroll
        for (int ai = 0; ai < 2; ++ai)
#pragma unroll
            for (int m = 0; m < 4; ++m) { float q = ss[ai][m]; q += __shfl_xor(q, 16); q += __shfl_xor(q, 32);
                if (fq == 0) P[(ai * HALF + wr * 64 + m * 16 + fr) * 4 + wc] = q; }
        asm volatile("s_waitcnt lgkmcnt(0)" ::: "memory"); __builtin_amdgcn_s_barrier(); asm volatile("" ::: "memory");
        const int row = wid * 32 + (lane & 31);
        if (lane < 32) { const f32x4 pq = *(const PG8_LAS f32x4*)(P + row * 4); const float tot = (pq[0] + pq[1]) + (pq[2] + pq[3]);
            __hip_atomic_store((unsigned*)xbuf + ((size_t)(u.pm * BM + row) * 8 + u.pn), __float_as_uint(tot), __ATOMIC_RELAXED, __HIP_MEMORY_SCOPE_AGENT); }
        asm volatile("s_waitcnt vmcnt(0)" ::: "memory");
        if (lane == 0) __hip_atomic_fetch_add(cnt + 64 * u.pm, 1u, __ATOMIC_RELAXED, __HIP_MEMORY_SCOPE_AGENT);
    }
    __device__ __forceinline__ void finish(const Unit& u, PG8_LAS unsigned char* lds, int wid, int lane) const {
        PG8_LAS float* S = (PG8_LAS float*)(lds + 4096);
        const int row = wid * 32 + (lane & 31);
        if (wid == 0) {
            unsigned sp = 0u;
            while ((unsigned)__builtin_amdgcn_readfirstlane((int)__hip_atomic_load(cnt + 64 * u.pm, __ATOMIC_RELAXED, __HIP_MEMORY_SCOPE_AGENT)) < 64u) {
                __builtin_amdgcn_s_sleep(1);
                if ((++sp & 255u) == 0u) { if (__hip_atomic_load(tmo, __ATOMIC_RELAXED, __HIP_MEMORY_SCOPE_AGENT)) break; if (sp > (1u << 20)) { if (lane == 0) atomicAdd(tmo, 1u); break; } } }
        }
        asm volatile("s_waitcnt vmcnt(0) lgkmcnt(0)" ::: "memory"); __builtin_amdgcn_s_barrier(); asm volatile("" ::: "memory");
        if (lane < 32) { const unsigned* slot = (const unsigned*)xbuf + (size_t)(u.pm * BM + row) * 8; float q = 0.f;
#pragma unroll
            for (int t = 0; t < 8; ++t) q += __uint_as_float(__hip_atomic_load(slot + t, __ATOMIC_RELAXED, __HIP_MEMORY_SCOPE_AGENT));
            S[row] = rsqrtf(q * (1.0f / 2048.0f) + 1e-6f); }
        asm volatile("s_waitcnt lgkmcnt(0)" ::: "memory"); __builtin_amdgcn_s_barrier(); asm volatile("" ::: "memory");
    }
};
struct EpiNorm {
    static constexpr bool PERM = true, AFTER_DRAIN = true;
    bf16_t* H; bf16_t* ABF; float* OUT; const float* gatev; const float* ngy; const float* ngn; const float* shiftv; const float* scalev; bool fin; NormX x1, x2;
    __device__ __forceinline__ void operator()(const f32x4 (&)[2][2][4][2], const Unit&, int, int, int, int) const {}
    __device__ __forceinline__ void fused(f32x4 (&acc)[2][2][4][2], const Unit& u, int wr, int wc, int fr, int fq, PG8_LAS unsigned char* lds, int wid, int lane) const {
        const PG8_LAS float* S = (const PG8_LAS float*)(lds + 4096);
        const int b = u.pm / 17, col0 = u.pn * BM + wc * 32 + 8 * fq;
        float ss[2][4];
#pragma unroll
        for (int ai = 0; ai < 2; ++ai)
#pragma unroll
            for (int m = 0; m < 4; ++m) { float q = 0.f;
#pragma unroll
                for (int bj = 0; bj < 2; ++bj)
#pragma unroll
                    for (int n = 0; n < 2; ++n) { const f32x4 x = acc[ai][bj][m][n]; q += (x[0] * x[0] + x[1] * x[1]) + (x[2] * x[2] + x[3] * x[3]); }
                ss[ai][m] = q; }
        x1.publish(ss, u, wr, wc, fr, fq, lds, wid, lane);
        u32x4 hw[2][4][2];
#pragma unroll
        for (int ai = 0; ai < 2; ++ai)
#pragma unroll
            for (int m = 0; m < 4; ++m)
#pragma unroll
                for (int bj = 0; bj < 2; ++bj) hw[ai][m][bj] = *(const u32x4*)(H + ((size_t)u.pm * BM + ai * HALF + wr * 64 + m * 16 + fr) * D + col0 + bj * HALF);
        f32x4 gy[2][2];
#pragma unroll
        for (int bj = 0; bj < 2; ++bj)
#pragma unroll
            for (int n = 0; n < 2; ++n) { const int c = col0 + bj * HALF + 4 * n; gy[bj][n] = *(const f32x4*)(gatev + (size_t)b * 12288 + c) * *(const f32x4*)(ngy + c); }
        x1.finish(u, lds, wid, lane);
        {
#pragma unroll
            for (int ai = 0; ai < 2; ++ai)
#pragma unroll
                for (int m = 0; m < 4; ++m) { const int r = ai * HALF + wr * 64 + m * 16 + fr; const float rs = S[r]; const size_t grow = (size_t)u.pm * BM + r;
#pragma unroll
                    for (int bj = 0; bj < 2; ++bj) { const u32x4 hq = hw[ai][m][bj];
                        f32x4 h0 = {bflo(hq.x), bfhi(hq.x), bflo(hq.y), bfhi(hq.y)}, h1 = {bflo(hq.z), bfhi(hq.z), bflo(hq.w), bfhi(hq.w)};
                        h0 += gy[bj][0] * (acc[ai][bj][m][0] * rs); h1 += gy[bj][1] * (acc[ai][bj][m][1] * rs);
                        if (fin) { float* o = OUT + ((size_t)b * SEQ + ((u.pm % 17) * BM + r - CTX)) * D + col0 + bj * HALF; *(f32x4*)o = h0; *(f32x4*)(o + 4) = h1; }
                        else { u32x4 w; w.x = pk2(h0[0], h0[1]); w.y = pk2(h0[2], h0[3]); w.z = pk2(h1[0], h1[1]); w.w = pk2(h1[2], h1[3]);
                            *(u32x4*)(H + grow * D + col0 + bj * HALF) = w;
                            acc[ai][bj][m][0] = (f32x4){bflo(w.x), bfhi(w.x), bflo(w.y), bfhi(w.y)}; acc[ai][bj][m][1] = (f32x4){bflo(w.z), bfhi(w.z), bflo(w.w), bfhi(w.w)}; } } }
        }
        if (fin) return;
#pragma unroll
        for (int ai = 0; ai < 2; ++ai)
#pragma unroll
            for (int m = 0; m < 4; ++m) { float q = 0.f;
#pragma unroll
                for (int bj = 0; bj < 2; ++bj)
#pragma unroll
                    for (int n = 0; n < 2; ++n) { const f32x4 x = acc[ai][bj][m][n]; q += (x[0] * x[0] + x[1] * x[1]) + (x[2] * x[2] + x[3] * x[3]); }
                ss[ai][m] = q; }
        x2.publish(ss, u, wr, wc, fr, fq, lds, wid, lane);
        f32x4 an[2][2], sh[2][2];
#pragma unroll
        for (int bj = 0; bj < 2; ++bj)
#pragma unroll
            for (int n = 0; n < 2; ++n) { const int c = col0 + bj * HALF + 4 * n;
                an[bj][n] = *(const f32x4*)(ngn + c) * (*(const f32x4*)(scalev + (size_t)b * 12288 + c) + 1.0f); sh[bj][n] = *(const f32x4*)(shiftv + (size_t)b * 12288 + c); }
        x2.finish(u, lds, wid, lane);
        {
#pragma unroll
            for (int ai = 0; ai < 2; ++ai)
#pragma unroll
                for (int m = 0; m < 4; ++m) { const int r = ai * HALF + wr * 64 + m * 16 + fr; const float rs = S[r]; const size_t grow = (size_t)u.pm * BM + r;
#pragma unroll
                    for (int bj = 0; bj < 2; ++bj) { const f32x4 o0 = (acc[ai][bj][m][0] * rs) * an[bj][0] + sh[bj][0], o1 = (acc[ai][bj][m][1] * rs) * an[bj][1] + sh[bj][1];
                        u32x4 w; w.x = pk2(o0[0], o0[1]); w.y = pk2(o0[2], o0[3]); w.z = pk2(o1[0], o1[1]); w.w = pk2(o1[2], o1[3]);
                        *(u32x4*)(ABF + grow * D + col0 + bj * HALF) = w; } }
        }
    }
};
}

#define XB_TMO      128
#define XB_XCNT(j)  (256  + 64 * (j))
#define XB_XSUB(j)  (1280 + 64 * (j))
#define XB_XGEN(j)  (2304 + 64 * (j))
#define XB_TOP      3328
#define XB_TOPGEN   3392
#define XCD_BAR_WORDS 3456
#define XB_SPIN_CAP (1u << 20)
__device__ __forceinline__ unsigned xb_ld(unsigned* p)              { return __hip_atomic_load(p, __ATOMIC_RELAXED, __HIP_MEMORY_SCOPE_AGENT); }
__device__ __forceinline__ unsigned xb_add(unsigned* p, unsigned v) { return __hip_atomic_fetch_add(p, v, __ATOMIC_RELAXED, __HIP_MEMORY_SCOPE_AGENT); }
__device__ __forceinline__ unsigned xb_xcc_id() { return (unsigned)__builtin_amdgcn_s_getreg((3 << 11) | 20) & 0xFu; }
#define XB_SPIN(cond, bar) do { unsigned _sp = 0; while (cond) { __builtin_amdgcn_s_sleep(1); \
    if ((++_sp & 255u) == 0u) { if (xb_ld(&(bar)[XB_TMO])) break; if (_sp > XB_SPIN_CAP) { atomicAdd(&(bar)[XB_TMO], 1u); break; } } } } while (0)
struct XcdBarrier { unsigned* bar; unsigned x; volatile LAS unsigned* st; };
__device__ __forceinline__ XcdBarrier xcd_barrier_post(unsigned* bar, volatile LAS unsigned* st) {
    XcdBarrier b; b.bar = bar; b.x = xb_xcc_id(); b.st = st;
    if (threadIdx.x == 0) (void)xb_add(&bar[XB_XCNT(b.x)], 1u);
    return b;
}
__device__ __forceinline__ void xcd_barrier_complete(unsigned* bar, unsigned x, unsigned& nloc, unsigned& nx) {
    const unsigned G = gridDim.x * gridDim.y * gridDim.z;
    unsigned sum, cnt, mine, sp = 0u;
    for (;;) {
        sum = 0u; cnt = 0u; mine = 0u;
#pragma unroll
        for (unsigned j = 0; j < 16; ++j) { const unsigned c = xb_ld(&bar[XB_XCNT(j)]); sum += c; cnt += (c > 0u) ? 1u : 0u; mine = (j == x) ? c : mine; }
        if (sum == G) break;
        __builtin_amdgcn_s_sleep(1);
        if ((++sp & 255u) == 0u) { if (xb_ld(&bar[XB_TMO])) break; if (sp > XB_SPIN_CAP) { atomicAdd(&bar[XB_TMO], 1u); break; } }
    }
    nloc = mine > 0u ? mine : 1u; nx = cnt > 0u ? cnt : 1u;
}
__device__ __forceinline__ void xcd_barrier(const XcdBarrier& b) {
    asm volatile("s_waitcnt vmcnt(0)" ::: "memory");
    __syncthreads();
    if (threadIdx.x == 0) {
        unsigned* bar = b.bar;
        __builtin_amdgcn_s_waitcnt(0);
        unsigned nloc = b.st[0], nx = b.st[1];
        if (nloc == 0u) { xcd_barrier_complete(bar, b.x, nloc, nx); b.st[0] = nloc; b.st[1] = nx; }
        const unsigned old = xb_add(&bar[XB_XSUB(b.x)], 1u);
        const unsigned gen = old / nloc;
        if (old + 1u == (gen + 1u) * nloc) {
            __builtin_amdgcn_fence(__ATOMIC_RELEASE, "agent");
            asm volatile("s_waitcnt vmcnt(0)" ::: "memory");
            __builtin_amdgcn_fence(__ATOMIC_ACQUIRE, "agent");
            const unsigned og = xb_add(&bar[XB_TOP], 1u);
            const unsigned tg = og / nx;
            if (og + 1u == (tg + 1u) * nx) xb_add(&bar[XB_TOPGEN], 1u);
            else XB_SPIN(xb_ld(&bar[XB_TOPGEN]) == tg, bar);
            xb_add(&bar[XB_XGEN(b.x)], 1u);
            asm volatile("s_waitcnt vmcnt(0)" ::: "memory");
        } else {
            __builtin_amdgcn_fence(__ATOMIC_ACQUIRE, "agent");
            XB_SPIN(xb_ld(&bar[XB_XGEN(b.x)]) == gen, bar);
            asm volatile("s_waitcnt vmcnt(0)" ::: "memory");
        }
    }
    __syncthreads();
}

struct Args {
    const float* in[27];
    float* out; unsigned char* ws;
    int ph_lo, ph_hi;
};
enum { I_X = 0, I_C, I_CTX, I_CCTX, I_MODW, I_MODB, I_NG, I_FWI, I_FWO, I_ABWI, I_ABWO, I_MU, I_W0, I_W2, I_A0, I_A2, I_G2, I_KK, I_KA, I_RK, I_LNW, I_LNB, I_GKUP, I_GKB, I_GLAG, I_RWI, I_RWO };

struct Fr {
    LAS unsigned char* lds; int tid, lane, wave, vcu, G;
};

__device__ __forceinline__ int dst_row(int n, int mode) {
    if (mode == 0) return n;
    return n < DFF ? 256 * (n / 128) + (n % 128) : 256 * ((n - DFF) / 128) + 128 + ((n - DFF) % 128);
}
__device__ __forceinline__ void conv_job(const Fr& F, const float* W, int K, int N, int Npad, bf16* WT, int mode, int wgi, int nWG) {
    LAS float* scr = (LAS float*)F.lds;
    const int tid = F.tid, ntn = Npad / 128, nitems = (K / 128) * ntn;
    const int lr = tid >> 5, lc = 4 * (tid & 31);
    f32x4 reg[8];
    int it = wgi;
    if (it < nitems) { const int k0 = (it / ntn) * 128, n0 = (it % ntn) * 128;
#pragma unroll
        for (int i = 0; i < 8; ++i) reg[i] = (n0 + lc < N) ? __builtin_nontemporal_load((const f32x4*)(W + (size_t)(k0 + lr + 16 * i) * N + n0 + lc)) : (f32x4){0.f, 0.f, 0.f, 0.f}; }
    while (it < nitems) {
        const int k0 = (it / ntn) * 128, n0 = (it % ntn) * 128;
#pragma unroll
        for (int i = 0; i < 8; ++i) *(LAS f32x4*)(scr + (lr + 16 * i) * 132 + lc) = reg[i];
        __syncthreads();
        const int nxt = it + nWG;
        if (nxt < nitems) { const int k1 = (nxt / ntn) * 128, n1 = (nxt % ntn) * 128;
#pragma unroll
            for (int i = 0; i < 8; ++i) reg[i] = (n1 + lc < N) ? __builtin_nontemporal_load((const f32x4*)(W + (size_t)(k1 + lr + 16 * i) * N + n1 + lc)) : (f32x4){0.f, 0.f, 0.f, 0.f}; }
        { const int c = tid & 15;
#pragma unroll
          for (int j = 0; j < 4; ++j) { const int n = (tid >> 4) + 32 * j; const LAS float* sp = scr + (8 * c) * 132 + n;
              u32x4 o; o.x = pk2(sp[0], sp[132]); o.y = pk2(sp[2 * 132], sp[3 * 132]); o.z = pk2(sp[4 * 132], sp[5 * 132]); o.w = pk2(sp[6 * 132], sp[7 * 132]);
              __builtin_nontemporal_store(o, (u32x4*)(WT + (size_t)dst_row(n0 + n, mode) * K + k0 + 8 * c)); } }
        __syncthreads();
        it = nxt;
    }
}
struct ConvJob { const float* W; bf16* WT; int K, N, Npad, mode; };
__device__ __forceinline__ void conv_jobs(const Fr& F, const Args& a, int jlo, int jhi, int wgi, int nWG) {
    unsigned char* ws = a.ws;
    ConvJob jobs[8];
    jobs[0] = {a.in[I_ABWI], (bf16*)(ws + WS_WAB), D, ABCOLS, ZLD0, 0};
    jobs[1] = {a.in[I_ABWO], (bf16*)(ws + WS_WO0), D, D, D, 0};
    jobs[2] = {a.in[I_FWI], (bf16*)(ws + WS_WFI0), D, 2 * DFF, 2 * DFF, 1};
    jobs[3] = {a.in[I_FWO], (bf16*)(ws + WS_WFO0), DFF, D, D, 0};
    jobs[4] = {a.in[I_RWI], (bf16*)(ws + WS_WRI), D, RETC, RETC, 0};
    jobs[5] = {a.in[I_RWO], (bf16*)(ws + WS_WRO), 2 * D, D, D, 0};
    jobs[6] = {a.in[I_FWI] + (size_t)D * 2 * DFF, (bf16*)(ws + WS_WFI1), D, 2 * DFF, 2 * DFF, 1};
    jobs[7] = {a.in[I_FWO] + (size_t)DFF * D, (bf16*)(ws + WS_WFO1), DFF, D, D, 0};
#pragma unroll
    for (int j = 0; j < 8; ++j) {
        if (j < jlo || j >= jhi) continue;
        conv_job(F, jobs[j].W, jobs[j].K, jobs[j].N, jobs[j].Npad, jobs[j].WT, jobs[j].mode, wgi, nWG);
    }
}
__device__ __forceinline__ void conv_dyn(const Fr& F, const Args& a, unsigned* qhead, int jlo, int jhi, int tlo = 0, int thi = -1) {
    unsigned char* ws = a.ws;
    LAS float* scr = (LAS float*)F.lds; volatile LAS int* slot = (volatile LAS int*)(F.lds + 128 * 132 * 4);
    const int tid = F.tid, lr = tid >> 5, lc = 4 * (tid & 31);
    constexpr int NT[8] = {(D / 128) * (ZLD0 / 128), (D / 128) * (D / 128), (D / 128) * (2 * DFF / 128), (DFF / 128) * (D / 128), (D / 128) * (RETC / 128), (2 * D / 128) * (D / 128), (D / 128) * (2 * DFF / 128), (DFF / 128) * (D / 128)};
    int total = 0;
#pragma unroll
    for (int j = 0; j < 8; ++j) if (j >= jlo && j < jhi) total += NT[j];
    if (thi >= 0) total = thi;
    const float* W = nullptr; bf16* WT = nullptr; int K = 0, N = 0, Np = 0, mode = 0, k0 = 0, n0 = 0;
    auto decode = [&](int it) {
        int li = it, job = jlo;
#pragma unroll
        for (int j = 0; j < 8; ++j) if (j >= jlo && j < jhi - 1 && job == j && li >= NT[j]) { li -= NT[j]; job = j + 1; }
        switch (job) {
            case 0: W = a.in[I_ABWI]; WT = (bf16*)(ws + WS_WAB); K = D; N = ABCOLS; Np = ZLD0; mode = 0; break;
            case 1: W = a.in[I_ABWO]; WT = (bf16*)(ws + WS_WO0); K = D; N = D; Np = D; mode = 0; break;
            case 2: W = a.in[I_FWI]; WT = (bf16*)(ws + WS_WFI0); K = D; N = 2 * DFF; Np = 2 * DFF; mode = 1; break;
            case 3: W = a.in[I_FWO]; WT = (bf16*)(ws + WS_WFO0); K = DFF; N = D; Np = D; mode = 0; break;
            case 4: W = a.in[I_RWI]; WT = (bf16*)(ws + WS_WRI); K = D; N = RETC; Np = RETC; mode = 0; break;
            case 5: W = a.in[I_RWO]; WT = (bf16*)(ws + WS_WRO); K = 2 * D; N = D; Np = D; mode = 0; break;
            case 6: W = a.in[I_FWI] + (size_t)D * 2 * DFF; WT = (bf16*)(ws + WS_WFI1); K = D; N = 2 * DFF; Np = 2 * DFF; mode = 1; break;
            default: W = a.in[I_FWO] + (size_t)DFF * D; WT = (bf16*)(ws + WS_WFO1); K = DFF; N = D; Np = D; mode = 0; break;
        }
        const int ntn = Np / 128; k0 = (li / ntn) * 128; n0 = (li % ntn) * 128; };
    f32x4 reg[8];
    if (tid == 0) slot[0] = tlo + (int)atomicAdd(qhead, 1u);
    __syncthreads();
    int cur = slot[0];
    __syncthreads();
    if (cur < total) { decode(cur);
#pragma unroll
        for (int i = 0; i < 8; ++i) reg[i] = (n0 + lc < N) ? __builtin_nontemporal_load((const f32x4*)(W + (size_t)(k0 + lr + 16 * i) * N + n0 + lc)) : (f32x4){0.f, 0.f, 0.f, 0.f}; }
    while (cur < total) {
        const int ck0 = k0, cn0 = n0, cK = K, cmode = mode; bf16* cWT = WT;
#pragma unroll
        for (int i = 0; i < 8; ++i) *(LAS f32x4*)(scr + (lr + 16 * i) * 132 + lc) = reg[i];
        if (tid == 0) slot[0] = tlo + (int)atomicAdd(qhead, 1u);
        __syncthreads();
        const int nxt = slot[0];
        if (nxt < total) { decode(nxt);
#pragma unroll
            for (int i = 0; i < 8; ++i) reg[i] = (n0 + lc < N) ? __builtin_nontemporal_load((const f32x4*)(W + (size_t)(k0 + lr + 16 * i) * N + n0 + lc)) : (f32x4){0.f, 0.f, 0.f, 0.f}; }
        { const int c = tid & 15;
#pragma unroll
          for (int j = 0; j < 4; ++j) { const int n = (tid >> 4) + 32 * j; const LAS float* sp = scr + (8 * c) * 132 + n;
              u32x4 o; o.x = pk2(sp[0], sp[132]); o.y = pk2(sp[2 * 132], sp[3 * 132]); o.z = pk2(sp[4 * 132], sp[5 * 132]); o.w = pk2(sp[6 * 132], sp[7 * 132]);
              __builtin_nontemporal_store(o, (u32x4*)(cWT + (size_t)dst_row(cn0 + n, cmode) * cK + ck0 + 8 * c)); } }
        __syncthreads();
        cur = nxt;
    }
}
__device__ __forceinline__ void p0_prologue(const Fr& F, const Args& a) {
    unsigned char* ws = a.ws;
    conv_jobs(F, a, 0, 1, F.vcu, F.G);
    {
        bf16* WL = (bf16*)(ws + WS_WLO); const float* w2 = a.in[I_W2]; const float* a2 = a.in[I_A2]; const float* g2 = a.in[I_G2];
        for (int idx = F.vcu * NTHR + F.tid; idx < 4096 * 64; idx += F.G * NTHR) {
            const int n = idx & 4095, k0 = (idx >> 12) * 8;
            const int seg = n >> 10, c = n & 1023; float v[8];
#pragma unroll
            for (int j = 0; j < 8; ++j) { const int k = k0 + j; float x = 0.f;
                if (seg < 2) { if (k < 96) x = w2[((size_t)seg * 96 + k) * MIXA + c]; }
                else if (seg == 2) { if (k >= 128 && k < 224) x = a2[(size_t)(k - 128) * MIXA + c]; }
                else { if (k >= 256) x = g2[(size_t)(k - 256) * MIXA + c]; }
                v[j] = x; }
            *(u32x4*)(WL + (size_t)n * 512 + k0) = pack8(v);
        }
    }
    {
        float* rot = (float*)(ws + WS_ROT);
        for (int idx = F.vcu * NTHR + F.tid; idx < 4096; idx += F.G * NTHR) {
            const int pos = idx >> 6, f = idx & 63;
            const float inv = exp2f(-(float)f * (13.287712379549449f / 64.0f));
            const float rev = (float)pos * inv * 0.15915494309189535f;
            rot[2 * idx] = __builtin_amdgcn_cosf(rev); rot[2 * idx + 1] = __builtin_amdgcn_sinf(rev);
        }
    }
    {
        LAS float* sv = (LAS float*)F.lds;
        LAS float* red = sv + 3 * 2048;
        { float xs[12];
#pragma unroll
          for (int it = 0; it < 12; ++it) { const int i = F.tid + it * NTHR; const int w = it >> 2, k = i & 2047; xs[it] = (w < 2) ? a.in[I_C][w * D + k] : a.in[I_CCTX][k]; }
#pragma unroll
          for (int it = 0; it < 12; ++it) sv[F.tid + it * NTHR] = fsilu(xs[it]); }
        __syncthreads();
        float* modv = (float*)(ws + WS_MODV);
        for (int slab = F.vcu; slab < 256; slab += F.G) {
            const int l = slab >> 7, col0 = (slab & 127) * 96;
            const float* Wm = a.in[I_MODW] + (size_t)l * D * 12288;
            const int cq = F.tid % 24, kg = F.tid / 24;
            f32x4 a0 = {0, 0, 0, 0}, a1 = {0, 0, 0, 0}, a2v = {0, 0, 0, 0};
            if (kg < 21) {
#pragma unroll 1
                for (int i0 = 0; i0 < 98; i0 += 7) { f32x4 wv[7];
#pragma unroll
                    for (int j = 0; j < 7; ++j) { const int k = kg + 21 * (i0 + j), kc = k < D ? k : D - 1;
                        wv[j] = __builtin_nontemporal_load((const f32x4*)(Wm + (size_t)kc * 12288 + col0 + 4 * cq)); }
#pragma unroll
                    for (int j = 0; j < 7; ++j) { const int k = kg + 21 * (i0 + j), kc = k < D ? k : D - 1; const float z = k < D ? 1.0f : 0.0f;
                        a0 += wv[j] * (sv[kc] * z); a1 += wv[j] * (sv[2048 + kc] * z); a2v += wv[j] * (sv[4096 + kc] * z); } }
#pragma unroll
                for (int j = 0; j < 4; ++j) { red[(kg * 3 + 0) * 96 + 4 * cq + j] = a0[j]; red[(kg * 3 + 1) * 96 + 4 * cq + j] = a1[j]; red[(kg * 3 + 2) * 96 + 4 * cq + j] = a2v[j]; }
            }
            __syncthreads();
            if (F.tid < 288) { const int w = F.tid / 96, cc = F.tid % 96; float s = 0.f;
                for (int g = 0; g < 21; ++g) s += red[(g * 3 + w) * 96 + cc];
                modv[((size_t)l * 3 + w) * 12288 + col0 + cc] = s + a.in[I_MODB][l * 12288 + col0 + cc]; }
            __syncthreads();
        }
    }
}

struct Row { f32x4 v[8]; };
__device__ __forceinline__ void row_load(Row& r, const float* p, int lane) {
#pragma unroll
    for (int j = 0; j < 8; ++j) r.v[j] = *(const f32x4*)(p + 4 * lane + 256 * j);
}
__device__ __forceinline__ float row_rstd(const Row& r) {
    float s = 0.f;
#pragma unroll
    for (int j = 0; j < 8; ++j) s += (r.v[j][0] * r.v[j][0] + r.v[j][1] * r.v[j][1]) + (r.v[j][2] * r.v[j][2] + r.v[j][3] * r.v[j][3]);
    return rsqrtf(wave_sum(s) * (1.0f / D) + RMS_EPS);
}
struct RowVecs { f32x4 gy[8], an[8], sh[8]; int cached; };
template <bool CTXROW>
__device__ __forceinline__ void rows_row(const Fr& F, const Args& a, int m, int mode, int nsplit, bool hprev_is_input, const float* ngy, const float* gatev, bool fin, const float* ngn,
                                         const float* shiftv, const float* scalev, RowVecs& C) {
    unsigned char* ws = a.ws;
    bf16* H = (bf16*)(ws + WS_H); const bf16* Y = (const bf16*)(ws + WS_MIX + MX_Y); float* YC = (float*)(ws + WS_YC); bf16* ABF = (bf16*)a.out;
    const int lane = F.lane;
    const int b = m / TB, t = m % TB, which = CTXROW ? 2 : b;
    Row y; bool ysum = false;
    if (CTXROW && mode == 1 && nsplit > 0) { ysum = true;
        const float* yc = YC + ((size_t)b * CTX + t) * D;
#pragma unroll
        for (int j = 0; j < 8; ++j) y.v[j] = (f32x4){0.f, 0.f, 0.f, 0.f};
#pragma unroll 1
        for (int sp = 0; sp < nsplit; sp += 4) { Row q0, q1, q2, q3;
            row_load(q0, yc + (size_t)sp * NB * CTX * D, lane);
            if (sp + 1 < nsplit) row_load(q1, yc + (size_t)(sp + 1) * NB * CTX * D, lane);
            if (sp + 2 < nsplit) row_load(q2, yc + (size_t)(sp + 2) * NB * CTX * D, lane);
            if (sp + 3 < nsplit) row_load(q3, yc + (size_t)(sp + 3) * NB * CTX * D, lane);
#pragma unroll
            for (int j = 0; j < 8; ++j) { f32x4 acc4 = q0.v[j];
                if (sp + 1 < nsplit) acc4 += q1.v[j];
                if (sp + 2 < nsplit) acc4 += q2.v[j];
                if (sp + 3 < nsplit) acc4 += q3.v[j];
                y.v[j] += acc4; } }
    }
    if (CTXROW || which != C.cached) { C.cached = which;
        if (mode == 1) { const float* gp = gatev + (size_t)which * 12288;
#pragma unroll
            for (int j = 0; j < 8; ++j) C.gy[j] = *(const f32x4*)(gp + 4 * lane + 256 * j) * *(const f32x4*)(ngy + 4 * lane + 256 * j); }
        if (!fin) { const float* sp = shiftv + (size_t)which * 12288; const float* cp = scalev + (size_t)which * 12288;
#pragma unroll
            for (int j = 0; j < 8; ++j) { C.an[j] = *(const f32x4*)(ngn + 4 * lane + 256 * j) * (*(const f32x4*)(cp + 4 * lane + 256 * j) + 1.0f); C.sh[j] = *(const f32x4*)(sp + 4 * lane + 256 * j); } }
    }
    const float* h0 = CTXROW ? a.in[I_CTX] + ((size_t)b * CTX + t) * D : a.in[I_X] + ((size_t)b * SEQ + (t - CTX)) * D;
    Row h;
    if (mode == 0 || hprev_is_input) row_load(h, h0, lane);
    else {
#pragma unroll
        for (int j = 0; j < 8; ++j) { const u32x2 hw = *(const u32x2*)(H + (size_t)m * D + 4 * lane + 256 * j); h.v[j] = (f32x4){bflo(hw.x), bfhi(hw.x), bflo(hw.y), bfhi(hw.y)}; } }
    if (mode == 1) {
        if (!ysum) {
#pragma unroll
            for (int j = 0; j < 8; ++j) { const u32x2 yw = *(const u32x2*)(Y + (size_t)m * D + 4 * lane + 256 * j); y.v[j] = (f32x4){bflo(yw.x), bfhi(yw.x), bflo(yw.y), bfhi(yw.y)}; } }
        const float rs = row_rstd(y);
#pragma unroll
        for (int j = 0; j < 8; ++j) h.v[j] += C.gy[j] * (y.v[j] * rs);
        if (!fin) {
#pragma unroll
            for (int j = 0; j < 8; ++j) { u32x2 hw; hw.x = pk2(h.v[j][0], h.v[j][1]); hw.y = pk2(h.v[j][2], h.v[j][3]); *(u32x2*)(H + (size_t)m * D + 4 * lane + 256 * j) = hw;
                h.v[j] = (f32x4){bflo(hw.x), bfhi(hw.x), bflo(hw.y), bfhi(hw.y)}; }
        }
    }
    if (fin) {
        float* o = a.out + ((size_t)b * SEQ + (t - CTX)) * D;
#pragma unroll
        for (int j = 0; j < 8; ++j) *(f32x4*)(o + 4 * lane + 256 * j) = h.v[j];
    } else {
        const float rs = row_rstd(h);
#pragma unroll
        for (int j = 0; j < 8; ++j) { const f32x4 o = (h.v[j] * rs) * C.an[j] + C.sh[j];
            u32x2 w; w.x = pk2(o[0], o[1]); w.y = pk2(o[2], o[3]);
            *(u32x2*)(ABF + (size_t)m * D + 4 * lane + 256 * j) = w; }
    }
}
__device__ __forceinline__ void rows_phase(const Fr& F, const Args& a, int mode, int nsplit, bool hprev_is_input, const float* ngy, const float* gatev  ,
                                           bool fin, const float* ngn, const float* shiftv, const float* scalev) {
    const int gw = F.vcu * NWAVES + F.wave, NGW = F.G * NWAVES;
    RowVecs C; C.cached = -1;
    if (NGW == 2048) {
        const int grp = gw & 3, q = gw >> 2;
        int l0, ln;
        if (grp == 0) { l0 = 2 * q; ln = 2; if (!fin) rows_row<true>(F, a, (q >> 8) * TB + (q & 255), mode, nsplit, hprev_is_input, ngy, gatev, fin, ngn, shiftv, scalev, C); }
        else if (grp == 3) { l0 = 6144 + 4 * q; ln = 4; }
        else { l0 = 1024 + 5 * (2 * q + (grp - 1)); ln = 5; }
        for (int i = 0; i < ln; ++i) { const int li = l0 + i; rows_row<false>(F, a, (li >> 12) * TB + CTX + (li & 4095), mode, nsplit, hprev_is_input, ngy, gatev, fin, ngn, shiftv, scalev, C); }
    } else {
        if (!fin) { for (int m = gw; m < M; m += NGW) { if ((m % TB) < CTX) rows_row<true>(F, a, m, mode, nsplit, hprev_is_input, ngy, gatev, fin, ngn, shiftv, scalev, C); } }
        for (int m = gw; m < M; m += NGW) { if ((m % TB) >= CTX) rows_row<false>(F, a, m, mode, nsplit, hprev_is_input, ngy, gatev, fin, ngn, shiftv, scalev, C); }
    }
}

__device__ __forceinline__ void load16s(const bf16* p, bool ok, float (&o)[16]) {
    if (ok) { float t[8]; unpack8(*(const u32x4*)p, t);
#pragma unroll
        for (int i = 0; i < 8; ++i) o[i] = t[i];
        unpack8(*(const u32x4*)(p + 8), t);
#pragma unroll
        for (int i = 0; i < 8; ++i) o[8 + i] = t[i];
    } else {
#pragma unroll
        for (int i = 0; i < 16; ++i) o[i] = 0.f;
    }
}
struct Raw16 { u32x4 a, b; };
__device__ __forceinline__ Raw16 ld16raw(const bf16* p, bool ok) { Raw16 r; const u32x4 z = {0u, 0u, 0u, 0u}; r.a = ok ? *(const u32x4*)p : z; r.b = ok ? *(const u32x4*)(p + 8) : z; return r; }
__device__ __forceinline__ void unpack16(const Raw16& r, float (&o)[16]) { float t[8]; unpack8(r.a, t);
#pragma unroll
    for (int i = 0; i < 8; ++i) o[i] = t[i];
    unpack8(r.b, t);
#pragma unroll
    for (int i = 0; i < 8; ++i) o[8 + i] = t[i]; }
__device__ __forceinline__ void store16(bf16* p, const float (&v)[16]) {
    float t[8];
#pragma unroll
    for (int i = 0; i < 8; ++i) t[i] = v[i];
    *(u32x4*)p = pack8(t);
#pragma unroll
    for (int i = 0; i < 8; ++i) t[i] = v[8 + i];
    *(u32x4*)(p + 8) = pack8(t);
}
__device__ __forceinline__ void prep_phase(const Fr& F, const Args& a) {
    unsigned char* ws = a.ws;
    const bf16* Z = (const bf16*)(ws + WS_ZR);
    bf16* R = (bf16*)(ws + WS_MIX + MX_R); bf16* V = (bf16*)(ws + WS_MIX + MX_V); bf16* Kr = (bf16*)(ws + WS_MIX + MX_K); bf16* KK = (bf16*)(ws + WS_MIX + MX_KK);
    bf16* AL = (bf16*)(ws + WS_MIX + MX_ALO);
    const float* mu = a.in[I_MU]; const float* k_k = a.in[I_KK];
    const int gw = F.wave * F.G + F.vcu, NGW = F.G * NWAVES, lane = F.lane;
    for (int m = gw; m < M; m += NGW) {
        const int t = m % TB;
        const bool hp = (t != 0) && (t != CTX), hn = (t != CTX - 1) && (t != TB - 1);
        const bf16* z = Z + (size_t)m * ZLD0; const bf16* zp = z - ZLD0; const bf16* zn = z + ZLD0;
        Raw16 rc[3], rl[3], rr[3];
#pragma unroll
        for (int sec = 0; sec < 3; ++sec) { const int c0 = sec * MIXA + 16 * lane; rc[sec] = ld16raw(z + c0, true); rl[sec] = ld16raw(zp + c0, hp); rr[sec] = ld16raw(zn + c0, hn); }
        const u32x4 zero4 = {0u, 0u, 0u, 0u};
        const int lcol = 3072 + 8 * (lane < 56 ? lane : 0);
        const u32x4 lc = *(const u32x4*)(z + lcol), ll = hp ? *(const u32x4*)(zp + lcol) : zero4, lr = hn ? *(const u32x4*)(zn + lcol) : zero4;
#pragma unroll
        for (int sec = 0; sec < 3; ++sec) {
            const int c0 = sec * MIXA + 16 * lane;
            float zc[16], zl[16], zr[16], o[16];
            unpack16(rc[sec], zc); unpack16(rl[sec], zl); unpack16(rr[sec], zr);
#pragma unroll
            for (int q = 0; q < 4; ++q) { const f32x4 mv = *(const f32x4*)(mu + c0 + 4 * q);
#pragma unroll
                for (int i = 0; i < 4; ++i) { const int e = 4 * q + i; o[e] = zc[e] + (0.5f * (zl[e] + zr[e]) - zc[e]) * mv[i]; } }
            if (sec == 0) store16(R + (size_t)m * MIXA + 16 * lane, o);
            else if (sec == 2) store16(V + (size_t)m * MIXA + 16 * lane, o);
            else {
                store16(Kr + (size_t)m * MIXA + 16 * lane, o);
                float kq[16]; float ss = 0.f;
#pragma unroll
                for (int q = 0; q < 4; ++q) { const f32x4 kv = *(const f32x4*)(k_k + 16 * lane + 4 * q);
#pragma unroll
                    for (int i = 0; i < 4; ++i) { const int e = 4 * q + i; kq[e] = o[e] * kv[i]; ss += kq[e] * kq[e]; } }
                ss = quad_sum(ss);
                const float inv = 1.0f / fmaxf(sqrtf(ss), 1e-12f);
#pragma unroll
                for (int e = 0; e < 16; ++e) kq[e] *= inv;
                store16(KK + (size_t)m * MIXA + 16 * lane, kq);
            }
        }
        bf16* al = AL + (size_t)m * 512;
        if (lane < 56) {
            float c8[8], l8[8], r8[8], v[8]; unpack8(lc, c8); unpack8(ll, l8); unpack8(lr, r8);
            const f32x4 m0 = *(const f32x4*)(mu + lcol), m1 = *(const f32x4*)(mu + lcol + 4);
#pragma unroll
            for (int e = 0; e < 8; ++e) { const float x = c8[e] + (0.5f * (l8[e] + r8[e]) - c8[e]) * (e < 4 ? m0[e & 3] : m1[e & 3]);
                v[e] = lane < 12 ? tanhf(x) : (lane < 24 ? x : fsigmoid(x)); }
            bf16* dst = lane < 12 ? al + 8 * lane : (lane < 24 ? al + 128 + 8 * (lane - 12) : al + 256 + 8 * (lane - 24));
            *(u32x4*)dst = pack8(v);
        } else { bf16* dst = lane < 60 ? al + 96 + 8 * (lane - 56) : al + 224 + 8 * (lane - 60); *(u32x4*)dst = zero4; }
    }
}

template <int KS>
__device__ __forceinline__ void mma16(f32x4& acc, const LAS bf16* A, int lda, int arow, const LAS bf16* Bt, int ldb, int brow, int lane) {
    const LAS bf16* ap = A + (size_t)(arow + (lane & 15)) * lda + 8 * (lane >> 4);
    const LAS bf16* bp = Bt + (size_t)(brow + (lane & 15)) * ldb + 8 * (lane >> 4);
#pragma unroll
    for (int ks = 0; ks < KS; ++ks) {
        const bf16x8 av = *(const LAS bf16x8*)(ap + ks * 32), bv = *(const LAS bf16x8*)(bp + ks * 32);
        acc = __builtin_amdgcn_mfma_f32_16x16x32_bf16(av, bv, acc, 0, 0, 0);
    }
}
template <int LD>
__device__ __forceinline__ void tr_frags64(const LAS bf16* T, int col0, int lane, bf16x8& f0, bf16x8& f1) {
    const unsigned addr = (unsigned)(size_t)(T + (8 * (lane >> 4) + ((lane & 15) >> 2)) * LD + col0 + 4 * (lane & 3));
    u32x2 a0, a1, a2, a3;
    asm volatile("ds_read_b64_tr_b16 %0, %4\n\tds_read_b64_tr_b16 %1, %4 offset:%5\n\tds_read_b64_tr_b16 %2, %4 offset:%6\n\tds_read_b64_tr_b16 %3, %4 offset:%7\n\ts_waitcnt lgkmcnt(0)\n\ts_nop 1"
                 : "=&v"(a0), "=&v"(a1), "=&v"(a2), "=&v"(a3) : "v"(addr), "i"(4 * LD * 2), "i"(32 * LD * 2), "i"(36 * LD * 2) : "memory");
    const u32x4 w0 = {a0.x, a0.y, a1.x, a1.y}, w1 = {a2.x, a2.y, a3.x, a3.y};
    f0 = __builtin_bit_cast(bf16x8, w0); f1 = __builtin_bit_cast(bf16x8, w1);
}
template <int LD>
__device__ __forceinline__ void tr_frags64x2(const LAS bf16* T0, int c0, const LAS bf16* T1, int c1, int lane, bf16x8 (&f)[2][2]) {
    const int ro = (8 * (lane >> 4) + ((lane & 15) >> 2)) * LD + 4 * (lane & 3);
    const unsigned a0 = (unsigned)(size_t)(T0 + ro + c0), a1 = (unsigned)(size_t)(T1 + ro + c1);
    u32x2 r[8];
    asm volatile("ds_read_b64_tr_b16 %0, %8\n\tds_read_b64_tr_b16 %1, %8 offset:%10\n\tds_read_b64_tr_b16 %2, %8 offset:%11\n\tds_read_b64_tr_b16 %3, %8 offset:%12\n\t"
                 "ds_read_b64_tr_b16 %4, %9\n\tds_read_b64_tr_b16 %5, %9 offset:%10\n\tds_read_b64_tr_b16 %6, %9 offset:%11\n\tds_read_b64_tr_b16 %7, %9 offset:%12\n\ts_waitcnt lgkmcnt(0)\n\ts_nop 1"
                 : "=&v"(r[0]), "=&v"(r[1]), "=&v"(r[2]), "=&v"(r[3]), "=&v"(r[4]), "=&v"(r[5]), "=&v"(r[6]), "=&v"(r[7])
                 : "v"(a0), "v"(a1), "i"(4 * LD * 2), "i"(32 * LD * 2), "i"(36 * LD * 2) : "memory");
#pragma unroll
    for (int i = 0; i < 2; ++i) { const u32x4 w0 = {r[4 * i].x, r[4 * i].y, r[4 * i + 1].x, r[4 * i + 1].y}, w1 = {r[4 * i + 2].x, r[4 * i + 2].y, r[4 * i + 3].x, r[4 * i + 3].y};
        f[i][0] = __builtin_bit_cast(bf16x8, w0); f[i][1] = __builtin_bit_cast(bf16x8, w1); }
}
template <int LD>
__device__ __forceinline__ void tr_frags64x4(const LAS bf16* T0, int c0, const LAS bf16* T1, int c1, const LAS bf16* T2, int c2, const LAS bf16* T3, int c3, int lane, bf16x8 (&f)[4][2]) {
    const int ro = (8 * (lane >> 4) + ((lane & 15) >> 2)) * LD + 4 * (lane & 3);
    const unsigned a0 = (unsigned)(size_t)(T0 + ro + c0), a1 = (unsigned)(size_t)(T1 + ro + c1), a2 = (unsigned)(size_t)(T2 + ro + c2), a3 = (unsigned)(size_t)(T3 + ro + c3);
    u32x2 r[16];
    asm volatile("ds_read_b64_tr_b16 %0, %16\n\tds_read_b64_tr_b16 %1, %16 offset:%20\n\tds_read_b64_tr_b16 %2, %16 offset:%21\n\tds_read_b64_tr_b16 %3, %16 offset:%22\n\t"
                 "ds_read_b64_tr_b16 %4, %17\n\tds_read_b64_tr_b16 %5, %17 offset:%20\n\tds_read_b64_tr_b16 %6, %17 offset:%21\n\tds_read_b64_tr_b16 %7, %17 offset:%22\n\t"
                 "ds_read_b64_tr_b16 %8, %18\n\tds_read_b64_tr_b16 %9, %18 offset:%20\n\tds_read_b64_tr_b16 %10, %18 offset:%21\n\tds_read_b64_tr_b16 %11, %18 offset:%22\n\t"
                 "ds_read_b64_tr_b16 %12, %19\n\tds_read_b64_tr_b16 %13, %19 offset:%20\n\tds_read_b64_tr_b16 %14, %19 offset:%21\n\tds_read_b64_tr_b16 %15, %19 offset:%22\n\ts_waitcnt lgkmcnt(0)\n\ts_nop 1"
                 : "=&v"(r[0]), "=&v"(r[1]), "=&v"(r[2]), "=&v"(r[3]), "=&v"(r[4]), "=&v"(r[5]), "=&v"(r[6]), "=&v"(r[7]),
                   "=&v"(r[8]), "=&v"(r[9]), "=&v"(r[10]), "=&v"(r[11]), "=&v"(r[12]), "=&v"(r[13]), "=&v"(r[14]), "=&v"(r[15])
                 : "v"(a0), "v"(a1), "v"(a2), "v"(a3), "i"(4 * LD * 2), "i"(32 * LD * 2), "i"(36 * LD * 2) : "memory");
#pragma unroll
    for (int i = 0; i < 4; ++i) { const u32x4 w0 = {r[4 * i].x, r[4 * i].y, r[4 * i + 1].x, r[4 * i + 1].y}, w1 = {r[4 * i + 2].x, r[4 * i + 2].y, r[4 * i + 3].x, r[4 * i + 3].y};
        f[i][0] = __builtin_bit_cast(bf16x8, w0); f[i][1] = __builtin_bit_cast(bf16x8, w1); }
}
__device__ __forceinline__ int chunk_tok(int d, int ci, int p) { const int uc = (d == 0) ? ci : (ci < 4 ? 3 - ci : 71 - ci); return (d == 0) ? uc * 64 + p : uc * 64 + 63 - p; }
__device__ __forceinline__ float dpp_allreduce4(float x) {
    x += __int_as_float(__builtin_amdgcn_update_dpp(0, __float_as_int(x), 0xB1, 0xF, 0xF, false));
    x += __int_as_float(__builtin_amdgcn_update_dpp(0, __float_as_int(x), 0x4E, 0xF, 0xF, false));
    return x;
}
__device__ __forceinline__ float quad_bcast(float v, int src) {
    const int iv = __float_as_int(v);
    const int r = src == 0 ? __builtin_amdgcn_update_dpp(0, iv, 0x00, 0xF, 0xF, false) : src == 1 ? __builtin_amdgcn_update_dpp(0, iv, 0x55, 0xF, 0xF, false)
                : src == 2 ? __builtin_amdgcn_update_dpp(0, iv, 0xAA, 0xF, 0xF, false) : __builtin_amdgcn_update_dpp(0, iv, 0xFF, 0xF, 0xF, false);
    return __int_as_float(r);
}
__device__ __forceinline__ void rwkv_pre_phase(const Fr& F, const Args& a, int wgi, int nWG) {
    unsigned char* ws = a.ws;
    const bf16* R = (const bf16*)(ws + WS_MIX + MX_R); const bf16* V = (const bf16*)(ws + WS_MIX + MX_V); const bf16* Km = (const bf16*)(ws + WS_MIX + MX_K);
    const bf16* KK = (const bf16*)(ws + WS_MIX + MX_KK); const bf16* BV = (const bf16*)(ws + WS_MIX + MX_BV);
    constexpr int LT = 72;
    LAS bf16* AT = (LAS bf16*)F.lds; LAS bf16* BT = AT + 64 * LT; LAS bf16* KT = BT + 64 * LT; LAS bf16* RT = KT + 64 * LT; LAS bf16* VM = RT + 64 * LT;
    LAS float* ATF = (LAS float*)(VM + 64 * LT); LAS float* LAB = ATF + 4096;
    LAS bf16* LKA = (LAS bf16*)(LAB + 64 * 68); LAS bf16* LBR = LKA + 64 * LT; LAS bf16* LKR = LBR + 64 * LT;
    LAS float* RHZ = (LAS float*)(LKR + 64 * LT);
    LAS bf16* XI = (LAS bf16*)(RHZ + 4096); LAS bf16* ZI = XI + 64 * LT;
    LAS float* WC = (LAS float*)(ZI + 64 * LT);
    LAS float* LW = RHZ; LAS float* SEG = (LAS float*)XI;
    const int tid = F.tid, lane = F.lane, w = F.wave;
    u32x4 nrr = {0, 0, 0, 0}, nkr = nrr, nvr = nrr, nar = nrr, nbr = nrr; f32x4 nlw0 = {0.f, 0.f, 0.f, 0.f}, nlw1 = nlw0;
    auto issue_loads = [&](int it2) {
        const int d_ = it2 / (int)RW_ITEMS, it_ = it2 % (int)RW_ITEMS, bh_ = it_ / (TB / 64), ci_ = it_ % (TB / 64);
        const size_t off = ((size_t)(bh_ >> 4) * TB + chunk_tok(d_, ci_, tid >> 3)) * MIXA + (bh_ & 15) * 64 + (tid & 7) * 8;
        const float* lwd = (const float*)(ws + WS_MIX + MX_DEC) + (size_t)d_ * M * MIXA;
        nrr = *(const u32x4*)(R + off); nkr = *(const u32x4*)(Km + off); nvr = *(const u32x4*)(V + off); nar = *(const u32x4*)(KK + off); nbr = *(const u32x4*)(BV + off);
        nlw0 = *(const f32x4*)(lwd + off); nlw1 = *(const f32x4*)(lwd + off + 4);
    };
    if (wgi < 2 * (int)RW_ITEMS) issue_loads(wgi);
    for (int item2 = wgi; item2 < 2 * (int)RW_ITEMS; item2 += nWG) {
        const int d = item2 / (int)RW_ITEMS, item = item2 % (int)RW_ITEMS;
        unsigned char* ob = d ? (ws + WS_H) : (ws + WS_RWG);
        bf16* GO = (bf16*)ob; bf16* PO = (bf16*)(ob + RW_ITEMS * 8192); bf16* YO = (bf16*)(ob + 2 * RW_ITEMS * 8192); bf16* QO = (bf16*)(ob + 3 * RW_ITEMS * 8192);
        const int bh = item / (TB / 64), ci = item % (TB / 64), b = bh >> 4, h = bh & 15;
        const size_t rowb = (size_t)b * TB;
        const int p = tid >> 3, c8 = (tid & 7) * 8;
        const u32x4 rr = nrr, kr = nkr, vr = nvr, ar = nar, br = nbr; const f32x4 lw0 = nlw0, lw1 = nlw1;
        if (item2 + nWG < 2 * (int)RW_ITEMS) issue_loads(item2 + nWG);
        *(LAS f32x4*)(LW + p * 64 + c8) = lw0; *(LAS f32x4*)(LW + p * 64 + c8 + 4) = lw1;
        __syncthreads();
        {
            const int col = tid & 63, seg = tid >> 6; float pf[8];
#pragma unroll
            for (int q = 0; q < 8; ++q) pf[q] = LW[(8 * seg + q) * 64 + col];
#pragma unroll
            for (int q = 1; q < 8; ++q) pf[q] += pf[q - 1];
            SEG[seg * 64 + col] = pf[7];
            __syncthreads();
            float offs = 0.f;
#pragma unroll
            for (int s2 = 0; s2 < 7; ++s2) { const float sv = SEG[s2 * 64 + col]; offs += (s2 < seg) ? sv : 0.f; }
#pragma unroll
            for (int q = 0; q < 8; ++q) LW[(8 * seg + q) * 64 + col] = pf[q] + offs;
        }
        __syncthreads();
        {
            const f32x4 c0 = *(const LAS f32x4*)(LW + p * 64 + c8), c1 = *(const LAS f32x4*)(LW + p * 64 + c8 + 4);
            float r8[8], k8[8], a8[8], b8[8], at[8];
            unpack8(rr, r8); unpack8(kr, k8); unpack8(ar, a8); unpack8(br, b8);
#pragma unroll
            for (int i = 0; i < 8; ++i) { const float cum = i < 4 ? c0[i & 3] : c1[i & 3], lwr = i < 4 ? lw0[i & 3] : lw1[i & 3];
                const float Wt = fexp(cum), iWt = fexp(-cum), Wp = fexp(cum - lwr);
                at[i] = -a8[i] * Wp; b8[i] *= iWt; k8[i] *= iWt; r8[i] *= Wt;
                if (p == 63) WC[c8 + i] = Wt; }
            *(LAS u32x4*)(AT + p * LT + c8) = pack8(at); *(LAS u32x4*)(BT + p * LT + c8) = pack8(b8); *(LAS u32x4*)(KT + p * LT + c8) = pack8(k8); *(LAS u32x4*)(RT + p * LT + c8) = pack8(r8);
            *(LAS u32x4*)(VM + p * LT + c8) = vr;
        }
        __syncthreads();
        {
            const int g = w >> 1; const LAS bf16* Am = (g < 2) ? AT : RT; const LAS bf16* Bm = (g & 1) ? KT : BT;
            bf16x8 bfr[4][2];
#pragma unroll
            for (int nt = 0; nt < 4; ++nt) { const LAS bf16* bp = Bm + (size_t)(16 * nt + (lane & 15)) * LT + 8 * (lane >> 4); bfr[nt][0] = *(const LAS bf16x8*)bp; bfr[nt][1] = *(const LAS bf16x8*)(bp + 32); }
#pragma unroll
            for (int e2 = 0; e2 < 2; ++e2) { const int mt = (w & 1) * 2 + e2;
                const LAS bf16* ap = Am + (size_t)(16 * mt + (lane & 15)) * LT + 8 * (lane >> 4); const bf16x8 a0 = *(const LAS bf16x8*)ap, a1 = *(const LAS bf16x8*)(ap + 32);
#pragma unroll
                for (int nt = 0; nt < 4; ++nt) { f32x4 acc = {0.f, 0.f, 0.f, 0.f};
                    if (nt <= mt) { acc = __builtin_amdgcn_mfma_f32_16x16x32_bf16(a0, bfr[nt][0], acc, 0, 0, 0); acc = __builtin_amdgcn_mfma_f32_16x16x32_bf16(a1, bfr[nt][1], acc, 0, 0, 0); }
#pragma unroll
                    for (int r = 0; r < 4; ++r) { const int t = 16 * mt + 4 * (lane >> 4) + r, i = 16 * nt + (lane & 15);
                        const bool keep = (g < 2) ? (i < t) : (i <= t); const float val = keep ? acc[r] : 0.f;
                        if (g == 0) LAB[i * 68 + (t & 3) * 16 + (t >> 2)] = val;
                        else { LAS bf16* dst = (g == 1) ? LKA : (g == 2 ? LBR : LKR); dst[t * LT + i] = f2bf(val); } } } }
        }
        __syncthreads();
        LAS bf16* TI = (LAS bf16*)ATF;
        LAS bf16* RZ = (LAS bf16*)RHZ;
        if (w < 4) {
            const int col = w * 16 + (lane >> 2), part = lane & 3;
            f32x2 x[8];
#pragma unroll
            for (int j = 0; j < 8; ++j) { x[j][0] = (8 * j + part == col) ? 1.f : 0.f; x[j][1] = (8 * j + 4 + part == col) ? 1.f : 0.f; }
#pragma unroll
            for (int t = 0; t < 64; ++t) {
                const float xs = quad_bcast(x[t >> 3][(t >> 2) & 1], t & 3); const f32x2 xv = {xs, xs};
#pragma unroll
                for (int j4 = (t >> 4); j4 < 4; ++j4) { const f32x4 l = *(const LAS f32x4*)(LAB + t * 68 + part * 16 + 4 * j4);
                    x[2 * j4] += (f32x2){l[0], l[1]} * xv; x[2 * j4 + 1] += (f32x2){l[2], l[3]} * xv; }
            }
#pragma unroll
            for (int j = 0; j < 8; ++j) { TI[(8 * j + part) * LT + col] = f2bf(x[j][0]); TI[(8 * j + 4 + part) * LT + col] = f2bf(x[j][1]); }
        } else {
            const int w4 = w - 4;
            bf16x8 vf0, vf1; tr_frags64<LT>(VM, 16 * w4, lane, vf0, vf1);
#pragma unroll
            for (int nt = 0; nt < 4; ++nt) { f32x4 acc = {0.f, 0.f, 0.f, 0.f};
                const LAS bf16* bp = LKA + (size_t)(16 * nt + (lane & 15)) * LT + 8 * (lane >> 4);
                acc = __builtin_amdgcn_mfma_f32_16x16x32_bf16(vf0, *(const LAS bf16x8*)bp, acc, 0, 0, 0);
                acc = __builtin_amdgcn_mfma_f32_16x16x32_bf16(vf1, *(const LAS bf16x8*)(bp + 32), acc, 0, 0, 0);
                u32x2 o; o.x = pk2(acc[0], acc[1]); o.y = pk2(acc[2], acc[3]);
                *(LAS u32x2*)(RZ + (16 * nt + (lane & 15)) * LT + 16 * w4 + 4 * (lane >> 4)) = o; }
        }
        __syncthreads();
        {
            const LAS bf16* src = (w < 4) ? AT : RZ; LAS bf16* dst = (w < 4) ? XI : ZI; const int ct = w & 3;
            bf16x8 af0, af1; tr_frags64<LT>(src, 16 * ct, lane, af0, af1);
#pragma unroll
            for (int nt = 0; nt < 4; ++nt) { f32x4 acc = {0.f, 0.f, 0.f, 0.f};
                const LAS bf16* bp = TI + (size_t)(16 * nt + (lane & 15)) * LT + 8 * (lane >> 4);
                acc = __builtin_amdgcn_mfma_f32_16x16x32_bf16(af0, *(const LAS bf16x8*)bp, acc, 0, 0, 0);
                acc = __builtin_amdgcn_mfma_f32_16x16x32_bf16(af1, *(const LAS bf16x8*)(bp + 32), acc, 0, 0, 0);
                u32x2 o; o.x = pk2(acc[0], acc[1]); o.y = pk2(acc[2], acc[3]);
                *(LAS u32x2*)(dst + (16 * nt + (lane & 15)) * LT + 16 * ct + 4 * (lane >> 4)) = o; }
        }
        __syncthreads();
        {
            const int mq = w >> 1; const size_t ib = (size_t)item * 4096;
#pragma unroll
            for (int e2 = 0; e2 < 2; ++e2) { const int mt = (w & 1) * 2 + e2; const int rr0 = 16 * mt + 4 * (lane >> 4);
                if (mq == 0) {
                    bf16x8 xf0, xf1; tr_frags64<LT>(XI, 16 * mt, lane, xf0, xf1);
#pragma unroll
                    for (int nt = 0; nt < 4; ++nt) { const int cc = 16 * nt + (lane & 15); f32x4 acc = {0.f, 0.f, 0.f, 0.f};
                        const LAS bf16* bp = LBR + (size_t)cc * LT + 8 * (lane >> 4);
                        acc = __builtin_amdgcn_mfma_f32_16x16x32_bf16(xf0, *(const LAS bf16x8*)bp, acc, 0, 0, 0);
                        acc = __builtin_amdgcn_mfma_f32_16x16x32_bf16(xf1, *(const LAS bf16x8*)(bp + 32), acc, 0, 0, 0);
                        const u32x2 rw = *(const LAS u32x2*)(RT + cc * LT + rr0);
                        u32x2 o; o.x = pk2(acc[0] + bflo(rw.x), acc[1] + bfhi(rw.x)); o.y = pk2(acc[2] + bflo(rw.y), acc[3] + bfhi(rw.y));
                        *(u32x2*)(GO + ib + (size_t)cc * 64 + rr0) = o; }
                } else if (mq == 1) {
                    bf16x8 f[2][2]; tr_frags64x2<LT>(ZI, 16 * mt, VM, 16 * mt, lane, f);
#pragma unroll
                    for (int nt = 0; nt < 4; ++nt) { const int cc = 16 * nt + (lane & 15); f32x4 acc = {0.f, 0.f, 0.f, 0.f};
                        const LAS bf16* bp = LBR + (size_t)cc * LT + 8 * (lane >> 4); const LAS bf16* cp = LKR + (size_t)cc * LT + 8 * (lane >> 4);
                        acc = __builtin_amdgcn_mfma_f32_16x16x32_bf16(f[0][0], *(const LAS bf16x8*)bp, acc, 0, 0, 0);
                        acc = __builtin_amdgcn_mfma_f32_16x16x32_bf16(f[0][1], *(const LAS bf16x8*)(bp + 32), acc, 0, 0, 0);
                        acc = __builtin_amdgcn_mfma_f32_16x16x32_bf16(f[1][0], *(const LAS bf16x8*)cp, acc, 0, 0, 0);
                        acc = __builtin_amdgcn_mfma_f32_16x16x32_bf16(f[1][1], *(const LAS bf16x8*)(cp + 32), acc, 0, 0, 0);
                        u32x2 o; o.x = pk2(acc[0], acc[1]); o.y = pk2(acc[2], acc[3]);
                        *(u32x2*)(YO + ib + (size_t)cc * 64 + rr0) = o; }
                } else if (mq == 2) {
                    bf16x8 xf0, xf1; tr_frags64<LT>(XI, 16 * mt, lane, xf0, xf1);
                    bf16x8 g[4][2]; tr_frags64x4<LT>(BT, 0, BT, 16, BT, 32, BT, 48, lane, g);
#pragma unroll
                    for (int nt = 0; nt < 4; ++nt) { const int cc = 16 * nt + (lane & 15); f32x4 acc = {0.f, 0.f, 0.f, 0.f};
                        acc = __builtin_amdgcn_mfma_f32_16x16x32_bf16(xf0, g[nt][0], acc, 0, 0, 0);
                        acc = __builtin_amdgcn_mfma_f32_16x16x32_bf16(xf1, g[nt][1], acc, 0, 0, 0);
                        const float wc = WC[cc];
                        u32x2 o; o.x = pk2(wc * (acc[0] + (rr0 == cc ? 1.f : 0.f)), wc * (acc[1] + (rr0 + 1 == cc ? 1.f : 0.f)));
                        o.y = pk2(wc * (acc[2] + (rr0 + 2 == cc ? 1.f : 0.f)), wc * (acc[3] + (rr0 + 3 == cc ? 1.f : 0.f)));
                        *(u32x2*)(PO + ib + (size_t)cc * 64 + rr0) = o; }
                } else {
                    bf16x8 fa[2][2]; tr_frags64x2<LT>(BT, 16 * mt, KT, 16 * mt, lane, fa);
                    bf16x8 gz[4][2], gv[4][2]; tr_frags64x4<LT>(ZI, 0, ZI, 16, ZI, 32, ZI, 48, lane, gz); tr_frags64x4<LT>(VM, 0, VM, 16, VM, 32, VM, 48, lane, gv);
                    const f32x4 wc = *(const LAS f32x4*)(WC + rr0);
#pragma unroll
                    for (int nt = 0; nt < 4; ++nt) { const int cc = 16 * nt + (lane & 15); f32x4 acc = {0.f, 0.f, 0.f, 0.f};
                        acc = __builtin_amdgcn_mfma_f32_16x16x32_bf16(fa[0][0], gz[nt][0], acc, 0, 0, 0);
                        acc = __builtin_amdgcn_mfma_f32_16x16x32_bf16(fa[0][1], gz[nt][1], acc, 0, 0, 0);
                        acc = __builtin_amdgcn_mfma_f32_16x16x32_bf16(fa[1][0], gv[nt][0], acc, 0, 0, 0);
                        acc = __builtin_amdgcn_mfma_f32_16x16x32_bf16(fa[1][1], gv[nt][1], acc, 0, 0, 0);
                        u32x2 o; o.x = pk2(wc[0] * acc[0], wc[1] * acc[1]); o.y = pk2(wc[2] * acc[2], wc[3] * acc[3]);
                        *(u32x2*)(QO + ib + (size_t)cc * 64 + rr0) = o; }
                }
            }
        }
        __syncthreads();
    }
}
__device__ __forceinline__ void rwkv_seq_phase(const Fr& F, const Args& a, int wgi, int nWG) {
    unsigned char* ws = a.ws;
    constexpr int SLOT = 32768, IMG = 64 * 64 * 2, RING0 = 4 * IMG;
    static_assert(RING0 % 16 == 0 && RING0 + 3 * SLOT <= LDS_BYTES - 16, "RWKV recurrence LDS map");
    LAS unsigned char* ring = F.lds + RING0;
    const int tid = F.tid, lane = F.lane, w = F.wave, fr = lane & 15, fq = lane >> 4;
    for (int ch = wgi; ch < 2 * NB * 16; ch += nWG) {
        const int d = ch >> 5, bh = ch & 31, b = bh >> 4, h = bh & 15; const size_t rowb = (size_t)b * TB;
        const unsigned char* ob = d ? (ws + WS_H) : (ws + WS_RWG);
        bf16* YA = (bf16*)(ws + WS_MIX + MX_YA) + (size_t)d * M * MIXA;
        for (int i = tid; i < RING0 / 4; i += NTHR) ((LAS unsigned*)F.lds)[i] = 0u;
        const unsigned srcoff = (unsigned)((tid >> 3) * 128 + (((tid & 7) ^ ((tid >> 3) & 7)) * 16));
        auto issue = [&](int ci_) { const int ci = ci_ < TB / 64 ? ci_ : TB / 64 - 1;
            const unsigned char* src = ob + ((size_t)bh * (TB / 64) + ci) * 8192 + srcoff; LAS unsigned char* dst = ring + (ci_ % 3) * SLOT + w * 1024;
#pragma unroll
            for (int j = 0; j < 4; ++j)
                __builtin_amdgcn_global_load_lds((const unsigned*)(src + (size_t)j * RW_ITEMS * 8192), (LAS unsigned*)(dst + j * 8192), 16, 0, 0); };
        issue(0); issue(1);
        asm volatile("s_waitcnt lgkmcnt(0)" ::: "memory");
        for (int ci = 0; ci < TB / 64; ++ci) {
            if (ci == 0) asm volatile("s_waitcnt vmcnt(4)" ::: "memory"); else if (ci == 1) asm volatile("s_waitcnt vmcnt(6)" ::: "memory"); else asm volatile("s_waitcnt vmcnt(8)" ::: "memory");
            __builtin_amdgcn_s_barrier();
            asm volatile("" ::: "memory");
            issue(ci + 2);
            const LAS unsigned char* slot = ring + (ci % 3) * SLOT;
            const LAS bf16* SH = (const LAS bf16*)(F.lds + (ci & 1) * 2 * IMG); const LAS bf16* SL = SH + 64 * 64;
            LAS bf16* NH = (LAS bf16*)(F.lds + ((ci & 1) ^ 1) * 2 * IMG); LAS bf16* NL = NH + 64 * 64;
#pragma unroll
            for (int e = 0; e < 2; ++e) { const int tile = 2 * w + e, mt = tile >> 2, nt = tile & 3;
                const int rt = 16 * nt + fr, rk = 16 * mt + fr;
                const LAS unsigned char* gr = slot + rt * 128; const LAS unsigned char* pr = slot + 8192 + rk * 128;
                const bf16x8 g0 = *(const LAS bf16x8*)(gr + (((fq) ^ (rt & 7)) * 16)), g1 = *(const LAS bf16x8*)(gr + (((fq + 4) ^ (rt & 7)) * 16));
                const bf16x8 p0 = *(const LAS bf16x8*)(pr + (((fq) ^ (rk & 7)) * 16)), p1 = *(const LAS bf16x8*)(pr + (((fq + 4) ^ (rk & 7)) * 16));
                const int cpos = ((2 * mt + (fq >> 1)) ^ (rt & 7)) * 16 + (fq & 1) * 8;
                const u32x2 yl = *(const LAS u32x2*)(slot + 16384 + rt * 128 + cpos), ql = *(const LAS u32x2*)(slot + 24576 + rt * 128 + cpos);
                f32x4 acc = {bflo(yl.x), bfhi(yl.x), bflo(yl.y), bfhi(yl.y)}, acl = {0.f, 0.f, 0.f, 0.f};
                const int rm = 16 * mt + fr, om0 = rm * 64 + ((fq ^ (rm & 7)) * 8), om1 = rm * 64 + (((fq + 4) ^ (rm & 7)) * 8);
                acc = __builtin_amdgcn_mfma_f32_16x16x32_bf16(*(const LAS bf16x8*)(SH + om0), g0, acc, 0, 0, 0);
                acl = __builtin_amdgcn_mfma_f32_16x16x32_bf16(*(const LAS bf16x8*)(SL + om0), g0, acl, 0, 0, 0);
                acc = __builtin_amdgcn_mfma_f32_16x16x32_bf16(*(const LAS bf16x8*)(SH + om1), g1, acc, 0, 0, 0);
                acl = __builtin_amdgcn_mfma_f32_16x16x32_bf16(*(const LAS bf16x8*)(SL + om1), g1, acl, 0, 0, 0);
                acc += acl;
                u32x2 o; o.x = pk2(acc[0], acc[1]); o.y = pk2(acc[2], acc[3]);
                *(u32x2*)(YA + (rowb + chunk_tok(d, ci, rt)) * MIXA + h * 64 + 16 * mt + 4 * fq) = o;
                f32x4 s2 = {bflo(ql.x), bfhi(ql.x), bflo(ql.y), bfhi(ql.y)}, s3 = {0.f, 0.f, 0.f, 0.f};
                const int rn = 16 * nt + fr, on0 = rn * 64 + ((fq ^ (rn & 7)) * 8), on1 = rn * 64 + (((fq + 4) ^ (rn & 7)) * 8);
                s2 = __builtin_amdgcn_mfma_f32_16x16x32_bf16(p0, *(const LAS bf16x8*)(SH + on0), s2, 0, 0, 0);
                s3 = __builtin_amdgcn_mfma_f32_16x16x32_bf16(p0, *(const LAS bf16x8*)(SL + on0), s3, 0, 0, 0);
                s2 = __builtin_amdgcn_mfma_f32_16x16x32_bf16(p1, *(const LAS bf16x8*)(SH + on1), s2, 0, 0, 0);
                s3 = __builtin_amdgcn_mfma_f32_16x16x32_bf16(p1, *(const LAS bf16x8*)(SL + on1), s3, 0, 0, 0);
                s2 += s3;
                u32x2 hi; hi.x = pk2(s2[0], s2[1]); hi.y = pk2(s2[2], s2[3]);
                u32x2 lo; lo.x = pk2(s2[0] - bflo(hi.x), s2[1] - bfhi(hi.x)); lo.y = pk2(s2[2] - bflo(hi.y), s2[3] - bfhi(hi.y));
                const int ow = rn * 64 + (((2 * mt + (fq >> 1)) ^ (rn & 7)) * 8) + (fq & 1) * 4;
                *(LAS u32x2*)(NH + ow) = hi; *(LAS u32x2*)(NL + ow) = lo; }
            asm volatile("s_waitcnt lgkmcnt(0)" ::: "memory");
        }
        asm volatile("s_waitcnt vmcnt(0)" ::: "memory");
        __builtin_amdgcn_s_barrier();
        asm volatile("" ::: "memory");
    }
}

__device__ __forceinline__ void gla_pre_phase(const Fr& F, const Args& a, int wgi, int nWG) {
    unsigned char* ws = a.ws;
    const bf16* Z = (const bf16*)(ws + WS_ZR); bf16* YB = (bf16*)(ws + WS_MIX + MX_YB);
    bf16* GQI = (bf16*)((unsigned char*)a.out + DO_GQI); bf16* GKI = (bf16*)(ws + WS_GKI); float* GDL = (float*)(ws + WS_GDL);
    const float* gk_up = a.in[I_GKUP]; const float* gk_b = a.in[I_GKB];
    constexpr int DK = 128, LQ = DK + 24, LV = 256 + 8, LT = 72;
    LAS bf16* QIN = (LAS bf16*)F.lds; LAS bf16* KIN = QIN + 64 * LQ; LAS bf16* VI = KIN + 64 * LQ; LAS bf16* ATT = VI + 64 * LV;
    LAS float* BC = (LAS float*)(ATT + 64 * LT); LAS float* QS = BC + 64 * DK; LAS float* GD = QS + 4 * DK;
    const int tid = F.tid, lane = F.lane, w = F.wave;
    const float qscale = 0.08838834764831845f;
    for (int item = wgi; item < (int)GLA_ITEMS; item += nWG) {
        const int ci = item % (TB / 64), d = (item / (TB / 64)) & 1, h = (item / (2 * (TB / 64))) & 3, b = item / (8 * (TB / 64));
        const size_t rowb = (size_t)b * TB;
        const int col = tid & (DK - 1);
        float gku[16];
#pragma unroll
        for (int j = 0; j < 16; ++j) gku[j] = gk_up[((size_t)d * 16 + j) * 512 + h * DK + col];
        const float gkb = gk_b[d * 512 + h * DK + col];
        u32x4 qreg[2], kreg[2], vreg[4], gdreg = {0, 0, 0, 0};
#pragma unroll
        for (int it = 0; it < 2; ++it) { const int idx = tid + it * NTHR; const int p = idx >> 4, kc = (idx & 15) * 8; const bf16* zr = Z + (rowb + chunk_tok(d, ci, p)) * ZLD0;
            qreg[it] = *(const u32x4*)(zr + GQ + h * DK + kc); kreg[it] = *(const u32x4*)(zr + GK + h * DK + kc); }
#pragma unroll
        for (int it = 0; it < 4; ++it) { const int idx = tid + it * NTHR; const int p = idx >> 5, vc = (idx & 31) * 8;
            vreg[it] = *(const u32x4*)(Z + (rowb + chunk_tok(d, ci, p)) * ZLD0 + GV + h * 256 + vc); }
        if (tid < 128) { const int p = tid >> 1, hf = tid & 1; gdreg = *(const u32x4*)(Z + (rowb + chunk_tok(d, ci, p)) * ZLD0 + GGD + 8 * hf); }
        if (tid < 128) { const int p = tid >> 1, hf = tid & 1; float t8[8]; unpack8(gdreg, t8);
            *(LAS f32x4*)(GD + p * 16 + 8 * hf) = (f32x4){t8[0], t8[1], t8[2], t8[3]}; *(LAS f32x4*)(GD + p * 16 + 8 * hf + 4) = (f32x4){t8[4], t8[5], t8[6], t8[7]}; }
        __syncthreads();
        {
            const int qq = tid / DK; float bc[16];
#pragma unroll
            for (int pp = 0; pp < 16; ++pp) { const int p = 16 * qq + pp; float x = gkb;
                const f32x4 g0 = *(const LAS f32x4*)(GD + p * 16), g1 = *(const LAS f32x4*)(GD + p * 16 + 4), g2 = *(const LAS f32x4*)(GD + p * 16 + 8), g3 = *(const LAS f32x4*)(GD + p * 16 + 12);
#pragma unroll
                for (int j = 0; j < 4; ++j) { x += g0[j] * gku[j]; x += g1[j] * gku[4 + j]; x += g2[j] * gku[8 + j]; x += g3[j] * gku[12 + j]; }
                bc[pp] = flogsigmoid(x) * (1.0f / 16.0f); }
#pragma unroll
            for (int pp = 1; pp < 16; ++pp) bc[pp] += bc[pp - 1];
            QS[qq * DK + col] = bc[15];
            __syncthreads();
            float offs = 0.f;
#pragma unroll
            for (int q2 = 0; q2 < 3; ++q2) { const float sv = QS[q2 * DK + col]; offs += (q2 < qq) ? sv : 0.f; }
#pragma unroll
            for (int pp = 0; pp < 16; ++pp) BC[(16 * qq + pp) * DK + col] = bc[pp] + offs;
        }
        __syncthreads();
#pragma unroll
        for (int it = 0; it < 2; ++it) { const int idx = tid + it * NTHR; const int p = idx >> 4, kc = (idx & 15) * 8;
            float q8[8], k8[8]; unpack8(qreg[it], q8); unpack8(kreg[it], k8);
            const f32x4 b0 = *(const LAS f32x4*)(BC + p * DK + kc), b1 = *(const LAS f32x4*)(BC + p * DK + kc + 4);
#pragma unroll
            for (int i = 0; i < 8; ++i) { const float bc = i < 4 ? b0[i & 3] : b1[i & 3]; q8[i] *= fexp(bc) * qscale; k8[i] *= fexp(-bc); }
            const u32x4 qw = pack8(q8), kw = pack8(k8);
            *(LAS u32x4*)(QIN + p * LQ + kc) = qw; *(LAS u32x4*)(KIN + p * LQ + kc) = kw;
            *(u32x4*)(GQI + (size_t)item * 8192 + p * DK + kc) = qw; *(u32x4*)(GKI + (size_t)item * 8192 + p * DK + kc) = kw; }
#pragma unroll
        for (int it = 0; it < 4; ++it) { const int idx = tid + it * NTHR; const int p = idx >> 5, vc = (idx & 31) * 8; *(LAS u32x4*)(VI + p * LV + vc) = vreg[it]; }
        if (tid < DK) GDL[(size_t)item * DK + tid] = fexp(BC[63 * DK + tid]);
        __syncthreads();
        { const int mt = w >> 1;
#pragma unroll
          for (int e = 0; e < 2; ++e) { const int nt = (w & 1) * 2 + e; f32x4 acc = {0.f, 0.f, 0.f, 0.f};
              if (nt <= mt) mma16<DK / 32>(acc, QIN, LQ, 16 * mt, KIN, LQ, 16 * nt, lane);
#pragma unroll
              for (int r = 0; r < 4; ++r) { const int i = 16 * mt + 4 * (lane >> 4) + r, j = 16 * nt + (lane & 15);
                  ATT[i * LT + j] = f2bf(j <= i ? acc[r] : 0.f); } } }
        __syncthreads();
        { bf16x8 af[4][2];
#pragma unroll
          for (int mt = 0; mt < 4; ++mt) { const LAS bf16* ap = ATT + (size_t)(16 * mt + (lane & 15)) * LT + 8 * (lane >> 4); af[mt][0] = *(const LAS bf16x8*)ap; af[mt][1] = *(const LAS bf16x8*)(ap + 32); }
          bf16x8 vf[2][2]; tr_frags64x2<LV>(VI, 32 * w, VI, 32 * w + 16, lane, vf);
          bf16* yb = YB + (size_t)d * M * MIXA;
#pragma unroll
          for (int e = 0; e < 2; ++e)
#pragma unroll
              for (int mt = 0; mt < 4; ++mt) { f32x4 acc = {0.f, 0.f, 0.f, 0.f};
                  acc = __builtin_amdgcn_mfma_f32_16x16x32_bf16(vf[e][0], af[mt][0], acc, 0, 0, 0);
                  acc = __builtin_amdgcn_mfma_f32_16x16x32_bf16(vf[e][1], af[mt][1], acc, 0, 0, 0);
                  u32x2 o; o.x = pk2(acc[0], acc[1]); o.y = pk2(acc[2], acc[3]);
                  *(u32x2*)(yb + (rowb + chunk_tok(d, ci, 16 * mt + (lane & 15))) * MIXA + h * 256 + 32 * w + 16 * e + 4 * (lane >> 4)) = o; } }
        __syncthreads();
    }
}
__device__ __forceinline__ void gla_seq_phase(const Fr& F, const Args& a, int wgi, int nWG) {
    unsigned char* ws = a.ws;
    const bf16* Z = (const bf16*)(ws + WS_ZR); bf16* OC2 = (bf16*)(ws + WS_MIX + MX_DEC);
    const bf16* GQI = (const bf16*)((const unsigned char*)a.out + DO_GQI); const bf16* GKI = (const bf16*)(ws + WS_GKI); const float* GDL = (const float*)(ws + WS_GDL);
    constexpr int DK = 128, LQ = DK + 24, SLOT = 37888, IMG = 32 * LQ * 2, RING0 = 2 * IMG;
    LAS unsigned char* ring = F.lds + RING0;
    static_assert(RING0 % 16 == 0 && RING0 + 3 * SLOT <= LDS_BYTES - 16, "GLA recurrence LDS map");
    const int tid = F.tid, lane = F.lane, w = F.wave, fr = lane & 15, fq = lane >> 4;
    for (int unit = wgi; unit < 128; unit += nWG) {
        const int vs = unit & 7, d = (unit >> 3) & 1, h = (unit >> 4) & 3, b = unit >> 6;
        const size_t rowb = (size_t)b * TB; const size_t it0 = (size_t)((b * 4 + h) * 2 + d) * (TB / 64);
        bf16* oc = OC2 + (size_t)d * M * MIXA;
        f32x4 S[2] = {{0.f, 0.f, 0.f, 0.f}, {0.f, 0.f, 0.f, 0.f}};
        const int vt = w >> 2, nt = w & 3;
        auto issue = [&](int ci_) { const int ci = ci_ < TB / 64 ? ci_ : TB / 64 - 1; const size_t ib = (it0 + ci) * 8192;
            LAS unsigned char* dst = ring + (ci_ % 3) * SLOT;
#pragma unroll
            for (int j = 0; j < 2; ++j) { const int lin = j * 8192 + tid * 16; const int r = lin >> 8, pp = (lin >> 4) & 15; const int sp = pp ^ (r & 7);
                __builtin_amdgcn_global_load_lds((const unsigned*)((const unsigned char*)GKI + ib * 2 + r * 256 + sp * 16), (LAS unsigned*)(dst + j * 8192 + w * 1024), 16, 0, 0);
                __builtin_amdgcn_global_load_lds((const unsigned*)((const unsigned char*)GQI + ib * 2 + r * 256 + sp * 16), (LAS unsigned*)(dst + 16384 + j * 8192 + w * 1024), 16, 0, 0); }
            { const int t2 = tid & 255; const int r = t2 >> 2, pc = t2 & 3;
              __builtin_amdgcn_global_load_lds((const unsigned*)(Z + (rowb + chunk_tok(d, ci, r)) * ZLD0 + GV + h * 256 + vs * 32 + pc * 8), (LAS unsigned*)(dst + 32768 + (w & 3) * 1024), 16, 0, 0); }
            { const int t3 = lane & 31;
              __builtin_amdgcn_global_load_lds((const unsigned*)(GDL + (it0 + ci) * DK + t3 * 4), (LAS unsigned*)(dst + 36864), 16, 0, 0); }
        };
        issue(0); issue(1);
#pragma unroll
        for (int e = 0; e < 2; ++e) *(LAS u32x2*)((LAS bf16*)F.lds + (16 * e + fr) * LQ + 16 * w + 4 * fq) = (u32x2){0u, 0u};
        asm volatile("s_waitcnt lgkmcnt(0)" ::: "memory");
        for (int ci = 0; ci < TB / 64; ++ci) {
            if (ci == 0) asm volatile("s_waitcnt vmcnt(6)" ::: "memory"); else if (ci == 1) asm volatile("s_waitcnt vmcnt(7)" ::: "memory"); else asm volatile("s_waitcnt vmcnt(8)" ::: "memory");
            __builtin_amdgcn_s_barrier();
            asm volatile("" ::: "memory");
            issue(ci + 2);
            const LAS unsigned char* slot = ring + (ci % 3) * SLOT;
            const LAS bf16* ST = (const LAS bf16*)(F.lds + (ci & 1) * IMG); LAS bf16* STN = (LAS bf16*)(F.lds + ((ci & 1) ^ 1) * IMG);
            { f32x4 acc = {0.f, 0.f, 0.f, 0.f};
              const LAS bf16* sp = ST + (size_t)(16 * vt + fr) * LQ + 8 * fq; const int rt = 16 * nt + fr; const LAS unsigned char* qr = slot + 16384 + rt * 256;
#pragma unroll
              for (int ks = 0; ks < 4; ++ks) acc = __builtin_amdgcn_mfma_f32_16x16x32_bf16(*(const LAS bf16x8*)(sp + 32 * ks), *(const LAS bf16x8*)(qr + (((fq + 4 * ks) ^ (rt & 7)) * 16)), acc, 0, 0, 0);
              u32x2 o; o.x = pk2(acc[0], acc[1]); o.y = pk2(acc[2], acc[3]);
              *(u32x2*)(oc + (rowb + chunk_tok(d, ci, rt)) * MIXA + h * 256 + vs * 32 + 16 * vt + 4 * fq) = o; }
            { const int g = lane >> 4, q = (lane & 15) >> 2, pq = lane & 3;
              const LAS unsigned char* kb = slot + (8 * g + q) * 256 + (pq & 1) * 8; const int pc = 2 * w + (pq >> 1);
              const unsigned ka0 = (unsigned)(size_t)(kb + ((pc ^ q) * 16)), ka1 = (unsigned)(size_t)(kb + 4 * 256 + ((pc ^ (q + 4)) * 16));
              u32x2 r0, r1, r2, r3;
              asm volatile("ds_read_b64_tr_b16 %0, %4\n\tds_read_b64_tr_b16 %1, %5\n\tds_read_b64_tr_b16 %2, %4 offset:8192\n\tds_read_b64_tr_b16 %3, %5 offset:8192\n\ts_waitcnt lgkmcnt(0)\n\ts_nop 1"
                           : "=&v"(r0), "=&v"(r1), "=&v"(r2), "=&v"(r3) : "v"(ka0), "v"(ka1) : "memory");
              const u32x4 k0w = {r0.x, r0.y, r1.x, r1.y}, k1w = {r2.x, r2.y, r3.x, r3.y};
              const bf16x8 kf0 = __builtin_bit_cast(bf16x8, k0w), kf1 = __builtin_bit_cast(bf16x8, k1w);
              bf16x8 f[2][2]; tr_frags64x2<32>((const LAS bf16*)(slot + 32768), 0, (const LAS bf16*)(slot + 32768), 16, lane, f);
              const f32x4 dl = *(const LAS f32x4*)(slot + 36864 + (16 * w + 4 * fq) * 4);
#pragma unroll
              for (int e = 0; e < 2; ++e) {
                  S[e] = __builtin_amdgcn_mfma_f32_16x16x32_bf16(kf0, f[e][0], S[e], 0, 0, 0);
                  S[e] = __builtin_amdgcn_mfma_f32_16x16x32_bf16(kf1, f[e][1], S[e], 0, 0, 0);
                  S[e] = S[e] * dl; } }
#pragma unroll
            for (int e = 0; e < 2; ++e) { u32x2 pw; pw.x = pk2(S[e][0], S[e][1]); pw.y = pk2(S[e][2], S[e][3]);
                *(LAS u32x2*)(STN + (16 * e + fr) * LQ + 16 * w + 4 * fq) = pw; }
            asm volatile("s_waitcnt lgkmcnt(0)" ::: "memory");
        }
        asm volatile("s_waitcnt vmcnt(0)" ::: "memory");
        __builtin_amdgcn_s_barrier();
        asm volatile("" ::: "memory");
    }
}

__device__ __forceinline__ void ret_intra_phase(const Fr& F, const bf16* Z, bf16* OI) {
    constexpr int LQ = 256 + 16, LV = 512 + 8, LT = 72;
    LAS bf16* QI = (LAS bf16*)F.lds; LAS bf16* KI = QI + 64 * LQ; LAS bf16* VI = KI + 64 * LQ; LAS bf16* ATT = VI + 64 * LV;
    const int tid = F.tid, lane = F.lane, w = F.wave;
    u32x4 pq[4], pk[4], pv[8];
    auto fetch = [&](int item) { const int uc = 4 + (item & 63), h = (item >> 6) & 7, b = item >> 9; const size_t row0 = (size_t)b * TB + uc * 64;
#pragma unroll
        for (int it = 0; it < 4; ++it) { const int idx = tid + it * NTHR; const int p = idx >> 5, kc = (idx & 31) * 8; const bf16* zr = Z + (row0 + p) * RETC + h * 256 + kc;
            pq[it] = *(const u32x4*)(zr); pk[it] = *(const u32x4*)(zr + D); }
#pragma unroll
        for (int it = 0; it < 8; ++it) { const int idx = tid + it * NTHR; const int p = idx >> 6, vc = (idx & 63) * 8;
            pv[it] = *(const u32x4*)(Z + (row0 + p) * RETC + 2 * D + h * 512 + vc); } };
    if (F.vcu < NB * 8 * 64) fetch(F.vcu);
    for (int item = F.vcu; item < NB * 8 * 64; item += F.G) {
        const int uc = 4 + (item & 63), h = (item >> 6) & 7, b = item >> 9;
        const size_t row0 = (size_t)b * TB + uc * 64;
        const float l2g = log1pf(-exp2f(-5.0f - (float)h)) * 1.4426950408889634f;
#pragma unroll
        for (int it = 0; it < 4; ++it) { const int idx = tid + it * NTHR; const int p = idx >> 5, kc = (idx & 31) * 8;
            *(LAS u32x4*)(QI + p * LQ + kc) = pq[it]; *(LAS u32x4*)(KI + p * LQ + kc) = pk[it]; }
#pragma unroll
        for (int it = 0; it < 8; ++it) { const int idx = tid + it * NTHR; const int p = idx >> 6, vc = (idx & 63) * 8;
            *(LAS u32x4*)(VI + p * LV + vc) = pv[it]; }
        __syncthreads();
        if (item + F.G < NB * 8 * 64) fetch(item + F.G);
        { const int mt = w >> 1;
#pragma unroll
          for (int e = 0; e < 2; ++e) { const int nt = (w & 1) * 2 + e; f32x4 acc = {0.f, 0.f, 0.f, 0.f};
              mma16<8>(acc, QI, LQ, 16 * mt, KI, LQ, 16 * nt, lane);
#pragma unroll
              for (int r = 0; r < 4; ++r) { const int i = 16 * mt + 4 * (lane >> 4) + r, j = 16 * nt + (lane & 15); const int dd = i > j ? i - j : j - i;
                  ATT[i * LT + j] = f2bf(acc[r] * (dd == 0 ? 2.0f : __builtin_amdgcn_exp2f((float)dd * l2g))); } } }
        __syncthreads();
        {
            bf16x8 af[4][2];
#pragma unroll
            for (int mt = 0; mt < 4; ++mt) { const LAS bf16* ap = ATT + (size_t)(16 * mt + (lane & 15)) * LT + 8 * (lane >> 4); af[mt][0] = *(const LAS bf16x8*)ap; af[mt][1] = *(const LAS bf16x8*)(ap + 32); }
#pragma unroll
            for (int vt = 0; vt < 4; ++vt) { bf16x8 vf0, vf1; tr_frags64<LV>(VI, 64 * w + 16 * vt, lane, vf0, vf1);
#pragma unroll
                for (int mt = 0; mt < 4; ++mt) { f32x4 acc = {0.f, 0.f, 0.f, 0.f};
                    acc = __builtin_amdgcn_mfma_f32_16x16x32_bf16(vf0, af[mt][0], acc, 0, 0, 0);
                    acc = __builtin_amdgcn_mfma_f32_16x16x32_bf16(vf1, af[mt][1], acc, 0, 0, 0);
                    u32x2 o; o.x = pk2(acc[0], acc[1]); o.y = pk2(acc[2], acc[3]);
                    *(u32x2*)(OI + (row0 + 16 * mt + (lane & 15)) * 4096 + h * 512 + 64 * w + 16 * vt + 4 * (lane >> 4)) = o; } }
        }
        __syncthreads();
    }
}
__device__ __forceinline__ void ret_scan_phase(const Fr& F, const bf16* Z, bf16* OUT) {
    constexpr int LQ = 256 + 24, LV = 64 + 8, LQQ = 256 + 16;
    LAS bf16* QI = (LAS bf16*)F.lds; LAS bf16* KI = QI + 64 * LQQ; LAS bf16* ST = KI + 2 * 64 * LQ; LAS bf16* VI = ST + 64 * LQ;
    static_assert((64 * LQQ + 3 * 64 * LQ + 2 * 64 * LV) * 2 <= LDS_BYTES - 16, "retention scan LDS map");
    const int tid = F.tid, lane = F.lane, w = F.wave;
    for (int unit = F.vcu; unit < NB * 8 * 2 * 8; unit += F.G) {
        const int vs = unit & 7, d = (unit >> 3) & 1, h = (unit >> 4) & 7, b = unit >> 7;
        const size_t rowb = (size_t)b * TB;
        bf16* out = OUT + (size_t)d * M * 4096;
        const float l2g = log1pf(-exp2f(-5.0f - (float)h)) * 1.4426950408889634f;
        const float g64 = __builtin_amdgcn_exp2f(64.0f * l2g);
        const float vsc = __builtin_amdgcn_exp2f((float)(63 - (tid >> 3)) * l2g);
        f32x4 S[2][4];
#pragma unroll
        for (int i = 0; i < 2; ++i)
#pragma unroll
            for (int j = 0; j < 4; ++j) S[i][j] = (f32x4){0.f, 0.f, 0.f, 0.f};
        struct Pre { u32x4 q[4], k[4], v; };
        Pre PA, PB;
        auto tok_of = [&](int ci, int p) { const int uc = (d == 0) ? ci : (ci < 4 ? 3 - ci : 71 - ci); return (d == 0) ? uc * 64 + p : uc * 64 + 63 - p; };
        const int sgn16 = d ? -16 : 16;
        const unsigned voq = (unsigned)(((d ? 63 - (tid >> 5) : (tid >> 5)) * RETC + (tid & 31) * 8) * 2);
        const unsigned vov = (unsigned)(((d ? 63 - (tid >> 3) : (tid >> 3)) * RETC + (tid & 7) * 8) * 2);
        const unsigned voo = (unsigned)(((d ? 63 - (32 * (w & 1) + (lane & 15)) : 32 * (w & 1) + (lane & 15)) * 4096 + 16 * (w >> 1) + 4 * (lane >> 4)) * 2);
        auto prefetch = [&](int ci_, Pre& P) { const int ci = ci_ < TB / 64 ? ci_ : TB / 64 - 1;
            const int uc = (d == 0) ? ci : (ci < 4 ? 3 - ci : 71 - ci);
            const char* rb = (const char*)(Z + (rowb + (size_t)uc * 64) * RETC);
#pragma unroll
            for (int it = 0; it < 4; ++it) { const char* qb = rb + ((ptrdiff_t)h * 256 + (ptrdiff_t)it * sgn16 * RETC) * 2;
                P.q[it] = *(const u32x4*)(qb + voq); P.k[it] = *(const u32x4*)(qb + D * 2 + voq); }
            P.v = *(const u32x4*)(rb + (size_t)(2 * D + h * 512 + vs * 64) * 2 + vov);
        };
        auto stage_kv = [&](int buf, const Pre& P) {
            LAS bf16* KB = KI + buf * (64 * LQ); LAS bf16* VB = VI + buf * (64 * LV);
#pragma unroll
            for (int it = 0; it < 4; ++it) { const int idx = tid + it * NTHR; const int p = idx >> 5, kc = (idx & 31) * 8; *(LAS u32x4*)(KB + p * LQ + kc) = P.k[it]; }
            { const int p = tid >> 3, vc = (tid & 7) * 8; float v8[8]; unpack8(P.v, v8);
#pragma unroll
              for (int i = 0; i < 8; ++i) v8[i] *= vsc;
              *(LAS u32x4*)(VB + p * LV + vc) = pack8(v8); } };
        auto step = [&](int ci, Pre& P, Pre& Pn) {
            const bool do_out = ci >= 4; const int buf = ci & 1;
            const LAS bf16* KB = KI + buf * (64 * LQ); const LAS bf16* VB = VI + buf * (64 * LV);
            if (do_out) {
#pragma unroll
                for (int it = 0; it < 4; ++it) { const int idx = tid + it * NTHR; const int p = idx >> 5, kc = (idx & 31) * 8; *(LAS u32x4*)(QI + p * LQQ + kc) = P.q[it]; } }
#pragma unroll
            for (int ki = 0; ki < 2; ++ki)
#pragma unroll
                for (int vt = 0; vt < 4; ++vt) { u32x2 pw; pw.x = pk2(S[ki][vt][0], S[ki][vt][1]); pw.y = pk2(S[ki][vt][2], S[ki][vt][3]);
                    *(LAS u32x2*)(ST + (16 * vt + (lane & 15)) * LQ + 16 * (2 * w + ki) + 4 * (lane >> 4)) = pw; }
            __syncthreads();
            prefetch(ci + 2, P);
            __builtin_amdgcn_s_waitcnt(0xF79);
            stage_kv(buf ^ 1, Pn);
            if (do_out) {
                const int vt = w >> 1;
#pragma unroll
                for (int e = 0; e < 2; ++e) { const int nt = 2 * (w & 1) + e; f32x4 acc = {0.f, 0.f, 0.f, 0.f};
                    mma16<8>(acc, ST, LQ, 16 * vt, QI, LQQ, 16 * nt, lane);
                    const int p = 16 * nt + (lane & 15); const float sc = __builtin_amdgcn_exp2f((float)(p + 1) * l2g);
                    u32x2 o; o.x = pk2(acc[0] * sc, acc[1] * sc); o.y = pk2(acc[2] * sc, acc[3] * sc);
                    const int uco = (d == 0) ? ci : 71 - ci;
                    const char* ob = (const char*)(out + (rowb + (size_t)uco * 64) * 4096 + h * 512 + vs * 64) + (ptrdiff_t)e * sgn16 * 4096 * 2;
                    *(u32x2*)(ob + voo) = o; }
            }
            {
                bf16x8 vf[4][2]; tr_frags64x4<LV>(VB, 0, VB, 16, VB, 32, VB, 48, lane, vf);
                bf16x8 kf[2][2]; tr_frags64x2<LQ>(KB, 16 * (2 * w), KB, 16 * (2 * w + 1), lane, kf);
#pragma unroll
                for (int ki = 0; ki < 2; ++ki) {
#pragma unroll
                    for (int vt = 0; vt < 4; ++vt) {
#pragma unroll
                        for (int r = 0; r < 4; ++r) S[ki][vt][r] *= g64;
                        S[ki][vt] = __builtin_amdgcn_mfma_f32_16x16x32_bf16(kf[ki][0], vf[vt][0], S[ki][vt], 0, 0, 0);
                        S[ki][vt] = __builtin_amdgcn_mfma_f32_16x16x32_bf16(kf[ki][1], vf[vt][1], S[ki][vt], 0, 0, 0); } }
            }
            __syncthreads();
        };
        prefetch(0, PA); prefetch(1, PB);
        __builtin_amdgcn_s_waitcnt(0xF79);
        stage_kv(0, PA);
        static_assert((TB / 64) % 2 == 0, "the chunk loop is unrolled by two");
#pragma unroll 1
        for (int ci = 0; ci < TB / 64; ci += 2) { step(ci, PA, PB); step(ci + 1, PB, PA); }
        __builtin_amdgcn_s_waitcnt(0xF70);
    }
}

__device__ __forceinline__ void finish0_phase(const Fr& F, const Args& a) {
    unsigned char* ws = a.ws;
    const bf16* Z = (const bf16*)(ws + WS_ZR);
    const bf16* R = (const bf16*)(ws + WS_MIX + MX_R); const bf16* V = (const bf16*)(ws + WS_MIX + MX_V); const bf16* Km = (const bf16*)(ws + WS_MIX + MX_K); const bf16* Gg = (const bf16*)(ws + WS_MIX + MX_G);
    const bf16* YA = (const bf16*)(ws + WS_MIX + MX_YA); const bf16* YB = (const bf16*)(ws + WS_MIX + MX_YB); const bf16* OC2 = (const bf16*)(ws + WS_MIX + MX_DEC);
    bf16* A2 = (bf16*)a.out;
    const float* rk = a.in[I_RK]; const float* lnw = a.in[I_LNW]; const float* lnb = a.in[I_LNB]; const float* glag = a.in[I_GLAG];
    const int gw = F.wave * F.G + F.vcu, NGW = F.G * NWAVES, lane = F.lane;
    for (int m = gw; m < M; m += NGW) {
        const size_t ro = (size_t)m * MIXA + 16 * lane;
        const Raw16 qy0 = ld16raw(YA + ro, true), qy1 = ld16raw(YA + (size_t)M * MIXA + ro, true), qr = ld16raw(R + ro, true), qk = ld16raw(Km + ro, true), qv = ld16raw(V + ro, true), qg = ld16raw(Gg + ro, true);
        const Raw16 pb0 = ld16raw(YB + ro, true), pb1 = ld16raw(YB + (size_t)M * MIXA + ro, true), pgt = ld16raw(Z + (size_t)m * ZLD0 + GR + 16 * lane, true), pc0 = ld16raw(OC2 + ro, true), pc1 = ld16raw(OC2 + (size_t)M * MIXA + ro, true);
        {
            float y0[16], y1[16], y[16], r[16], k[16], v[16], g[16], o[16];
            unpack16(qy0, y0); unpack16(qy1, y1); unpack16(qr, r); unpack16(qk, k); unpack16(qv, v); unpack16(qg, g);
            float s = 0.f, bs = 0.f;
#pragma unroll
            for (int q = 0; q < 4; ++q) { const f32x4 rkv = *(const f32x4*)(rk + 16 * lane + 4 * q);
#pragma unroll
                for (int i = 0; i < 4; ++i) { const int e = 4 * q + i; y[e] = y0[e] + y1[e]; s += y[e]; bs += r[e] * k[e] * rkv[i]; } }
            s = quad_sum(s); bs = quad_sum(bs);
            const float mean = s * (1.0f / 64.0f); float q2 = 0.f;
#pragma unroll
            for (int e = 0; e < 16; ++e) { const float dd = y[e] - mean; q2 += dd * dd; }
            q2 = quad_sum(q2);
            const float rstd = rsqrtf(q2 * (1.0f / 64.0f) + GN_EPS);
#pragma unroll
            for (int q = 0; q < 4; ++q) { const f32x4 lw = *(const f32x4*)(lnw + 16 * lane + 4 * q), lb = *(const f32x4*)(lnb + 16 * lane + 4 * q);
#pragma unroll
                for (int i = 0; i < 4; ++i) { const int e = 4 * q + i; o[e] = ((y[e] - mean) * rstd * lw[i] + lb[i] + bs * v[e]) * g[e]; } }
            store16(A2 + (size_t)m * D + 16 * lane, o);
        }
        {
            float y0[16], y1[16], y[16], gt[16], o[16];
            unpack16(pb0, y0); unpack16(pb1, y1); unpack16(pgt, gt);
            float c0[16], c1[16]; unpack16(pc0, c0); unpack16(pc1, c1);
            float s = 0.f;
#pragma unroll
            for (int e = 0; e < 16; ++e) { y[e] = (y0[e] + y1[e]) + (c0[e] + c1[e]); s += y[e] * y[e]; }
            s = row16_sum(s);
            const float rstd = rsqrtf(s * (1.0f / 256.0f) + RMS_EPS);
#pragma unroll
            for (int q = 0; q < 4; ++q) { const f32x4 gg = *(const f32x4*)(glag + ((16 * lane) & 255) + 4 * q);
#pragma unroll
                for (int i = 0; i < 4; ++i) { const int e = 4 * q + i; o[e] = y[e] * rstd * gg[i] * fsilu(gt[e]); } }
            store16(A2 + (size_t)m * D + MIXA + 16 * lane, o);
        }
    }
}
__device__ __forceinline__ void finish1_phase(const Fr& F, const Args& a) {
    unsigned char* ws = a.ws;
    const bf16* Z = (const bf16*)(ws + WS_ZR); const bf16* OC = (const bf16*)(ws + WS_MIX + MX_OC); bf16* A3 = (bf16*)(ws + WS_MIX + MX_A3);
    const int gw = F.vcu * NWAVES + F.wave, NGW = F.G * NWAVES, lane = F.lane;
    for (int m = gw; m < M; m += NGW) {
        if ((m % TB) < CTX) continue;
#pragma unroll
        for (int hb = 0; hb < 2; ++hb) {
            u32x4 q0[4], q1[4], q2[4], qg[4];
#pragma unroll
            for (int j = 0; j < 4; ++j) { const int h = 4 * hb + j; const size_t off = (size_t)m * 4096 + h * 512 + 8 * lane;
                q0[j] = *(const u32x4*)(OC + off); q1[j] = *(const u32x4*)(OC + (size_t)M * 4096 + off); q2[j] = *(const u32x4*)(A3 + off);
                qg[j] = *(const u32x4*)(Z + (size_t)m * RETC + 8192 + h * 512 + 8 * lane); }
#pragma unroll
            for (int j = 0; j < 4; ++j) { const int h = 4 * hb + j; const size_t off = (size_t)m * 4096 + h * 512 + 8 * lane;
                float o0[8], o1[8], o2[8], g[8], o[8];
                unpack8(q0[j], o0); unpack8(q1[j], o1); unpack8(q2[j], o2); unpack8(qg[j], g);
                float s = 0.f;
#pragma unroll
                for (int e = 0; e < 8; ++e) { o[e] = (o0[e] + o1[e]) + o2[e]; s += o[e] * o[e]; }
                const float rstd = rsqrtf(wave_sum(s) * (1.0f / 512.0f) + RMS_EPS);
#pragma unroll
                for (int e = 0; e < 8; ++e) o[e] = o[e] * rstd * fsilu(g[e]);
                *(u32x4*)(A3 + off) = pack8(o); }
        }
    }
}

constexpr int N_PHASES = 23;
__global__ void __launch_bounds__(NTHR, 2) mega(Args a) {
    extern __shared__ __attribute__((aligned(16))) unsigned char lds_raw[];
    Fr F; F.lds = (LAS unsigned char*)lds_raw; F.tid = threadIdx.x; F.lane = F.tid & 63; F.wave = __builtin_amdgcn_readfirstlane(F.tid >> 6);
    F.G = gridDim.x; { const int bx = blockIdx.x; F.vcu = (F.G % 8 == 0) ? (bx % 8) * (F.G / 8) + bx / 8 : bx; }
    const int wave0 = F.wave;
#define REFRAME() do { const int _l = lane_id_opaque(); int _w = wave0; asm volatile("" : "+s"(_w)); F.lane = _l; F.wave = _w; F.tid = _w * 64 + _l; } while (0)
    unsigned char* ws = a.ws;
    const int lo = a.ph_lo, hi = a.ph_hi;
#if MK_ONE_LAUNCH
    volatile LAS unsigned* bst = (volatile LAS unsigned*)(F.lds + LDS_BYTES - 16);
    if (F.tid < 4) bst[F.tid] = 0u;
    __syncthreads();
    XcdBarrier bar = xcd_barrier_post((unsigned*)(ws + WS_CTL) + 4096, bst);
#define GRID_BAR() xcd_barrier(bar)
#else
#define GRID_BAR() do { } while (0)
#endif
#define IN(k) (lo <= (k) && (k) < hi)
#if MK_ONE_LAUNCH
#define SEAM(k) do { if (IN(k) && IN((k) + 1)) { GRID_BAR(); } } while (0)
#else
#define SEAM(k) do { } while (0)
#endif
    const float* modv = (const float*)(ws + WS_MODV);
    const float* ng = a.in[I_NG];
    bf16* ABF = (bf16*)a.out;
    const int bx = blockIdx.x;

    if (IN(0)) { REFRAME(); p0_prologue(F, a); } SEAM(0);
    if (IN(1)) { REFRAME(); rows_phase(F, a, 0, 0, true, nullptr, nullptr, false, ng + 0 * D, modv + 0 * D, modv + 1 * D); } SEAM(1);
    if (IN(2)) { REFRAME(); pg8::Gemm g{ABF, (const bf16*)(ws + WS_WAB), D, D, D}; pg8::StaticOrder S; S.init(M / 256, ZLD0 / 256, F.G, bx, 0, D / 64);
        pg8::EpiBf16 E{(bf16*)(ws + WS_ZR), ZLD0, 0}; pg8::gemm_phase(F.lds, g, S, E, F.tid);
        REFRAME(); __syncthreads(); conv_dyn(F, a, (unsigned*)(ws + WS_CTL) + 2048, 1, 3); } SEAM(2);
    if (IN(3)) { REFRAME(); prep_phase(F, a); } SEAM(3);
    if (IN(4)) { REFRAME();
        pg8::Gemm g{(const bf16*)(ws + WS_MIX + MX_ALO), (const bf16*)(ws + WS_WLO), 512, 512, 256};
        { pg8::StaticOrder S; S.init(M / 256, 8, F.G, (bx + 136) % F.G, 0, 4, 0, 0); pg8::EpiDec E{(float*)(ws + WS_MIX + MX_DEC), a.in[I_W0]}; pg8::gemm_phase(F.lds, g, S, E, F.tid); }
        REFRAME();
        { pg8::StaticOrder S; S.init(M / 256, 4, F.G, (bx + 16) % F.G, 0, 4, 8, 0);
          pg8::EpiLr E{(bf16*)(ws + WS_MIX + MX_K), (const bf16*)(ws + WS_MIX + MX_KK), (bf16*)(ws + WS_MIX + MX_BV), a.in[I_A0], a.in[I_KA]}; pg8::gemm_phase(F.lds, g, S, E, F.tid); }
        REFRAME();
        { pg8::StaticOrder S; S.init(M / 256, 4, F.G, (bx + 16 + 136) % F.G, 0, 4, 12, 256); pg8::EpiBf16 E{(bf16*)(ws + WS_MIX + MX_G), MIXA, 12 * 256}; pg8::gemm_phase(F.lds, g, S, E, F.tid); }
    } SEAM(4);
    if (IN(5)) { REFRAME();
        if (F.vcu < 208) rwkv_pre_phase(F, a, F.vcu, 208);
        else gla_pre_phase(F, a, F.vcu - 208, F.G - 208);
    } SEAM(5);
    if (IN(6)) { REFRAME();
        { const int xj = F.vcu & 31, xx = F.vcu >> 5;
          if (F.G == 256) { if (xj < 8) rwkv_seq_phase(F, a, xx * 8 + xj, 64); else if (xj < 24) gla_seq_phase(F, a, xx * 16 + (xj - 8), 128); }
          else { if (F.vcu < 64) rwkv_seq_phase(F, a, F.vcu, 64); else if (F.vcu < 192) gla_seq_phase(F, a, F.vcu - 64, 128); } }
        REFRAME(); __syncthreads();
        conv_dyn(F, a, (unsigned*)(ws + WS_CTL) + 2112, 4, 5);
    } SEAM(6);
    if (IN(9)) { REFRAME(); finish0_phase(F, a); } SEAM(9);
    if (IN(10)) { REFRAME(); pg8::Gemm g{ABF, (const bf16*)(ws + WS_WO0), D, D, D}; pg8::StaticOrder S; S.init(32, D / 256, F.G, bx, 3, D / 64, 0, 0, 8);
        pg8::EpiF32 E{(bf16*)(ws + WS_MIX + MX_Y), D, (float*)(ws + WS_YC)}; pg8::gemm_phase(F.lds, g, S, E, F.tid);
        REFRAME(); __syncthreads(); conv_dyn(F, a, (unsigned*)(ws + WS_CTL) + 2560, 5, 6, 0, 256); } SEAM(10);
    if (IN(11)) { REFRAME(); rows_phase(F, a, 1, 8, true, ng + 1 * D, modv + 2 * D, false, ng + 2 * D, modv + 3 * D, modv + 4 * D); } SEAM(11);
    if (IN(12)) { REFRAME(); pg8::Gemm g{ABF, (const bf16*)(ws + WS_WFI0), D, D, D}; pg8::StaticOrder S; S.init(M / 256, 2 * DFF / 256, F.G, bx, 0, D / 64);
        pg8::EpiSwiglu E{(bf16*)(ws + WS_ZR), DFF}; pg8::gemm_phase(F.lds, g, S, E, F.tid);
        REFRAME(); __syncthreads(); conv_dyn(F, a, (unsigned*)(ws + WS_CTL) + 2304, 3, 4); } SEAM(12);
    if (IN(13)) { REFRAME(); pg8::Gemm g{(const bf16*)(ws + WS_ZR), (const bf16*)(ws + WS_WFO0), DFF, DFF, DFF}; pg8::StaticOrder S; S.init(32, D / 256, F.G, bx, 3, DFF / 64, 0, 0, 11);
        pg8::EpiF32 E{(bf16*)(ws + WS_MIX + MX_Y), D, (float*)(ws + WS_YC)}; pg8::gemm_phase(F.lds, g, S, E, F.tid);
        REFRAME(); __syncthreads(); conv_dyn(F, a, (unsigned*)(ws + WS_CTL) + 2432, 5, 6, 256, -1); } SEAM(13);
    if (IN(14)) { REFRAME(); rows_phase(F, a, 1, 11, false, ng + 3 * D, modv + 5 * D, false, ng + 4 * D, modv + 3 * 12288 + 0 * D, modv + 3 * 12288 + 1 * D); } SEAM(14);
    if (IN(15)) { REFRAME(); pg8::Gemm g{ABF, (const bf16*)(ws + WS_WRI), D, D, D}; pg8::StaticOrder S; S.init(M / 256, RETC / 256, F.G, bx, 0, D / 64);
        pg8::EpiRet E{(bf16*)(ws + WS_ZR), RETC, (const float*)(ws + WS_ROT)}; pg8::gemm_phase(F.lds, g, S, E, F.tid);
        REFRAME(); __syncthreads(); conv_dyn(F, a, (unsigned*)(ws + WS_CTL) + 2176, 6, 7); } SEAM(15);
    if (IN(16)) { REFRAME();
        ret_intra_phase(F, (const bf16*)(ws + WS_ZR), (bf16*)(ws + WS_MIX + MX_A3));
        REFRAME(); __syncthreads();
        ret_scan_phase(F, (const bf16*)(ws + WS_ZR), (bf16*)(ws + WS_MIX + MX_OC)); } SEAM(16);
    if (IN(17)) { REFRAME(); finish1_phase(F, a); } SEAM(17);
    const bool fuse_rows = (F.G == 256) && MK_ONE_LAUNCH;
    unsigned* xcnt = (unsigned*)(ws + WS_CTL + 65536); float* xslot = (float*)(ws + WS_CTL + 131072); unsigned* xtmo = (unsigned*)(ws + WS_CTL) + 4096 + XB_TMO;
    if (IN(18)) { REFRAME(); pg8::Gemm g{(const bf16*)(ws + WS_MIX + MX_A3), (const bf16*)(ws + WS_WRO), 2 * D, 2 * D, 2 * D}; pg8::StaticOrder S; S.init(32, D / 256, F.G, bx, 1, 2 * D / 64);
        if (fuse_rows) {
            pg8::NormX x1{xslot, xcnt, xtmo}, x2{xslot + 34 * 256 * 8, xcnt + 34 * 64, xtmo};
            pg8::EpiNorm E{(bf16*)(ws + WS_H), ABF, nullptr, modv + 3 * 12288 + 2 * D, ng + 5 * D, ng + 6 * D, modv + 3 * 12288 + 3 * D, modv + 3 * 12288 + 4 * D, false, x1, x2};
            pg8::gemm_phase(F.lds, g, S, E, F.tid);
        } else { pg8::EpiF32 E{(bf16*)(ws + WS_MIX + MX_Y), D, (float*)(ws + WS_YC)}; pg8::gemm_phase(F.lds, g, S, E, F.tid); } } SEAM(18);
    if (!fuse_rows) { if (IN(19)) { REFRAME(); rows_phase(F, a, 1, 0, false, ng + 5 * D, modv + 3 * 12288 + 2 * D, false, ng + 6 * D, modv + 3 * 12288 + 3 * D, modv + 3 * 12288 + 4 * D); } SEAM(19); }
    if (IN(20)) { REFRAME(); pg8::Gemm g{ABF, (const bf16*)(ws + WS_WFI1), D, D, D}; pg8::StaticOrder S; S.init(32, 2 * DFF / 256, F.G, bx, 1, D / 64);
        pg8::EpiSwiglu E{(bf16*)(ws + WS_ZR), DFF}; pg8::gemm_phase(F.lds, g, S, E, F.tid);
        REFRAME(); __syncthreads(); conv_dyn(F, a, (unsigned*)(ws + WS_CTL) + 2240, 7, 8); } SEAM(20);
    if (IN(21)) { REFRAME(); pg8::Gemm g{(const bf16*)(ws + WS_ZR), (const bf16*)(ws + WS_WFO1), DFF, DFF, DFF}; pg8::StaticOrder S; S.init(32, D / 256, F.G, bx, 1, DFF / 64);
        if (fuse_rows) {
            pg8::NormX x1{xslot + 2 * 34 * 256 * 8, xcnt + 2 * 34 * 64, xtmo};
            pg8::EpiNorm E{(bf16*)(ws + WS_H), nullptr, a.out, modv + 3 * 12288 + 5 * D, ng + 7 * D, nullptr, nullptr, nullptr, true, x1, x1};
            pg8::gemm_phase(F.lds, g, S, E, F.tid);
        } else { pg8::EpiF32 E{(bf16*)(ws + WS_MIX + MX_Y), D, (float*)(ws + WS_YC)}; pg8::gemm_phase(F.lds, g, S, E, F.tid); } }
    if (!fuse_rows) { SEAM(21);
    if (IN(22)) { REFRAME(); rows_phase(F, a, 1, 0, false, ng + 7 * D, modv + 3 * 12288 + 5 * D, true, nullptr, nullptr, nullptr); } }
#undef IN
#undef SEAM
}


extern "C" void kernel_launch(void* const* d_in, const int* in_sizes, int n_in, void* d_out, int out_size, void* d_ws, size_t ws_size, hipStream_t stream) {
    static int grid = 0;
    if (grid == 0) {
        if (n_in != 27 || ws_size < WS_END) { fprintf(stderr, "kernel_launch: unexpected n_in %d or ws_size %zu (need %zu)\n", n_in, ws_size, (size_t)WS_END); grid = -1; return; }
        int dev = 0, cus = 0, per_cu = 0;
        (void)hipGetDevice(&dev); (void)hipDeviceGetAttribute(&cus, hipDeviceAttributeMultiprocessorCount, dev);
        if (hipFuncSetAttribute((const void*)mega, hipFuncAttributeMaxDynamicSharedMemorySize, LDS_BYTES) != hipSuccess) { fprintf(stderr, "kernel_launch: hipFuncSetAttribute failed\n"); grid = -1; return; }
        if (hipOccupancyMaxActiveBlocksPerMultiprocessor(&per_cu, (const void*)mega, NTHR, LDS_BYTES) != hipSuccess || per_cu < 1) { fprintf(stderr, "kernel_launch: occupancy query says %d\n", per_cu); per_cu = 1; }
        (void)hipGetLastError();
        grid = cus;
    }
    if (grid < 0) return;
    Args a{};
    for (int i = 0; i < 27; ++i) a.in[i] = (const float*)d_in[i];
    a.out = (float*)d_out; a.ws = (unsigned char*)d_ws;
#if MK_ONE_LAUNCH
    (void)hipMemsetAsync((char*)d_ws + WS_CTL, 0, 128 * 1024, stream);
    a.ph_lo = 0; a.ph_hi = N_PHASES;
    void* args[] = {&a};
    hipError_t e = hipLaunchCooperativeKernel((const void*)mega, dim3(grid), dim3(NTHR), args, LDS_BYTES, stream);
    if (e != hipSuccess) fprintf(stderr, "cooperative launch failed: %s (grid %d)\n", hipGetErrorString(e), grid);
#else
    for (int p = 0; p < N_PHASES; ++p) {
        a.ph_lo = p; a.ph_hi = p + 1;
        hipLaunchKernelGGL(mega, dim3(grid), dim3(NTHR), LDS_BYTES, stream, a);
    }
#endif
}
```
